# Optimizing an MI355X kernel written in HIP

```python
import math
import jax, jax.numpy as jnp
from jax import lax
import numpy as np

D_MODEL = 1024
BATCH = 32
SEQ = 256
DEPTH = 1
DEC_BATCH = 2
DEC_SEQ = 1024
PAST_LEN = 512

GRID_W = 64
MIX_WIDTH = D_MODEL
H_A = 4
DK_A = MIX_WIDTH // 8
DV_A = MIX_WIDTH // 8
H_B = 4
D_HEAD_B = MIX_WIDTH // 16
D_FF = ((8 * D_MODEL // 3 + 127) // 128) * 128
HGRN_CHUNK = 32
Q_BLOCK = 128
ROPE_THETA = 10000.0
N_MOD = 9
EPS = 1e-6

kernel_name = "hymba_hgrn2_diffattn_macaron_dit_step"


def rms_norm(x, g):
    xf = x.astype(jnp.float32)
    y = xf * lax.rsqrt(jnp.mean(xf * xf, axis=-1, keepdims=True) + EPS)
    return (y * g.astype(jnp.float32)).astype(x.dtype)


def swiglu(h, w_in, w_out):
    gate, up = jnp.split(h @ w_in, 2, axis=-1)
    return (jax.nn.silu(gate) * up) @ w_out


def rope_tables(n_tokens):
    rows = n_tokens // GRID_W
    pos_row = jnp.repeat(jnp.arange(rows, dtype=jnp.float32), GRID_W)
    pos_col = jnp.tile(jnp.arange(GRID_W, dtype=jnp.float32), rows)
    half = D_HEAD_B // 2
    inv = ROPE_THETA ** (-jnp.arange(0, half, 2, dtype=jnp.float32) / half)
    ang_r = pos_row[:, None] * inv
    ang_c = pos_col[:, None] * inv
    return (jnp.cos(ang_r), jnp.sin(ang_r), jnp.cos(ang_c), jnp.sin(ang_c))


def apply_rope_2d(x, tables):
    cr, sr, cc, sc = [t[None, :, None, None, :].astype(x.dtype) for t in tables]
    xr, xc = jnp.split(x, 2, axis=-1)

    def rot(a, cos, sin):
        a1, a2 = jnp.split(a, 2, axis=-1)
        return jnp.concatenate([a1 * cos - a2 * sin, a2 * cos + a1 * sin], axis=-1)

    return jnp.concatenate([rot(xr, cr, sr), rot(xc, cc, sc)], axis=-1)


def hgrn_scan(q, k, log_f, v, s0):
    B, T, H, _ = q.shape
    dv = v.shape[-1]
    n = T // HGRN_CHUNK

    def chunks(a):
        return a.astype(jnp.float32).reshape(B, n, HGRN_CHUNK, H, a.shape[-1]).swapaxes(0, 1)

    tri = jnp.tril(jnp.ones((HGRN_CHUNK, HGRN_CHUNK), dtype=bool))[None, :, :, None, None]

    def body(s, blk):
        qc, kc, lf, vc = blk
        b = jnp.cumsum(lf, axis=1)
        decay = jnp.exp(jnp.where(tri, b[:, :, None] - b[:, None, :], -jnp.inf))
        scores = jnp.einsum('bthk,bshk,btshk->bhts', qc, kc, decay)
        o = (jnp.einsum('bhts,bshv->bthv', scores, vc)
             + jnp.einsum('bthk,bhkv->bthv', qc * jnp.exp(b), s))
        b_end = b[:, -1]
        s = (jnp.exp(b_end)[..., None] * s
             + jnp.einsum('bshk,bshv->bhkv', kc * jnp.exp(b_end[:, None] - b), vc))
        return s, o

    s_fin, o = lax.scan(body, s0.astype(jnp.float32), (chunks(q), chunks(k), chunks(log_f), chunks(v)))
    return o.swapaxes(0, 1).reshape(B, T, H, dv), s_fin


def diff_attention(q, k, v, lam):
    B, Tq = q.shape[:2]
    scale = D_HEAD_B ** -0.5
    qb = q.reshape(B, Tq // Q_BLOCK, Q_BLOCK, H_B, 2, D_HEAD_B).swapaxes(0, 1)

    def one_block(qi):
        s = jnp.einsum('bqhmd,bkhmd->bhmqk', qi, k).astype(jnp.float32) * scale
        p = jax.nn.softmax(s, axis=-1)
        a = p[:, :, 0] - lam * p[:, :, 1]
        return jnp.einsum('bhqk,bkhe->bqhe', a.astype(v.dtype), v)

    o = lax.map(one_block, qb)
    return o.swapaxes(0, 1).reshape(B, Tq, H_B, 2 * D_HEAD_B)


def token_mix(h, p, lb, lam_init, ctx_cache=None, rope=None):
    B, T, _ = h.shape
    sizes = [H_A * DK_A, H_A * DV_A, H_A * DK_A, H_A * DK_A, H_A * DV_A,
             H_B * 2 * D_HEAD_B, H_B * 2 * D_HEAD_B, H_B * 2 * D_HEAD_B]
    idx = []
    acc = 0
    for s in sizes[:-1]:
        acc += s
        idx.append(acc)
    proj = h @ p['w_mix_in']
    hq, hi, hf_fwd, hf_bwd, hg, aq, ak, av = jnp.split(proj, idx, axis=-1)

    def heads(a, d):
        return a.reshape(B, T, H_A, d)

    q_rec = heads(hq, DK_A)
    i_rec = heads(hi, DV_A)
    lb_h = lb.reshape(H_A, DK_A)

    def forget(hf):
        f = lb_h + (1.0 - lb_h) * jax.nn.sigmoid(heads(hf, DK_A).astype(jnp.float32))
        return jnp.log(f), 1.0 - f

    lf_f, k_f = forget(hf_fwd)
    lf_b, k_b = forget(hf_bwd)
    if ctx_cache is None:
        s0_f = jnp.zeros((B, H_A, DK_A, DV_A), jnp.float32)
        s0_b = s0_f
    else:
        s0_f = ctx_cache[2][:, 0]
        s0_b = ctx_cache[2][:, 1]
    o_f, s_f = hgrn_scan(q_rec, k_f, lf_f, i_rec, s0_f)
    rev = lambda a: jnp.flip(a, axis=1)
    o_b, s_b = hgrn_scan(rev(q_rec), rev(k_b), rev(lf_b), rev(i_rec), s0_b)
    o_rec = rms_norm(o_f + rev(o_b), p['hgrn_out_norm']).astype(h.dtype) * jax.nn.silu(heads(hg, DV_A))

    q_att = rms_norm(aq.reshape(B, T, H_B, 2, D_HEAD_B), p['attn_q_norm'])
    k_att = rms_norm(ak.reshape(B, T, H_B, 2, D_HEAD_B), p['attn_k_norm'])
    v_att = av.reshape(B, T, H_B, 2 * D_HEAD_B)
    if ctx_cache is None:
        keys, vals = k_att, v_att
    else:
        q_att = apply_rope_2d(q_att, rope)
        k_lat = apply_rope_2d(k_att, rope)
        keys = jnp.concatenate([ctx_cache[0].astype(h.dtype), k_lat], axis=1)
        vals = jnp.concatenate([ctx_cache[1].astype(h.dtype), v_att], axis=1)
    lq1, lk1, lq2, lk2 = p['attn_lambda'].astype(jnp.float32)
    lam = jnp.exp(jnp.sum(lq1 * lk1)) - jnp.exp(jnp.sum(lq2 * lk2)) + lam_init
    o_att = diff_attention(q_att, keys, vals, lam)
    o_att = rms_norm(o_att, p['attn_subln']) * (1.0 - lam_init)

    o = jnp.concatenate([o_rec.reshape(B, T, -1), o_att.reshape(B, T, -1)], axis=-1) @ p['w_mix_out']
    return o, k_att, v_att, jnp.stack([s_f, s_b], axis=1)


def layer(x, cond, p, lb, lam_init, ctx_cache=None, rope=None):
    m = (jax.nn.silu(cond) @ p['w_ada'] + p['b_ada']).reshape(cond.shape[0], N_MOD, D_MODEL)[:, :, None, :]
    sh1, sc1, g1, sh2, sc2, g2, sh3, sc3, g3 = [m[:, j] for j in range(N_MOD)]
    h = rms_norm(x, p['norm_ffn1']) * (1.0 + sc1) + sh1
    x = x + 0.5 * g1 * swiglu(h, p['w_ffn1_in'], p['w_ffn1_out'])
    h = rms_norm(x, p['norm_mix']) * (1.0 + sc2) + sh2
    mix, k_ctx, v_ctx, s_ctx = token_mix(h, p, lb, lam_init, ctx_cache, rope)
    x = x + g2 * mix
    h = rms_norm(x, p['norm_ffn2']) * (1.0 + sc3) + sh3
    x = x + 0.5 * g3 * swiglu(h, p['w_ffn2_in'], p['w_ffn2_out'])
    return x, k_ctx, v_ctx, s_ctx


def setup_inputs(seed: int = 0) -> dict:
    key = jax.random.key(seed)
    ks = jax.random.split(key, 24)
    f32 = jnp.float32

    def nrm(k, shape, s=1.0):
        return s * jax.random.normal(k, shape, f32)

    mix_in = 3 * H_A * DK_A + 2 * H_A * DV_A + 3 * H_B * 2 * D_HEAD_B
    mix_out = H_A * DV_A + H_B * 2 * D_HEAD_B
    return {
        "x_prompt": nrm(ks[0], (BATCH, SEQ, D_MODEL)),
        "x_sample": nrm(ks[1], (DEC_BATCH, DEC_SEQ, D_MODEL)),
        "c": nrm(ks[2], (DEC_BATCH, D_MODEL)),
        "cache_attn_k": nrm(ks[3], (DEC_BATCH, DEPTH, PAST_LEN, H_B, 2, D_HEAD_B)),
        "cache_attn_v": nrm(ks[4], (DEC_BATCH, DEPTH, PAST_LEN, H_B, 2 * D_HEAD_B), 0.5),
        "state_hgrn": nrm(ks[5], (DEC_BATCH, DEPTH, 2, H_A, DK_A, DV_A), 0.5),
        "c_ctx": nrm(ks[6], (D_MODEL,)),
        "w_ada": nrm(ks[7], (DEPTH, D_MODEL, N_MOD * D_MODEL), 0.5 * D_MODEL ** -0.5),
        "b_ada": nrm(ks[8], (DEPTH, N_MOD * D_MODEL), 0.02),
        "norm_ffn1": 1.0 + nrm(ks[9], (DEPTH, D_MODEL), 0.05),
        "w_ffn1_in": nrm(ks[10], (DEPTH, D_MODEL, 2 * D_FF), D_MODEL ** -0.5),
        "w_ffn1_out": nrm(ks[11], (DEPTH, D_FF, D_MODEL), D_FF ** -0.5),
        "norm_mix": 1.0 + nrm(ks[12], (DEPTH, D_MODEL), 0.05),
        "w_mix_in": nrm(ks[13], (DEPTH, D_MODEL, mix_in), D_MODEL ** -0.5),
        "w_mix_out": nrm(ks[14], (DEPTH, mix_out, D_MODEL), mix_out ** -0.5),
        "hgrn_lb_logits": nrm(ks[15], (DEPTH + 1, H_A * DK_A), 0.5),
        "hgrn_out_norm": 1.0 + nrm(ks[16], (DEPTH, DV_A), 0.05),
        "attn_q_norm": 1.0 + nrm(ks[17], (DEPTH, D_HEAD_B), 0.05),
        "attn_k_norm": 1.0 + nrm(ks[18], (DEPTH, D_HEAD_B), 0.05),
        "attn_lambda": nrm(ks[19], (DEPTH, 4, D_HEAD_B), 0.1),
        "attn_subln": 1.0 + nrm(ks[20], (DEPTH, 2 * D_HEAD_B), 0.05),
        "norm_ffn2": 1.0 + nrm(ks[21], (DEPTH, D_MODEL), 0.05),
        "w_ffn2_in": nrm(ks[22], (DEPTH, D_MODEL, 2 * D_FF), D_MODEL ** -0.5),
        "w_ffn2_out": nrm(ks[23], (DEPTH, D_FF, D_MODEL), D_FF ** -0.5),
    }


def reference(x_prompt, x_sample, c, cache_attn_k, cache_attn_v, state_hgrn, c_ctx,
              w_ada, b_ada, norm_ffn1, w_ffn1_in, w_ffn1_out, norm_mix, w_mix_in, w_mix_out,
              hgrn_lb_logits, hgrn_out_norm, attn_q_norm, attn_k_norm, attn_lambda, attn_subln,
              norm_ffn2, w_ffn2_in, w_ffn2_out):
    lb_all = jnp.cumsum(jax.nn.softmax(hgrn_lb_logits.astype(jnp.float32), axis=0), axis=0)
    rope = rope_tables(x_sample.shape[1])
    y_prompt = x_prompt
    y_sample = x_sample
    ks_list, vs_list, ss_list = [], [], []
    for l in range(DEPTH):
        p = {
            'w_ada': w_ada[l], 'b_ada': b_ada[l],
            'norm_ffn1': norm_ffn1[l], 'w_ffn1_in': w_ffn1_in[l], 'w_ffn1_out': w_ffn1_out[l],
            'norm_mix': norm_mix[l], 'w_mix_in': w_mix_in[l], 'w_mix_out': w_mix_out[l],
            'hgrn_out_norm': hgrn_out_norm[l], 'attn_q_norm': attn_q_norm[l],
            'attn_k_norm': attn_k_norm[l], 'attn_lambda': attn_lambda[l], 'attn_subln': attn_subln[l],
            'norm_ffn2': norm_ffn2[l], 'w_ffn2_in': w_ffn2_in[l], 'w_ffn2_out': w_ffn2_out[l],
        }
        lam_init = 0.8 - 0.6 * math.exp(-0.3 * l)
        y_prompt, k_l, v_l, s_l = layer(y_prompt, c_ctx[None], p, lb_all[l], lam_init)
        y_sample, _, _, _ = layer(y_sample, c, p, lb_all[l], lam_init,
                                  (cache_attn_k[:, l], cache_attn_v[:, l], state_hgrn[:, l]), rope)
        ks_list.append(k_l)
        vs_list.append(v_l)
        ss_list.append(s_l)
    new_attn_k = jnp.stack(ks_list, axis=1)
    new_attn_v = jnp.stack(vs_list, axis=1)
    new_state = jnp.stack(ss_list, axis=1)
    return (y_prompt, y_sample, new_attn_k, new_attn_v, new_state)
```

```cpp
#include <hip/hip_runtime.h>
#include <cstdio>
#include <cstdint>
#define MK_ONE_LAUNCH 1
#define PROBE_DUP 0u
namespace pg8 {
#define PG8_LAS __attribute__((address_space(3)))
typedef unsigned short bf16_t;
typedef short bf16x8 __attribute__((ext_vector_type(8)));
typedef float f32x4 __attribute__((ext_vector_type(4)));
typedef unsigned u32x4 __attribute__((ext_vector_type(4)));
constexpr int BM = 256, BK = 64, HALF = 128, HTB = HALF * BK * 2  , STAGE_BYTES = 8 * HTB, NXCD = 8, WGM = 5;

__host__ __device__ __forceinline__ int lds_byte(int r, int c) { const int st = (r >> 4) * 2 + (c >> 5), rr = r & 15, cc = c & 31, ob = rr * 64 + cc * 2; return st * 1024 + (ob ^ (((ob >> 9) & 1) << 5)); }
__host__ __device__ __forceinline__ void stage_rc(int b, int& R, int& C) { const int st = b / 1024, sb = b % 1024, swz = sb ^ (((sb >> 9) & 1) << 5); R = (st >> 1) * 16 + swz / 64; C = (st & 1) * 32 + (swz % 64) / 2; }
__host__ __device__ __forceinline__ int perm32(int rho) { const int n = rho >> 4, i = rho & 15; return 8 * (i >> 2) + 4 * n + (i & 3); }

struct Unit { int pm, pn, hf; };
struct Gemm { const bf16_t* A; const bf16_t* Bt; int M, N, K; int bmul = 1, amul = 1; };

struct StaticOrder {
    int nM, nN, nwg, G, c;
    __host__ __device__ void init(int M, int N, int G_, int c_) { nM = M / BM; nN = N / BM; nwg = nM * nN; G = G_; c = c_; }
    __host__ __device__ bool next(int i, Unit& u) const {
        const long L = (long)i * G + c; if (L >= nwg) return false; u.hf = 0;
        int wgid = (int)L; { const int q = nwg / NXCD, r = nwg % NXCD, xcd = wgid % NXCD, off = wgid / NXCD; wgid = (xcd < r ? xcd * (q + 1) : r * (q + 1) + (xcd - r) * q) + off; }
        const int nig = WGM * nN, gid = wgid / nig, fm = gid * WGM, gsz = (nM - fm) < WGM ? (nM - fm) : WGM;
        u.pm = fm + ((wgid % nig) % gsz); u.pn = (wgid % nig) / gsz; return true;
    }
    __device__ __forceinline__ void a_ready(const Unit&) const {}
    __device__ __forceinline__ void done(const Unit&) const {}
};


__device__ __forceinline__ unsigned cvt_pk_bf16(float lo, float hi) { unsigned r; asm volatile("v_cvt_pk_bf16_f32 %0, %1, %2" : "=v"(r) : "v"(lo), "v"(hi)); return r; }
#ifndef EPI_SC1
#define EPI_SC1 0
#endif
__device__ __forceinline__ void store16(void* p, u32x4 v) {
#if EPI_SC1
    asm volatile("global_store_dwordx4 %0, %1, off sc1\n\ts_nop 1" :: "v"(p), "v"(v) : "memory");
#else
    *(u32x4*)p = v;
#endif
}
__device__ __forceinline__ void store16f(void* p, f32x4 v) { store16(p, __builtin_bit_cast(u32x4, v)); }
__device__ __forceinline__ float silu_f(float g) { return g * __builtin_amdgcn_rcpf(1.0f + __builtin_amdgcn_exp2f(-1.4426950408889634f * g)); }

__device__ __forceinline__ float row_rstd(const float* rowss, int row) {
    const f32x4* p = (const f32x4*)(rowss + (size_t)row * 16); const f32x4 a = p[0], b = p[1], c = p[2], d = p[3];
    const float s = ((a[0] + a[1]) + (a[2] + a[3])) + ((b[0] + b[1]) + (b[2] + b[3])) + ((c[0] + c[1]) + (c[2] + c[3])) + ((d[0] + d[1]) + (d[2] + d[3]));
    return 1.0f / sqrtf(s * (1.0f / 1024.0f) + 1e-6f);
}
template <bool RS> struct EpiSwiGLU {
    static constexpr bool PERM = true, AFTER_DRAIN = false;
    bf16_t* H; int ldh; const float* rowss; const float* bias2; int ldb2;
    __device__ __forceinline__ void operator()(const f32x4 (&acc)[2][2][4][2], const Unit& u, int wr, int wc, int fr, int fq) const {
        const int row0 = u.pm * BM + (u.hf == 2 ? HALF : 0) + wr * 64 + fr, col0 = u.pn * HALF + wc * 32 + 8 * fq;
        const int cond = u.pm < 32 ? 0 : 1 + ((u.pm - 32) >> 2);
        f32x4 bz[2][2];
#pragma unroll
        for (int bj = 0; bj < 2; ++bj)
#pragma unroll
            for (int n = 0; n < 2; ++n) { bz[bj][n] = (f32x4){0.f, 0.f, 0.f, 0.f}; if constexpr (RS) bz[bj][n] = *(const f32x4*)(bias2 + (size_t)cond * ldb2 + u.pn * BM + bj * HALF + wc * 32 + 8 * fq + 4 * n); }
#pragma unroll
        for (int ai = 0; ai < 2; ++ai)
#pragma unroll
            for (int m = 0; m < 4; ++m) { if (ai == 1 && u.hf) break; const int row = row0 + ai * HALF + m * 16; bf16_t* rowp = H + (size_t)row * ldh + col0;
                float rs = 1.0f; if constexpr (RS) rs = row_rstd(rowss, row);
                const f32x4 g0 = acc[ai][0][m][0] * rs + bz[0][0], g1 = acc[ai][0][m][1] * rs + bz[0][1], u0 = acc[ai][1][m][0] * rs + bz[1][0], u1 = acc[ai][1][m][1] * rs + bz[1][1];
                u32x4 w;
#ifdef PROBE_EPI
                if (ldb2) { w.x = cvt_pk_bf16(g0[0] * u0[0], g0[1] * u0[1]); w.y = cvt_pk_bf16(g0[2] * u0[2], g0[3] * u0[3]); w.z = cvt_pk_bf16(g1[0] * u1[0], g1[1] * u1[1]); w.w = cvt_pk_bf16(g1[2] * u1[2], g1[3] * u1[3]); store16(rowp, w); continue; }
#endif
                w.x = cvt_pk_bf16(silu_f(g0[0]) * u0[0], silu_f(g0[1]) * u0[1]); w.y = cvt_pk_bf16(silu_f(g0[2]) * u0[2], silu_f(g0[3]) * u0[3]);
                w.z = cvt_pk_bf16(silu_f(g1[0]) * u1[0], silu_f(g1[1]) * u1[1]); w.w = cvt_pk_bf16(silu_f(g1[2]) * u1[2], silu_f(g1[3]) * u1[3]);
                store16(rowp, w); }
    }
};

template <bool NXT, bool HALFG> struct EpiResid {
    static constexpr bool PERM = false, AFTER_DRAIN = false;
    const float* base0; const float* base1; float* out; const float* gate;
    bf16_t* nxtA; const float* nw; const float* sc; float* rowss;
    __device__ __forceinline__ void operator()(const f32x4 (&acc)[2][2][4][2], const Unit& u, int wr, int wc, int fr, int fq) const {
        const int row0 = u.pm * BM + wr * 64 + fr, col0 = u.pn * BM + wc * 32 + 4 * fq;
        const int cond = u.pm < 32 ? 0 : 1 + ((u.pm - 32) >> 2);
        const float* bp = u.pm < 32 ? base0 : base1 - (size_t)8192 * 1024;
        if constexpr (!NXT) {
            constexpr float gsl = HALFG ? 0.5f : 1.0f;
            f32x4 gv[2][2];
#pragma unroll
            for (int bj = 0; bj < 2; ++bj)
#pragma unroll
                for (int n = 0; n < 2; ++n) gv[bj][n] = *(const f32x4*)(gate + cond * 9216 + col0 + bj * HALF + n * 16) * gsl;
#pragma unroll
            for (int ai = 0; ai < 2; ++ai)
#pragma unroll
                for (int m = 0; m < 4; ++m) { const size_t off = (size_t)(row0 + ai * HALF + m * 16) * 1024 + col0;
#pragma unroll
                    for (int bj = 0; bj < 2; ++bj)
#pragma unroll
                        for (int n = 0; n < 2; ++n) { const f32x4 b = *(const f32x4*)(bp + off + bj * HALF + n * 16); store16f(out + off + bj * HALF + n * 16, b + gv[bj][n] * acc[ai][bj][m][n]); } }
            return;
        }
        float ss[2][4];
#pragma unroll
        for (int ai = 0; ai < 2; ++ai)
#pragma unroll
            for (int m = 0; m < 4; ++m) ss[ai][m] = 0.f;
#pragma unroll
        for (int bj = 0; bj < 2; ++bj)
#pragma unroll
            for (int n = 0; n < 2; ++n) { const int c = col0 + bj * HALF + n * 16; constexpr float gsl = HALFG ? 0.5f : 1.0f; const f32x4 gv = *(const f32x4*)(gate + cond * 9216 + c) * gsl;
                f32x4 av = {0.f, 0.f, 0.f, 0.f}; if constexpr (NXT) av = *(const f32x4*)(nw + c) * (*(const f32x4*)(sc + cond * 9216 + c) + 1.0f);
#pragma unroll
                for (int ai = 0; ai < 2; ++ai)
#pragma unroll
                    for (int m = 0; m < 4; ++m) { const size_t off = (size_t)(row0 + ai * HALF + m * 16) * 1024 + c; const f32x4 b = *(const f32x4*)(bp + off); const f32x4 o = b + gv * acc[ai][bj][m][n];
                        *(f32x4*)(out + off) = o;
                        if constexpr (NXT) { ss[ai][m] += (o[0] * o[0] + o[1] * o[1]) + (o[2] * o[2] + o[3] * o[3]); const f32x4 a = o * av;
                            typedef unsigned u32x2 __attribute__((ext_vector_type(2))); *(u32x2*)(nxtA + off) = (u32x2){cvt_pk_bf16(a[0], a[1]), cvt_pk_bf16(a[2], a[3])}; } } }
        if constexpr (NXT) {
#pragma unroll
            for (int ai = 0; ai < 2; ++ai)
#pragma unroll
                for (int m = 0; m < 4; ++m) { float s = ss[ai][m]; s += __shfl_xor(s, 16); s += __shfl_xor(s, 32); if (fq == 0) rowss[(size_t)(row0 + ai * HALF + m * 16) * 16 + u.pn * 4 + wc] = s; } }
    }
};

typedef _Float16 h2_t __attribute__((ext_vector_type(2)));
__device__ __forceinline__ unsigned pkh2(float lo, float hi) { const h2_t h = {(_Float16)lo, (_Float16)hi}; return __builtin_bit_cast(unsigned, h); }
__device__ __forceinline__ float logf_gate(float x, float lb) { const float sg = __builtin_amdgcn_rcpf(1.0f + __builtin_amdgcn_exp2f(-1.4426950408889634f * x)); return 0.6931471805599453f * __builtin_amdgcn_logf(lb + (1.0f - lb) * sg); }
template <bool RS> struct EpiProj {
    static constexpr bool PERM = true, AFTER_DRAIN = false;
    bf16_t* P; float* outv; const float* lbv; const float* rowss; const float* bias2;
    __device__ __forceinline__ void operator()(const f32x4 (&acc)[2][2][4][2], const Unit& u, int wr, int wc, int fr, int fq) const {
        const int row0 = u.pm * BM + (u.hf == 2 ? HALF : 0) + wr * 64 + fr, col0 = u.pn * BM + wc * 32 + 8 * fq;
        const bool wv = (u.pn >= 14) && (u.pm < 32), gate = (u.pn >= 4) && (u.pn < 8);
        const int cond = u.pm < 32 ? 0 : 1 + ((u.pm - 32) >> 2);
        f32x4 lb[2][2], bz[2][2];
#pragma unroll
        for (int bj = 0; bj < 2; ++bj)
#pragma unroll
            for (int n = 0; n < 2; ++n) { lb[bj][n] = gate ? *(const f32x4*)(lbv + ((col0 + bj * HALF + 4 * n) & 511)) : (f32x4){0.f, 0.f, 0.f, 0.f}; bz[bj][n] = (f32x4){0.f, 0.f, 0.f, 0.f}; if constexpr (RS) bz[bj][n] = *(const f32x4*)(bias2 + cond * 4096 + col0 + bj * HALF + 4 * n); }
#pragma unroll
        for (int ai = 0; ai < 2; ++ai)
#pragma unroll
            for (int m = 0; m < 4; ++m) { if (ai == 1 && u.hf) break; const int row = row0 + ai * HALF + m * 16; bf16_t* rowp = P + (size_t)row * 4096 + col0; float rs = 1.0f; if constexpr (RS) rs = row_rstd(rowss, row);
#pragma unroll
                for (int bj = 0; bj < 2; ++bj) { const f32x4 v0 = acc[ai][bj][m][0] * rs + bz[bj][0], v1 = acc[ai][bj][m][1] * rs + bz[bj][1]; u32x4 w;
                    if (gate) { const f32x4 l0 = lb[bj][0], l1 = lb[bj][1];
                        w.x = pkh2(logf_gate(v0[0], l0[0]), logf_gate(v0[1], l0[1])); w.y = pkh2(logf_gate(v0[2], l0[2]), logf_gate(v0[3], l0[3]));
                        w.z = pkh2(logf_gate(v1[0], l1[0]), logf_gate(v1[1], l1[1])); w.w = pkh2(logf_gate(v1[2], l1[2]), logf_gate(v1[3], l1[3])); }
                    else { w.x = cvt_pk_bf16(v0[0], v0[1]); w.y = cvt_pk_bf16(v0[2], v0[3]); w.z = cvt_pk_bf16(v1[0], v1[1]); w.w = cvt_pk_bf16(v1[2], v1[3]); }
                    store16(rowp + bj * HALF, w);
                    if (wv) { float* ov = outv + (size_t)row * 512 + (col0 + bj * HALF - 3584); *(f32x4*)ov = v0; *(f32x4*)(ov + 4) = v1; } } }
    }
};
template <class Epi, class Sched, bool ALIGN_EPI = false, bool SP2 = false>
__device__ __forceinline__ void gemm_phase(PG8_LAS unsigned char* lds, const Gemm g, const Sched& S, const Epi& E) {
    const int tid = threadIdx.x, wid = __builtin_amdgcn_readfirstlane(tid >> 6), lane = tid & 63, wr = wid >> 2, wc = wid & 3, fr = lane & 15, fq = lane >> 4;
    const int K = g.K, nt = K / BK;
    unsigned voffA[2], voffB[2];
#pragma unroll
    for (int i = 0; i < 2; ++i) { int R, C; stage_rc(tid * 16 + i * 8192, R, C); const int Rb = Epi::PERM ? ((R & ~31) + perm32(R & 31)) : R;
        voffA[i] = (unsigned)(R * K + C) * 2u; voffB[i] = (unsigned)(Rb * K + C) * 2u; }
    const size_t kstep = (size_t)(BK * 2);
    const size_t hstep = (size_t)HALF * K * 2;
    const size_t tstep = 2 * hstep;
    const unsigned ldsw = (unsigned)wid * 1024u;
    const int aoff = lds_byte(wr * 64 + fr, fq * 8), boff = lds_byte(wc * 32 + fr, fq * 8);
#define PG8_SA(b, h) (((b) * 2 + (h)) * HTB)
#define PG8_SB(b, h) ((4 + (b) * 2 + (h)) * HTB)
#define PG8_STAGE(bufoff, gbase, voff) do { _Pragma("unroll") for (int _i = 0; _i < 2; ++_i) \
        __builtin_amdgcn_global_load_lds((const unsigned*)((const char*)(gbase) + (voff)[_i]), (PG8_LAS unsigned*)(lds + (bufoff) + ldsw + _i * 8192), 16, 0, 0); } while (0)
#define PG8_LDA(dst, b, h) do { _Pragma("unroll") for (int m = 0; m < 4; ++m) _Pragma("unroll") for (int k = 0; k < 2; ++k) dst[m][k] = *(const PG8_LAS bf16x8*)(lds + PG8_SA(b, h) + aoff + m * 2048 + k * 1024); } while (0)
#define PG8_LDB(dst, b, h) do { _Pragma("unroll") for (int n = 0; n < 2; ++n) _Pragma("unroll") for (int k = 0; k < 2; ++k) dst[n][k] = *(const PG8_LAS bf16x8*)(lds + PG8_SB(b, h) + boff + n * 2048 + k * 1024); } while (0)
#define PG8_MMA(ai, bj, At, Bt) do { __builtin_amdgcn_s_setprio(1); _Pragma("unroll") for (int m = 0; m < 4; ++m) _Pragma("unroll") for (int n = 0; n < 2; ++n) _Pragma("unroll") for (int k = 0; k < 2; ++k) \
        acc[ai][bj][m][n] = __builtin_amdgcn_mfma_f32_16x16x32_bf16(Bt[n][k], At[m][k], acc[ai][bj][m][n], 0, 0, 0); __builtin_amdgcn_s_setprio(0); } while (0)
#define PG8_WAIT_V(n) asm volatile("s_waitcnt vmcnt(" #n ")" ::: "memory")
#define PG8_WAIT_L(n) asm volatile("s_waitcnt lgkmcnt(" #n ")" ::: "memory")
#define PG8_BAR __builtin_amdgcn_s_barrier()
#define PG8_SCHED __builtin_amdgcn_sched_barrier(0)
    Unit cur, nxt; int ui = 0;
    if (!S.next(0, cur)) return;
    f32x4 acc[2][2][4][2];
#pragma unroll
    for (int a = 0; a < 2; ++a)
#pragma unroll
        for (int b = 0; b < 2; ++b)
#pragma unroll
            for (int m = 0; m < 4; ++m)
#pragma unroll
                for (int n = 0; n < 2; ++n) acc[a][b][m][n] = (f32x4){0.f, 0.f, 0.f, 0.f};
    bf16x8 At[4][2], B0[2][2], B1[2][2];
    const char* cA = (const char*)g.A + (size_t)(cur.pm * g.amul) * tstep + (cur.hf == 2 ? hstep : (size_t)0); const char* cB = (const char*)g.Bt + (size_t)(cur.pn * g.bmul) * tstep;
    S.a_ready(cur);
    if constexpr (SP2) {
        PG8_STAGE(PG8_SB(0, 0), cB, voffB); PG8_STAGE(PG8_SB(0, 1), cB + hstep, voffB); PG8_STAGE(PG8_SA(0, 0), cA, voffA); PG8_STAGE(PG8_SA(0, 1), cA + hstep, voffA);
        if (wr == 1) PG8_BAR;
        PG8_WAIT_V(2); PG8_BAR;
        PG8_STAGE(PG8_SB(1, 0), cB + kstep, voffB); PG8_STAGE(PG8_SA(1, 0), cA + kstep, voffA); PG8_STAGE(PG8_SB(1, 1), cB + hstep + kstep, voffB);
        PG8_WAIT_V(6); PG8_BAR;
    } else {
        PG8_STAGE(PG8_SB(0, 0), cB, voffB); PG8_STAGE(PG8_SA(0, 0), cA, voffA); PG8_STAGE(PG8_SB(0, 1), cB + hstep, voffB); PG8_STAGE(PG8_SA(0, 1), cA + hstep, voffA);
        if (wr == 1) PG8_BAR;
        PG8_WAIT_V(4); PG8_BAR;
        PG8_STAGE(PG8_SB(1, 0), cB + kstep, voffB); PG8_STAGE(PG8_SA(1, 0), cA + kstep, voffA); PG8_STAGE(PG8_SB(1, 1), cB + hstep + kstep, voffB);
        PG8_WAIT_V(6); PG8_BAR;
    }
    for (;;) {
        const bool has_next = S.next(ui + 1, nxt);
        const char* nA = has_next ? (const char*)g.A + (size_t)(nxt.pm * g.amul) * tstep + (nxt.hf == 2 ? hstep : (size_t)0) : cA; const char* nB = has_next ? (const char*)g.Bt + (size_t)(nxt.pn * g.bmul) * tstep : cB;
        for (int t = 0; t < nt; t += 2) {
            const bool last = (t == nt - 2);
            const char* a1 = cA + (size_t)(t + 1) * kstep;
            const char* a2 = last ? nA : cA + (size_t)(t + 2) * kstep; const char* b2 = last ? nB : cB + (size_t)(t + 2) * kstep;
            const char* a3 = a2 + kstep; const char* b3 = b2 + kstep;
            if (last && has_next) S.a_ready(nxt);
            if constexpr (SP2) {
            PG8_LDB(B0, 0, 0); PG8_LDB(B1, 0, 1); PG8_SCHED; PG8_LDA(At, 0, 0); PG8_STAGE(PG8_SA(1, 1), a1 + hstep, voffA);
            PG8_WAIT_V(8); PG8_WAIT_L(0); PG8_BAR; PG8_MMA(0, 0, At, B0); PG8_MMA(0, 1, At, B1); PG8_BAR; PG8_SCHED;
            PG8_LDA(At, 0, 1); PG8_STAGE(PG8_SB(0, 0), b2, voffB); PG8_STAGE(PG8_SB(0, 1), b2 + hstep, voffB); PG8_STAGE(PG8_SA(0, 0), a2, voffA);
            PG8_WAIT_V(8); PG8_WAIT_L(0); PG8_BAR; PG8_MMA(1, 0, At, B0); PG8_MMA(1, 1, At, B1); PG8_BAR; PG8_SCHED;
            PG8_LDB(B0, 1, 0); PG8_LDB(B1, 1, 1); PG8_SCHED; PG8_LDA(At, 1, 0); PG8_STAGE(PG8_SA(0, 1), a2 + hstep, voffA);
            PG8_WAIT_V(8); PG8_WAIT_L(0); PG8_BAR; PG8_MMA(0, 0, At, B0); PG8_MMA(0, 1, At, B1); PG8_BAR; PG8_SCHED;
            PG8_LDA(At, 1, 1); PG8_STAGE(PG8_SB(1, 0), b3, voffB); PG8_STAGE(PG8_SB(1, 1), b3 + hstep, voffB); PG8_STAGE(PG8_SA(1, 0), a3, voffA);
            PG8_WAIT_V(8); PG8_WAIT_L(0); PG8_BAR; PG8_MMA(1, 0, At, B0); PG8_MMA(1, 1, At, B1); PG8_BAR; PG8_SCHED;
            } else {
            PG8_LDB(B0, 0, 0); PG8_SCHED; PG8_LDA(At, 0, 0); PG8_STAGE(PG8_SA(1, 1), a1 + hstep, voffA);
            PG8_WAIT_L(8); PG8_BAR; PG8_WAIT_L(0); PG8_MMA(0, 0, At, B0); PG8_BAR; PG8_SCHED;
            PG8_LDB(B1, 0, 1); PG8_STAGE(PG8_SB(0, 0), b2, voffB);
            PG8_BAR; PG8_WAIT_L(0); PG8_MMA(0, 1, At, B1); PG8_BAR;
            PG8_LDA(At, 0, 1); PG8_STAGE(PG8_SA(0, 0), a2, voffA);
            PG8_BAR; PG8_WAIT_L(0); PG8_MMA(1, 0, At, B0); PG8_BAR; PG8_SCHED;
            PG8_STAGE(PG8_SB(0, 1), b2 + hstep, voffB);
            PG8_WAIT_V(6); PG8_BAR; PG8_MMA(1, 1, At, B1); PG8_BAR;
            PG8_LDB(B0, 1, 0); PG8_SCHED; PG8_LDA(At, 1, 0); PG8_STAGE(PG8_SA(0, 1), a2 + hstep, voffA);
            PG8_WAIT_L(8); PG8_BAR; PG8_WAIT_L(0); PG8_MMA(0, 0, At, B0); PG8_BAR; PG8_SCHED;
            PG8_LDB(B1, 1, 1); PG8_STAGE(PG8_SB(1, 0), b3, voffB);
            PG8_BAR; PG8_WAIT_L(0); PG8_MMA(0, 1, At, B1); PG8_BAR;
            PG8_LDA(At, 1, 1); PG8_STAGE(PG8_SA(1, 0), a3, voffA);
            PG8_BAR; PG8_WAIT_L(0); PG8_MMA(1, 0, At, B0); PG8_BAR; PG8_SCHED;
            PG8_STAGE(PG8_SB(1, 1), b3 + hstep, voffB);
            PG8_WAIT_V(6); PG8_BAR; PG8_MMA(1, 1, At, B1); PG8_BAR;
            }
        }
        if constexpr (ALIGN_EPI) { if (wr == 0) PG8_BAR; }
        if constexpr (!Epi::AFTER_DRAIN) { E(acc, cur, wr, wc, fr, fq); S.done(cur); }
        if (!has_next) break;
#pragma unroll
        for (int a = 0; a < 2; ++a)
#pragma unroll
            for (int b = 0; b < 2; ++b)
#pragma unroll
                for (int m = 0; m < 4; ++m)
#pragma unroll
                    for (int n = 0; n < 2; ++n) acc[a][b][m][n] = (f32x4){0.f, 0.f, 0.f, 0.f};
        cur = nxt; cA = nA; cB = nB; ++ui;
        if constexpr (ALIGN_EPI) { if (wr == 1) PG8_BAR; }
    }
    PG8_WAIT_V(0);
    if constexpr (!ALIGN_EPI) { if (wr == 0) PG8_BAR; }
    PG8_BAR;
    if constexpr (Epi::AFTER_DRAIN) { E.fused(acc, cur, wr, wc, fr, fq, lds, wid, lane); S.done(cur); }
#undef PG8_SA
#undef PG8_SB
#undef PG8_STAGE
#undef PG8_LDA
#undef PG8_LDB
#undef PG8_MMA
#undef PG8_WAIT_V
#undef PG8_WAIT_L
#undef PG8_BAR
#undef PG8_SCHED
}
}

#ifndef PG8_SP2
#define PG8_SP2 true
#endif
#ifndef PG8_ALIGN
#define PG8_ALIGN true
#endif
constexpr int NWAVES = 8;
#ifndef MK_ONE_LAUNCH
#define MK_ONE_LAUNCH 1
#endif
#ifndef MERGE_P01
#define MERGE_P01 0
#endif
#ifndef FUSE_NORM
#define FUSE_NORM 0
#endif
constexpr int N_PHASES = FUSE_NORM ? 11 : 13;
#ifndef CONV_MODE
#define CONV_MODE 0
#endif

constexpr int DM = 1024, M_P = 8192, M_S = 2048, M = M_P + M_S, DFF = 2816, NFF = 2 * DFF, NMIX = 4096;
constexpr int T_P = 256, T_S = 1024, PAST = 512, TK_S = PAST + T_S, NB_P = 32, NB_S = 2;
constexpr float EPS = 1e-6f;
constexpr float QSCALE = 0.125f * 1.4426950408889634f;
constexpr float LAM_INIT = 0.2f;
constexpr size_t OUT_Y = 0, OUT_K = (size_t)M * DM, OUT_V = OUT_K + (size_t)M_P * 512, OUT_S = OUT_V + (size_t)M_P * 512, OUT_END = OUT_S + (size_t)NB_P * 2 * 4 * 128 * 128;
constexpr int PC_Q = 0, PC_I = 512, PC_FF = 1024, PC_FB = 1536, PC_G = 2048, PC_AQ = 2560, PC_AK = 3072, PC_AV = 3584;

constexpr size_t MiB = 1u << 20;
constexpr size_t WS_CTL = 0, CTL_ZERO_BYTES = 192 * 1024;
constexpr size_t WS_MADA = 64 * 1024;
constexpr size_t WS_LB = 1 * MiB + 128 * 1024;
constexpr size_t WS_ROPE = 1 * MiB + 256 * 1024;
constexpr size_t WS_W1I = 2 * MiB, WS_W1O = 13 * MiB, WS_WMI = 19 * MiB, WS_WMO = 27 * MiB, WS_W2I = 29 * MiB, WS_W2O = 40 * MiB;
constexpr size_t WS_ABUF = 46 * MiB;
constexpr size_t WS_BIG = 66 * MiB;
constexpr size_t WS_QB = 146 * MiB;
constexpr size_t WS_KB = 156 * MiB;
constexpr size_t WS_KS = 164 * MiB;
constexpr size_t WS_VTP = 167 * MiB;
constexpr size_t WS_VTS = 175 * MiB;
constexpr size_t WS_OF = 178 * MiB, WS_OB = 198 * MiB;
constexpr size_t WS_ABUF2 = 218 * MiB;
constexpr size_t WS_ROWSS = 238 * MiB;
constexpr size_t WS_BIAS2 = 239 * MiB;
constexpr size_t WS_HSAVE = 240 * MiB;
constexpr size_t WS_END = 241 * MiB;
constexpr int CW_BAR = 4096;
constexpr int CW_QUEUE = 64;
constexpr int CW_MADA = 768;
constexpr int CW_CONVQ = 512;

constexpr int RING_OFF = 0, RING_BYTES = 131072;
constexpr int LDSCTL_OFF = RING_BYTES, MISC_OFF = LDSCTL_OFF + 320;
constexpr int LDS_BYTES = 147456;

#define GAS __attribute__((address_space(1)))
#define LAS __attribute__((address_space(3)))
typedef unsigned short bf16;
typedef unsigned v4u __attribute__((ext_vector_type(4)));
typedef unsigned v2u __attribute__((ext_vector_type(2)));
typedef float f32x4 __attribute__((ext_vector_type(4)));
typedef float f32x2 __attribute__((ext_vector_type(2)));
typedef float f32x16 __attribute__((ext_vector_type(16)));
typedef short bf16x8 __attribute__((ext_vector_type(8)));
typedef short s16x4 __attribute__((ext_vector_type(4)));
typedef GAS unsigned gu32;
#define RLX_AGENT __ATOMIC_RELAXED, __HIP_MEMORY_SCOPE_AGENT
#define LDS_WAIT() asm volatile("s_waitcnt lgkmcnt(0)" ::: "memory")
#define VM_WAIT() asm volatile("s_waitcnt vmcnt(0)" ::: "memory")
#define LDS_BARRIER() do { asm volatile("s_waitcnt lgkmcnt(0)" ::: "memory"); __builtin_amdgcn_s_barrier(); asm volatile("" ::: "memory"); } while (0)
__device__ __forceinline__ unsigned f2bf(float f) { unsigned u = __builtin_bit_cast(unsigned, f); return (u + 0x7fffu + ((u >> 16) & 1u)) >> 16; }
typedef __bf16 bf16x2_t __attribute__((ext_vector_type(2)));
typedef _Float16 h2_t __attribute__((ext_vector_type(2)));
__device__ __forceinline__ unsigned pkh2(float lo, float hi) { const h2_t h = {(_Float16)lo, (_Float16)hi}; return __builtin_bit_cast(unsigned, h); }
__device__ __forceinline__ unsigned pk2(float lo, float hi) { const f32x2 v = {lo, hi}; const bf16x2_t b = __builtin_convertvector(v, bf16x2_t); return __builtin_bit_cast(unsigned, b); }
__device__ __forceinline__ float bflo(unsigned w) { return __builtin_bit_cast(float, w << 16); }
__device__ __forceinline__ float bfhi(unsigned w) { return __builtin_bit_cast(float, w & 0xffff0000u); }
__device__ __forceinline__ float wave_sum(float v) {
#pragma unroll
    for (int o = 1; o < 64; o <<= 1) v += __shfl_xor(v, o);
    return v;
}
__device__ __forceinline__ float sigmoid_f(float x) { return __builtin_amdgcn_rcpf(1.0f + __builtin_amdgcn_exp2f(-1.4426950408889634f * x)); }
#define XB_TMO      128
#define XB_XCNT(j)  (256  + 64 * (j))
#define XB_XSUB(j)  (1280 + 64 * (j))
#define XB_XGEN(j)  (2304 + 64 * (j))
#define XB_TOP      3328
#define XB_TOPGEN   3392
#define XCD_BAR_WORDS 3456
#define XB_SPIN_CAP (1u << 18)

__device__ __forceinline__ unsigned xb_ld(unsigned* p)              { return __hip_atomic_load(p, __ATOMIC_RELAXED, __HIP_MEMORY_SCOPE_AGENT); }
__device__ __forceinline__ unsigned xb_add(unsigned* p, unsigned v) { return __hip_atomic_fetch_add(p, v, __ATOMIC_RELAXED, __HIP_MEMORY_SCOPE_AGENT); }
__device__ __forceinline__ unsigned xb_xcc_id() { return (unsigned)__builtin_amdgcn_s_getreg((3 << 11) | 20) & 0xFu; }
#define XB_SPIN(cond, bar) do { unsigned _sp = 0; while (cond) { __builtin_amdgcn_s_sleep(1); \
    if ((++_sp & 255u) == 0u) { if (xb_ld(&(bar)[XB_TMO])) break; if (_sp > XB_SPIN_CAP) { atomicAdd(&(bar)[XB_TMO], 1u); break; } } } } while (0)

struct XcdBarrier {
    unsigned* bar; unsigned x;
    volatile LAS unsigned* st;
};

__device__ __forceinline__ XcdBarrier xcd_barrier_post(unsigned* bar, volatile LAS unsigned* st) {
    XcdBarrier b; b.bar = bar; b.x = xb_xcc_id(); b.st = st;
    if (threadIdx.x == 0) (void)xb_add(&bar[XB_XCNT(b.x)], 1u);
    return b;
}
__device__ __forceinline__ void xcd_barrier_complete(unsigned* bar, unsigned x, unsigned& nloc, unsigned& nx) {
    const unsigned G = gridDim.x * gridDim.y * gridDim.z;
    unsigned sum, cnt, mine, sp = 0u;
    for (;;) {
        sum = 0u; cnt = 0u; mine = 0u;
#pragma unroll
        for (unsigned j = 0; j < 16; ++j) { const unsigned c = xb_ld(&bar[XB_XCNT(j)]); sum += c; cnt += (c > 0u) ? 1u : 0u; mine = (j == x) ? c : mine; }
        if (sum == G) break;
        __builtin_amdgcn_s_sleep(1);
        if ((++sp & 255u) == 0u) { if (xb_ld(&bar[XB_TMO])) break; if (sp > XB_SPIN_CAP) { atomicAdd(&bar[XB_TMO], 1u); break; } }
    }
    nloc = mine > 0u ? mine : 1u; nx = cnt > 0u ? cnt : 1u;
}

__device__ __forceinline__ void xcd_barrier(const XcdBarrier& b) {
    asm volatile("s_waitcnt vmcnt(0)" ::: "memory");
    __syncthreads();
    if (threadIdx.x == 0) {
        unsigned* bar = b.bar;
        __builtin_amdgcn_s_waitcnt(0);
        unsigned nloc = b.st[0], nx = b.st[1];
        if (nloc == 0u) { xcd_barrier_complete(bar, b.x, nloc, nx); b.st[0] = nloc; b.st[1] = nx; }
        const unsigned old = xb_add(&bar[XB_XSUB(b.x)], 1u);
        const unsigned gen = old / nloc;
        if (old + 1u == (gen + 1u) * nloc) {
            __builtin_amdgcn_fence(__ATOMIC_RELEASE, "agent");
            asm volatile("s_waitcnt vmcnt(0)" ::: "memory");
            const unsigned og = xb_add(&bar[XB_TOP], 1u);
            const unsigned tg = og / nx;
            if (og + 1u == (tg + 1u) * nx) xb_add(&bar[XB_TOPGEN], 1u);
            else XB_SPIN(xb_ld(&bar[XB_TOPGEN]) == tg, bar);
            __builtin_amdgcn_fence(__ATOMIC_ACQUIRE, "agent");
            xb_add(&bar[XB_XGEN(b.x)], 1u);
            asm volatile("s_waitcnt vmcnt(0)" ::: "memory");
        } else {
            XB_SPIN(xb_ld(&bar[XB_XGEN(b.x)]) == gen, bar);
            __builtin_amdgcn_fence(__ATOMIC_ACQUIRE, "agent");
            asm volatile("s_waitcnt vmcnt(0)" ::: "memory");
        }
    }
    __syncthreads();
}

struct Frame {
    LAS unsigned char* lds;
    volatile LAS unsigned* MISC;
    gu32* ctl;
    int tid, lane, wave;
    int vcu, G;
    const float *x_prompt, *x_sample, *c, *cache_k, *cache_v, *state0, *c_ctx, *w_ada, *b_ada, *norm_ffn1, *w_ffn1_in, *w_ffn1_out, *norm_mix, *w_mix_in, *w_mix_out,
                *lb_logits, *hgrn_out_norm, *q_norm, *k_norm, *attn_lambda, *attn_subln, *norm_ffn2, *w_ffn2_in, *w_ffn2_out;
    float* out;
    float *mada, *rope, *lbv, *bias2m, *bias2f, *rowss, *hsave; bf16 *W1I, *W1O, *WMI, *WMO, *W2I, *W2O, *ABUF, *ABUF2, *HID, *PROJ, *QB, *KB, *KS, *VTP, *VTS, *OF, *OB;
};

constexpr int CV_FI = (DM / 64) * (NFF / 32), CV_FO = (DFF / 64) * (DM / 32), CV_MI = (DM / 64) * (NMIX / 32), CV_MO = (DM / 64) * (DM / 32);
#ifndef CONV_P9
#define CONV_P9 0
#endif
#ifndef CONV_LATE_P3
#define CONV_LATE_P3 0
#endif
#ifndef CONV_P2TAIL
#define CONV_P2TAIL 1
#endif
constexpr int CV_P0_N = CONV_P2TAIL ? CV_FI : CV_FI + CV_FO + CV_MI;
constexpr int CV_LATE0 = CV_FI + CV_FO + CV_MI, CV_LATE_N = CV_MO + CV_FI + CV_FO;
template <int MODE>
__device__ __forceinline__ void p0_transpose_item(const float* W, int K, int N, bf16* WT, LAS float* scr, int item, int lane) {
    const int nblk = N / 32, kb = item / nblk, nb = item % nblk, k0 = 64 * kb, n0 = 32 * nb;
    int drow0 = n0;
    if (MODE == 1) { const int half = n0 / DFF, r = n0 % DFF; drow0 = (r / 128) * 256 + half * 128 + (r % 128); }
    float tv[32];
    const float* wp = W + (size_t)(k0 + (lane >> 5)) * N + n0 + (lane & 31);
#pragma unroll
    for (int i = 0; i < 32; ++i) tv[i] = __builtin_nontemporal_load(wp + (size_t)(2 * i) * N);
#pragma unroll
    for (int i = 0; i < 32; ++i) scr[(2 * i + (lane >> 5)) * 33 + (lane & 31)] = tv[i];
    LDS_WAIT(); asm volatile("" ::: "memory");
    const int c = lane & 7;
#pragma unroll
    for (int j = 0; j < 4; ++j) { const int n = (lane >> 3) + 8 * j; const LAS float* s = scr + (8 * c) * 33 + n;
        v4u o; o.x = pk2(s[0 * 33], s[1 * 33]); o.y = pk2(s[2 * 33], s[3 * 33]); o.z = pk2(s[4 * 33], s[5 * 33]); o.w = pk2(s[6 * 33], s[7 * 33]);
        *(GAS v4u*)(WT + (size_t)(drow0 + n) * K + k0 + 8 * c) = o; }
    LDS_WAIT(); asm volatile("" ::: "memory");
}

__device__ __forceinline__ void convert_item(Frame& F, LAS float* scr, int it) {
    int r = it;
    if (r < CV_FI) { p0_transpose_item<1>(F.w_ffn1_in, DM, NFF, F.W1I, scr, r, F.lane); return; } r -= CV_FI;
    if (r < CV_FO) { p0_transpose_item<0>(F.w_ffn1_out, DFF, DM, F.W1O, scr, r, F.lane); return; } r -= CV_FO;
    if (r < CV_MI) { p0_transpose_item<0>(F.w_mix_in, DM, NMIX, F.WMI, scr, r, F.lane); return; } r -= CV_MI;
    if (r < CV_MO) { p0_transpose_item<0>(F.w_mix_out, DM, DM, F.WMO, scr, r, F.lane); return; } r -= CV_MO;
    if (r < CV_FI) { p0_transpose_item<1>(F.w_ffn2_in, DM, NFF, F.W2I, scr, r, F.lane); return; } r -= CV_FI;
    p0_transpose_item<0>(F.w_ffn2_out, DFF, DM, F.W2O, scr, r, F.lane);
}
__device__ __forceinline__ void convert_queue(Frame& F, int qword, int first, int n) {
    LAS float* scr = (LAS float*)(F.lds + RING_OFF + F.wave * 16384);
    volatile LAS int* qslot = (volatile LAS int*)(F.lds + MISC_OFF + 64);
    for (;;) {
        if (F.tid == 0) *qslot = (int)__hip_atomic_fetch_add(F.ctl + qword, 1u, RLX_AGENT);
        __syncthreads();
        const int bt = *qslot;
        __syncthreads();
        if (bt * 8 >= n) break;
        { const int it = bt * 8 + F.wave; if (it < n) convert_item(F, scr, first + it); }
    }
}
__device__ __forceinline__ void p0_prologue(Frame& F) {
    if (F.vcu < 144) {
        LAS float* sS = (LAS float*)(F.lds);
        LAS float* red = (LAS float*)(F.lds + 12288);
        for (int i = F.tid; i < 3072; i += NWAVES * 64) { const int cond = i >> 10, k = i & 1023; const float cv = cond == 0 ? F.c_ctx[k] : F.c[(cond - 1) * 1024 + k]; sS[i] = cv * sigmoid_f(cv); }
        __syncthreads();
        const int cb = F.vcu % 36, kq = F.vcu / 36, col = cb * 256 + 4 * F.lane, k0 = kq * 256 + F.wave * 32;
        f32x4 a0 = {0.f, 0.f, 0.f, 0.f}, a1 = a0, a2 = a0;
#pragma unroll
        for (int hb = 0; hb < 2; ++hb) { f32x4 wv[16];
#pragma unroll
            for (int kk = 0; kk < 16; ++kk) wv[kk] = __builtin_nontemporal_load((const f32x4*)(F.w_ada + (size_t)(k0 + hb * 16 + kk) * 9216 + col));
#pragma unroll
            for (int kk = 0; kk < 16; ++kk) { const int k = k0 + hb * 16 + kk; a0 += wv[kk] * sS[k]; a1 += wv[kk] * sS[1024 + k]; a2 += wv[kk] * sS[2048 + k]; } }
        *(LAS f32x4*)(red + (F.wave * 3 + 0) * 256 + 4 * F.lane) = a0; *(LAS f32x4*)(red + (F.wave * 3 + 1) * 256 + 4 * F.lane) = a1; *(LAS f32x4*)(red + (F.wave * 3 + 2) * 256 + 4 * F.lane) = a2;
        __syncthreads();
        for (int o = F.tid; o < 768; o += NWAVES * 64) { const int cond = o >> 8, cc = o & 255; float s = kq == 0 ? F.b_ada[cb * 256 + cc] : 0.f;
#pragma unroll
            for (int w = 0; w < 8; ++w) s += red[(w * 3 + cond) * 256 + cc];
            atomicAdd(F.mada + cond * 9216 + cb * 256 + cc, s); }
        asm volatile("s_waitcnt vmcnt(0)" ::: "memory");
        __syncthreads();
        if (cb < 8 && F.tid == 0) { __builtin_amdgcn_fence(__ATOMIC_RELEASE, "agent"); asm volatile("s_waitcnt vmcnt(0)" ::: "memory"); (void)__hip_atomic_fetch_add(F.ctl + CW_MADA, 1u, RLX_AGENT); }
    }
    if (F.vcu == F.G - 1) { const int k = F.tid; F.lbv[k] = 1.0f / (1.0f + __expf(F.lb_logits[512 + k] - F.lb_logits[k])); }
    { const int gid = (F.vcu * NWAVES + F.wave) * 64 + F.lane;
      if (gid < 1024 * 32) { const int t = gid >> 5, j = gid & 31, i = j & 15; const float pos = (j < 16) ? (float)(t >> 6) : (float)(t & 63);
          const float inv = exp2f(-(float)i * (13.287712379549449f / 16.0f));
          float sn, cs; sincosf(pos * inv, &sn, &cs); F.rope[gid] = cs; F.rope[32768 + gid] = sn; } }
    LAS float* scr = (LAS float*)(F.lds + RING_OFF + F.wave * 16384);
    const int gw = F.vcu * NWAVES + F.wave, NGW = F.G * NWAVES;
#if CONV_MODE == 0
    (void)gw; (void)NGW; (void)scr; convert_queue(F, CW_CONVQ + 128, 0, CV_P0_N);
#else
    for (int it = gw; it < CV_FI; it += NGW) p0_transpose_item<1>(F.w_ffn1_in, DM, NFF, F.W1I, scr, it, F.lane);
#endif
}
__device__ __forceinline__ void wait_mada01(Frame& F) {
    if (F.tid == 0) { unsigned sp = 0;
        while (__hip_atomic_load(F.ctl + CW_MADA, RLX_AGENT) < 32u) { __builtin_amdgcn_s_sleep(2); if (++sp > (1u << 22)) break; }
        __builtin_amdgcn_fence(__ATOMIC_ACQUIRE, "agent"); asm volatile("s_waitcnt vmcnt(0)" ::: "memory"); }
    __syncthreads();
}
__device__ __forceinline__ void norm_mod_phase(Frame& F, const float* src0, const float* src1, const float* nw, int sh_chunk, int sc_chunk) {
    const int xl = (int)blockIdx.x % 8, wl = ((int)blockIdx.x / 8) * NWAVES + F.wave, NWL = (F.G / 8) * NWAVES;
    f32x4 a4[4], h4[4]; int cur = -1;
    for (int rl = wl; rl < M / 8; rl += NWL) { const int row = xl * (M / 8) + rl;
        const float* xr = row < M_P ? src0 + (size_t)row * DM : src1 + (size_t)(row - M_P) * DM;
        const int cond = row < M_P ? 0 : 1 + ((row - M_P) >> 10);
        f32x4 v[4]; float ss = 0.f;
#pragma unroll
        for (int j = 0; j < 4; ++j) { v[j] = ((const GAS f32x4*)xr)[F.lane + 64 * j]; ss += (v[j].x * v[j].x + v[j].y * v[j].y) + (v[j].z * v[j].z + v[j].w * v[j].w); }
        if (cond != cur) { cur = cond; const float* sh = F.mada + cond * 9216 + sh_chunk * 1024; const float* sc = F.mada + cond * 9216 + sc_chunk * 1024;
#pragma unroll
            for (int j = 0; j < 4; ++j) { const int q = F.lane + 64 * j; a4[j] = ((const GAS f32x4*)nw)[q] * (((const GAS f32x4*)sc)[q] + 1.0f); h4[j] = ((const GAS f32x4*)sh)[q]; } }
        const float rstd = 1.0f / sqrtf(wave_sum(ss) * (1.0f / DM) + EPS);
        GAS v2u* o8 = (GAS v2u*)(F.ABUF + (size_t)row * DM);
#pragma unroll
        for (int j = 0; j < 4; ++j) { const int q = F.lane + 64 * j; const f32x4 o = v[j] * rstd * a4[j] + h4[j]; v2u w; w.x = pk2(o.x, o.y); w.y = pk2(o.z, o.w); o8[q] = w; }
    }
}

__device__ __forceinline__ void bias2_rows(Frame& F, const bf16* Wt, int N, int sh_chunk, float* dst) {
    const int gw = F.vcu * NWAVES + F.wave, NGW = F.G * NWAVES, lane = F.lane;
    float sh[3][16];
#pragma unroll
    for (int c = 0; c < 3; ++c)
#pragma unroll
        for (int j = 0; j < 16; ++j) sh[c][j] = F.mada[c * 9216 + sh_chunk * 1024 + (j < 8 ? 8 * lane + j : 512 + 8 * lane + (j - 8))];
    for (int n = gw; n < N; n += NGW) {
        const v4u w0 = *(const GAS v4u*)(Wt + (size_t)n * DM + 8 * lane), w1 = *(const GAS v4u*)(Wt + (size_t)n * DM + 512 + 8 * lane);
        const float wv[16] = {bflo(w0.x), bfhi(w0.x), bflo(w0.y), bfhi(w0.y), bflo(w0.z), bfhi(w0.z), bflo(w0.w), bfhi(w0.w), bflo(w1.x), bfhi(w1.x), bflo(w1.y), bfhi(w1.y), bflo(w1.z), bfhi(w1.z), bflo(w1.w), bfhi(w1.w)};
        float a0 = 0.f, a1 = 0.f, a2 = 0.f;
#pragma unroll
        for (int j = 0; j < 16; ++j) { a0 += wv[j] * sh[0][j]; a1 += wv[j] * sh[1][j]; a2 += wv[j] * sh[2][j]; }
        a0 = wave_sum(a0); a1 = wave_sum(a1); a2 = wave_sum(a2);
        if (lane == 0) { dst[n] = a0; dst[N + n] = a1; dst[2 * N + n] = a2; }
    }
}

constexpr int N_HEADWG = NB_S * 4 * 2, HG_HEAD = 6;
template <bool SRC_F32>
__device__ __forceinline__ void vt_item(const void* src, size_t src_pitch  , bf16* dst, size_t dst_pitch, LAS unsigned short* scr, int lane) {
#pragma unroll
    for (int i = 0; i < 8; ++i) { const int id = i * 64 + lane, r = id >> 3, ch = id & 7; v4u w;
        if (SRC_F32) { const float* p = (const float*)src + (size_t)r * src_pitch + ch * 8; const f32x4 a = *(const GAS f32x4*)p, b = *(const GAS f32x4*)(p + 4);
            w.x = pk2(a.x, a.y); w.y = pk2(a.z, a.w); w.z = pk2(b.x, b.y); w.w = pk2(b.z, b.w); }
        else w = *(const GAS v4u*)((const bf16*)src + (size_t)r * src_pitch + ch * 8);
        *(LAS v4u*)(scr + r * 72 + ch * 8) = w; }
    LDS_WAIT(); asm volatile("" ::: "memory");
#pragma unroll
    for (int i = 0; i < 8; ++i) { const int id = i * 64 + lane, c = id >> 3, rc = id & 7; const LAS unsigned short* s = scr + (rc * 8) * 72 + c; v4u w;
        w.x = (unsigned)s[0] | ((unsigned)s[72] << 16); w.y = (unsigned)s[2 * 72] | ((unsigned)s[3 * 72] << 16); w.z = (unsigned)s[4 * 72] | ((unsigned)s[5 * 72] << 16); w.w = (unsigned)s[6 * 72] | ((unsigned)s[7 * 72] << 16);
        *(GAS v4u*)(dst + (size_t)c * dst_pitch + rc * 8) = w; }
    LDS_WAIT(); asm volatile("" ::: "memory");
}

__device__ __forceinline__ void p6a_prep(Frame& F) {
    const int gw = ((int)blockIdx.x - N_HEADWG) * NWAVES + F.wave, NGW = (F.G - N_HEADWG) * NWAVES, lane = F.lane;
    const int d0 = 8 * (lane & 7);
    float qw[8], kw[8];
#pragma unroll
    for (int j = 0; j < 8; ++j) { qw[j] = F.q_norm[d0 + j]; kw[j] = F.k_norm[d0 + j]; }
    for (int row = gw; row < M; row += NGW) {
        const bf16* pr = F.PROJ + (size_t)row * NMIX;
        const v4u qa = *(const GAS v4u*)(pr + PC_AQ + 8 * lane), ka = *(const GAS v4u*)(pr + PC_AK + 8 * lane);
        float q[8] = {bflo(qa.x), bfhi(qa.x), bflo(qa.y), bfhi(qa.y), bflo(qa.z), bfhi(qa.z), bflo(qa.w), bfhi(qa.w)};
        float k[8] = {bflo(ka.x), bfhi(ka.x), bflo(ka.y), bfhi(ka.y), bflo(ka.z), bfhi(ka.z), bflo(ka.w), bfhi(ka.w)};
        float sq = 0.f, sk = 0.f;
#pragma unroll
        for (int j = 0; j < 8; ++j) { sq += q[j] * q[j]; sk += k[j] * k[j]; }
        sq += __shfl_xor(sq, 1); sq += __shfl_xor(sq, 2); sq += __shfl_xor(sq, 4);
        sk += __shfl_xor(sk, 1); sk += __shfl_xor(sk, 2); sk += __shfl_xor(sk, 4);
        const float rq = 1.0f / sqrtf(sq * (1.0f / 64.0f) + EPS), rk = 1.0f / sqrtf(sk * (1.0f / 64.0f) + EPS);
#pragma unroll
        for (int j = 0; j < 8; ++j) { q[j] = q[j] * rq * qw[j]; k[j] = k[j] * rk * kw[j]; }
        if (row < M_P) {
            float* ok = F.out + OUT_K + (size_t)row * 512 + 8 * lane;
            *(GAS f32x4*)ok = (f32x4){k[0], k[1], k[2], k[3]}; *(GAS f32x4*)(ok + 4) = (f32x4){k[4], k[5], k[6], k[7]};
            v4u w; w.x = pk2(k[0], k[1]); w.y = pk2(k[2], k[3]); w.z = pk2(k[4], k[5]); w.w = pk2(k[6], k[7]);
            *(GAS v4u*)(F.KB + (size_t)row * 512 + 8 * lane) = w;
        } else {
            const int rs = row - M_P, b = rs >> 10, t = rs & 1023, g8 = lane & 7;
            const bool first = (g8 & 2) == 0; const int tc = ((g8 >= 4) ? 16 : 0) + 8 * (g8 & 1);
            const float* cs = F.rope + t * 32 + tc; const float* sn = F.rope + 32768 + t * 32 + tc;
#pragma unroll
            for (int j = 0; j < 8; ++j) { const float c = cs[j], s = sn[j]; const float pq = __shfl_xor(q[j], 2), pk = __shfl_xor(k[j], 2);
                q[j] = first ? q[j] * c - pq * s : q[j] * c + pq * s; k[j] = first ? k[j] * c - pk * s : k[j] * c + pk * s; }
            v4u w; w.x = pk2(k[0], k[1]); w.y = pk2(k[2], k[3]); w.z = pk2(k[4], k[5]); w.w = pk2(k[6], k[7]);
            *(GAS v4u*)(F.KS + ((size_t)b * TK_S + PAST + t) * 512 + 8 * lane) = w;
        }
        v4u w; w.x = pk2(q[0] * QSCALE, q[1] * QSCALE); w.y = pk2(q[2] * QSCALE, q[3] * QSCALE); w.z = pk2(q[4] * QSCALE, q[5] * QSCALE); w.w = pk2(q[6] * QSCALE, q[7] * QSCALE);
        *(GAS v4u*)(F.QB + (size_t)row * 512 + 8 * lane) = w;
    }
    for (int r = gw; r < NB_S * PAST; r += NGW) { const int b = r >> 9, j = r & 511; const float* p = F.cache_k + (size_t)r * 512 + 8 * lane;
        const f32x4 a = *(const GAS f32x4*)p, bb = *(const GAS f32x4*)(p + 4); v4u w; w.x = pk2(a.x, a.y); w.y = pk2(a.z, a.w); w.z = pk2(bb.x, bb.y); w.w = pk2(bb.z, bb.w);
        *(GAS v4u*)(F.KS + ((size_t)b * TK_S + j) * 512 + 8 * lane) = w; }
    LAS unsigned short* scr = (LAS unsigned short*)(F.lds + RING_OFF + F.wave * 16384);
    constexpr int IT_P = NB_P * 4 * 4 * 2, IT_SL = NB_S * 4 * 16 * 2, IT_SC = NB_S * 4 * 8 * 2;
    for (int it = gw; it < IT_P + IT_SL + IT_SC; it += NGW) {
        if (it < IT_P) { const int bh = it >> 3, tb = (it >> 1) & 3, db = it & 1, b = bh >> 2, h = bh & 3;
            vt_item<false>(F.PROJ + ((size_t)b * T_P + tb * 64) * NMIX + PC_AV + h * 128 + db * 64, NMIX, F.VTP + ((size_t)bh * 128 + db * 64) * T_P + tb * 64, T_P, scr, lane); }
        else if (it < IT_P + IT_SL) { const int r = it - IT_P, bh = r >> 5, tb = (r >> 1) & 15, db = r & 1, b = bh >> 2, h = bh & 3;
            vt_item<false>(F.PROJ + ((size_t)M_P + b * T_S + tb * 64) * NMIX + PC_AV + h * 128 + db * 64, NMIX, F.VTS + ((size_t)bh * 128 + db * 64) * TK_S + PAST + tb * 64, TK_S, scr, lane); }
        else { const int r = it - IT_P - IT_SL, bh = r >> 4, tb = (r >> 1) & 7, db = r & 1, b = bh >> 2, h = bh & 3;
            vt_item<true>(F.cache_v + ((size_t)b * PAST + tb * 64) * 512 + h * 128 + db * 64, 512, F.VTS + ((size_t)bh * 128 + db * 64) * TK_S + tb * 64, TK_S, scr, lane); }
    }
}

constexpr int HG_QT = 0, HG_KT = 8192, HG_KH = 16384, HG_VT = 24576, HG_PE = 32768, HG_BUF = 33792, HG_GT = 2 * HG_BUF, HG_GTB = 4096;
#define MFMA16(a, b, c) __builtin_amdgcn_mfma_f32_16x16x32_bf16(a, b, c, 0, 0, 0)
__device__ __forceinline__ void hgrn_unit(Frame& F, int row_base, int T, int h, int dir, const float* s0, float* sfin, bf16* obuf, int c_begin, int c_end) {
    LAS unsigned char* L = F.lds;
    int tid_ = F.tid; asm volatile("" : "+v"(tid_));
    const int tid = tid_, lane = tid & 63, w = F.wave, r = lane & 15, g = lane >> 4, kp = tid & 63, tg = w;
    f32x4 S[8];
#pragma unroll
    for (int t8 = 0; t8 < 8; ++t8)
#pragma unroll
        for (int i = 0; i < 4; ++i) S[t8][i] = s0 ? s0[(size_t)(16 * t8 + 4 * g + i) * 128 + 16 * w + r] : 0.f;
    const int cq = PC_Q + h * 128 + 2 * kp, cf = (dir == 0 ? PC_FF : PC_FB) + h * 128 + 2 * kp, ci = PC_I + h * 128 + 2 * kp;
    unsigned rq[4], rx[4], rv[4];
    const int tsgn = dir == 0 ? 1 : -1, tbase = dir == 0 ? 0 : T - 1;
    const int nch = c_end;
#define HG_L(c_) do { const int cc_ = (c_) < nch ? (c_) : nch - 1;     \
        _Pragma("unroll") for (int i = 0; i < 4; ++i) { const int tt = 32 * cc_ + 4 * tg + i, ta = tbase + tsgn * tt; const bf16* pr = F.PROJ + (size_t)(row_base + ta) * NMIX; \
        rq[i] = *(const GAS unsigned*)(pr + cq); rx[i] = *(const GAS unsigned*)(pr + cf); rv[i] = *(const GAS unsigned*)(pr + ci); } } while (0)
#define HG_P1(c_) do { { float acc0 = 0.f, acc1 = 0.f; \
        _Pragma("unroll") for (int i = 0; i < 4; ++i) { const h2_t lf = __builtin_bit_cast(h2_t, rx[i]); acc0 += (float)lf[0]; acc1 += (float)lf[1]; } \
        *(LAS f32x2*)(L + HG_GT + ((c_) & 1) * HG_GTB + (tg * 128 + 2 * kp) * 4) = (f32x2){acc0, acc1}; } } while (0)
#define HG_P2(c_) do { { LAS unsigned char* Lb = L + ((c_) & 1) * HG_BUF; const LAS unsigned char* Gt = L + HG_GT + ((c_) & 1) * HG_GTB; f32x2 off = {0.f, 0.f}, be = {0.f, 0.f}; \
        _Pragma("unroll") for (int g2 = 0; g2 < 8; ++g2) { const f32x2 v2 = *(const LAS f32x2*)(Gt + (g2 * 128 + 2 * kp) * 4); if (g2 < tg) off += v2; be += v2; } \
        float kh[2][4]; float b0 = off.x, b1 = off.y; \
        _Pragma("unroll") for (int i = 0; i < 4; ++i) { const int t = 4 * tg + i; const h2_t lf = __builtin_bit_cast(h2_t, rx[i]); const float l0 = (float)lf[0], l1 = (float)lf[1]; b0 += l0; b1 += l1; \
            const float B0 = fmaxf(b0, -80.f), B1 = fmaxf(b1, -80.f); \
            const float qt0 = bflo(rq[i]) * __expf(B0), qt1 = bfhi(rq[i]) * __expf(B1), kt0 = (1.0f - __expf(l0)) * __expf(-B0), kt1 = (1.0f - __expf(l1)) * __expf(-B1); kh[0][i] = kt0; kh[1][i] = kt1; \
            const int a = t * 256 + ((((kp >> 2) ^ (t & 15))) << 4) + (kp & 3) * 4; \
            *(LAS unsigned*)(Lb + HG_QT + a) = pk2(qt0, qt1); *(LAS unsigned*)(Lb + HG_KT + a) = pk2(kt0, kt1); } \
        _Pragma("unroll") for (int e = 0; e < 2; ++e) { const int k = 2 * kp + e; const int a = (((k >> 4) * 4 + (tg >> 1)) * 16 + (k & 15)) * 16 + 8 * (tg & 1); \
            *(LAS v2u*)(Lb + HG_KH + a) = (v2u){pk2(kh[e][0], kh[e][1]), pk2(kh[e][2], kh[e][3])}; \
            v2u vw; if (e == 0) { vw.x = (rv[0] & 0xffffu) | (rv[1] << 16); vw.y = (rv[2] & 0xffffu) | (rv[3] << 16); } else { vw.x = (rv[0] >> 16) | (rv[1] & 0xffff0000u); vw.y = (rv[2] >> 16) | (rv[3] & 0xffff0000u); } \
            *(LAS v2u*)(Lb + HG_VT + a) = vw; } \
        if (tg == 0) *(LAS f32x2*)(Lb + HG_PE + 2 * kp * 4) = (f32x2){__expf(be.x), __expf(be.y)}; } } while (0)
    HG_L(c_begin);
    for (int c = c_begin; c < nch; ++c) {
        HG_P1(c);
        LDS_BARRIER();
        HG_P2(c); HG_L(c + 1);
        LDS_BARRIER();
        const LAS unsigned char* Lb = L + (c & 1) * HG_BUF;
        f32x4 d00 = {0.f, 0.f, 0.f, 0.f}, d01 = d00, d11 = d00;
#pragma unroll
        for (int ks = 0; ks < 4; ++ks) { const int co = (((4 * ks + g) ^ r) << 4);
            const bf16x8 kt0 = *(const LAS bf16x8*)(Lb + HG_KT + r * 256 + co), kt1 = *(const LAS bf16x8*)(Lb + HG_KT + (16 + r) * 256 + co);
            const bf16x8 qt0 = *(const LAS bf16x8*)(Lb + HG_QT + r * 256 + co), qt1 = *(const LAS bf16x8*)(Lb + HG_QT + (16 + r) * 256 + co);
            d00 = MFMA16(kt0, qt0, d00); d01 = MFMA16(kt0, qt1, d01); d11 = MFMA16(kt1, qt1, d11); }
        asm volatile("" ::: "memory");
#pragma unroll
        for (int i = 0; i < 4; ++i) if (4 * g + i > r) { d00[i] = 0.f; d11[i] = 0.f; }
        const v4u a0w = {pk2(d00[0], d00[1]), pk2(d00[2], d00[3]), 0u, 0u}, a1w = {pk2(d01[0], d01[1]), pk2(d01[2], d01[3]), pk2(d11[0], d11[1]), pk2(d11[2], d11[3])};
        const v2u vpl = *(const LAS v2u*)(Lb + HG_VT + ((w * 4 + (g >> 1)) * 16 + r) * 16 + 8 * (g & 1)), vph = *(const LAS v2u*)(Lb + HG_VT + ((w * 4 + 2 + (g >> 1)) * 16 + r) * 16 + 8 * (g & 1));
        const bf16x8 vperm = __builtin_bit_cast(bf16x8, (v4u){vpl.x, vpl.y, vph.x, vph.y});
        const bf16x8 vnat = *(const LAS bf16x8*)(Lb + HG_VT + ((w * 4 + g) * 16 + r) * 16);
        f32x4 o0 = MFMA16(__builtin_bit_cast(bf16x8, a0w), vperm, ((f32x4){0.f, 0.f, 0.f, 0.f})), o1 = MFMA16(__builtin_bit_cast(bf16x8, a1w), vperm, ((f32x4){0.f, 0.f, 0.f, 0.f}));
        asm volatile("" ::: "memory");
#pragma unroll
        for (int kk = 0; kk < 4; ++kk) {
            const v4u sw = {pk2(S[2 * kk][0], S[2 * kk][1]), pk2(S[2 * kk][2], S[2 * kk][3]), pk2(S[2 * kk + 1][0], S[2 * kk + 1][1]), pk2(S[2 * kk + 1][2], S[2 * kk + 1][3])};
            const int c_lo = (((4 * kk + (g >> 1)) ^ r) << 4) + 8 * (g & 1), c_hi = (((4 * kk + 2 + (g >> 1)) ^ r) << 4) + 8 * (g & 1);
            const v2u p0l = *(const LAS v2u*)(Lb + HG_QT + r * 256 + c_lo), p0h = *(const LAS v2u*)(Lb + HG_QT + r * 256 + c_hi);
            const v2u p1l = *(const LAS v2u*)(Lb + HG_QT + (16 + r) * 256 + c_lo), p1h = *(const LAS v2u*)(Lb + HG_QT + (16 + r) * 256 + c_hi);
            o0 = MFMA16(__builtin_bit_cast(bf16x8, (v4u){p0l.x, p0l.y, p0h.x, p0h.y}), __builtin_bit_cast(bf16x8, sw), o0);
            o1 = MFMA16(__builtin_bit_cast(bf16x8, (v4u){p1l.x, p1l.y, p1h.x, p1h.y}), __builtin_bit_cast(bf16x8, sw), o1); }
#pragma unroll
        for (int i = 0; i < 4; ++i) { const int t0 = 32 * c + 4 * g + i, t1 = t0 + 16, ta0 = tbase + tsgn * t0, ta1 = tbase + tsgn * t1;
            obuf[(size_t)(row_base + ta0) * 512 + h * 128 + 16 * w + r] = (bf16)(pk2(o0[i], 0.f) & 0xffffu); obuf[(size_t)(row_base + ta1) * 512 + h * 128 + 16 * w + r] = (bf16)(pk2(o1[i], 0.f) & 0xffffu); }
#pragma unroll
        for (int t8 = 0; t8 < 8; ++t8) { const bf16x8 khf = *(const LAS bf16x8*)(Lb + HG_KH + ((t8 * 4 + g) * 16 + r) * 16); const f32x4 pe = *(const LAS f32x4*)(Lb + HG_PE + (16 * t8 + 4 * g) * 4);
            S[t8] = MFMA16(khf, vnat, S[t8]) * pe; }
    }
#undef HG_L
#undef HG_P1
#undef HG_P2
    if (sfin) {
#pragma unroll
        for (int t8 = 0; t8 < 8; ++t8)
#pragma unroll
            for (int i = 0; i < 4; ++i) sfin[(size_t)(16 * t8 + 4 * g + i) * 128 + 16 * w + r] = S[t8][i];
    }
    __syncthreads();
}

__device__ __forceinline__ void p6_phase(Frame& F) {
    if ((int)blockIdx.x < N_HEADWG) { const int v = (int)blockIdx.x, dir = v & 1, h = (v >> 1) & 3, b = v >> 3;
        hgrn_unit(F, M_P + b * T_S, T_S, h, dir, F.state0 + ((size_t)(b * 2 + dir) * 4 + h) * 16384, F.hsave + (size_t)v * 16384, dir == 0 ? F.OF : F.OB, 0, HG_HEAD); }
    else p6a_prep(F);
}

__device__ __forceinline__ int crow(int r, int hi) { return (r & 3) + 8 * (r >> 2) + 4 * hi; }
constexpr int AT_K = 0, AT_V = 16384, AT_STAGE = 16384 + 128 * 136, XCH_SLOT = 64 * 64 * 4;
__device__ __forceinline__ void attn_finish(Frame& F, const f32x16 (&o)[4], const LAS float* slot, float lam, int row0, int h, int lane) {
    const int r32 = lane & 31, hi = lane >> 5;
    f32x16 d[4]; float ss = 0.f;
#pragma unroll
    for (int dv = 0; dv < 4; ++dv)
#pragma unroll
        for (int r = 0; r < 16; ++r) { const float x = o[dv][r] - lam * slot[(dv * 16 + r) * 64 + lane]; d[dv][r] = x; ss += x * x; }
    ss += __shfl_xor(ss, 32);
    const float rstd = (1.0f - LAM_INIT) / sqrtf(ss * (1.0f / 128.0f) + EPS);
    bf16* orow = F.ABUF2 + (size_t)(row0 + r32) * DM + 512 + h * 128;
#pragma unroll
    for (int dv = 0; dv < 4; ++dv)
#pragma unroll
        for (int g = 0; g < 4; ++g) { const int c = 32 * dv + 8 * g + 4 * hi; const f32x4 w4 = *(const GAS f32x4*)(F.attn_subln + c);
            v2u w; w.x = pk2(d[dv][4 * g] * rstd * w4.x, d[dv][4 * g + 1] * rstd * w4.y); w.y = pk2(d[dv][4 * g + 2] * rstd * w4.z, d[dv][4 * g + 3] * rstd * w4.w);
            *(GAS v2u*)(orow + c) = w; }
}
__device__ __forceinline__ float attn_lam(Frame& F) {
    const float a = F.attn_lambda[F.lane] * F.attn_lambda[64 + F.lane], b = F.attn_lambda[128 + F.lane] * F.attn_lambda[192 + F.lane];
    return __expf(wave_sum(a)) - __expf(wave_sum(b)) + LAM_INIT;
}
__device__ __forceinline__ void attn_unit(Frame& F, const bf16* Kb, const bf16* VTb, int TK, int row0, int h) {
    LAS unsigned char* L = F.lds;
    int tid_ = F.tid; asm volatile("" : "+v"(tid_));
    const int tid = tid_, w = F.wave, lane = tid & 63, mp = w >> 2, qb = w & 3, r32 = lane & 31, hi = lane >> 5;
    const float lam = attn_lam(F);
    bf16x8 qf[4];
    { const bf16* Qp = F.QB + (size_t)(row0 + 32 * qb + r32) * 512 + h * 128 + mp * 64 + 8 * hi;
#pragma unroll
      for (int s = 0; s < 4; ++s) qf[s] = *(const GAS bf16x8*)(Qp + 16 * s); }
    f32x16 o[4];
#pragma unroll
    for (int d = 0; d < 4; ++d) o[d] = f32x16{};
    float m_run = -1e30f, l_run = 0.f;
    v4u kreg[2], vreg[2];
    const int krow0 = tid >> 4, kch = tid & 15, vrow0 = tid >> 3, vch = tid & 7;
#define AT_LOAD(kv0_) do { _Pragma("unroll") for (int i = 0; i < 2; ++i) { kreg[i] = *(const GAS v4u*)(Kb + (size_t)((kv0_) + krow0 + 32 * i) * 512 + h * 128 + kch * 8); \
        vreg[i] = *(const GAS v4u*)(VTb + (size_t)(vrow0 + 64 * i) * TK + (kv0_) + vch * 8); } } while (0)
#define AT_WRITE(st_) do { LAS unsigned char* Ls_ = L + (st_) * AT_STAGE; _Pragma("unroll") for (int i = 0; i < 2; ++i) { const int kr = krow0 + 32 * i, vr = vrow0 + 64 * i; \
        *(LAS v4u*)(Ls_ + AT_K + kr * 256 + ((kch ^ (kr & 15)) << 4)) = kreg[i]; \
        *(LAS v2u*)(Ls_ + AT_V + vr * 136 + vch * 16) = (v2u){vreg[i].x, vreg[i].y}; *(LAS v2u*)(Ls_ + AT_V + vr * 136 + vch * 16 + 8) = (v2u){vreg[i].z, vreg[i].w}; } } while (0)
    const int ntiles = TK >> 6;
    AT_LOAD(0); AT_WRITE(0);
    __syncthreads();
    for (int t = 0; t < ntiles; ++t) {
        if (t + 1 < ntiles) AT_LOAD((t + 1) * 64);
        const LAS unsigned char* Ls = L + (t & 1) * AT_STAGE;
#pragma unroll
        for (int j = 0; j < 2; ++j) {
            f32x16 p = f32x16{};
            __builtin_amdgcn_s_setprio(1);
#pragma unroll
            for (int s = 0; s < 4; ++s) { const bf16x8 kf = *(const LAS bf16x8*)(Ls + AT_K + (32 * j + r32) * 256 + (((mp * 8 + 2 * s + hi) ^ (r32 & 15)) << 4));
                p = __builtin_amdgcn_mfma_f32_32x32x16_bf16(kf, qf[s], p, 0, 0, 0); }
            __builtin_amdgcn_s_setprio(0);
            float mx = p[0];
#pragma unroll
            for (int r = 1; r < 16; ++r) mx = fmaxf(mx, p[r]);
            mx = fmaxf(mx, __shfl_xor(mx, 32));
            const float mnew = (mx > m_run + 8.0f) ? mx : m_run, alpha = __builtin_amdgcn_exp2f(m_run - mnew); m_run = mnew;
            float ls = 0.f;
#pragma unroll
            for (int r = 0; r < 16; ++r) { p[r] = __builtin_amdgcn_exp2f(p[r] - mnew); ls += p[r]; }
            l_run = l_run * alpha + ls;
            if (__any(alpha != 1.0f)) {
#pragma unroll
                for (int d = 0; d < 4; ++d)
#pragma unroll
                    for (int r = 0; r < 16; ++r) o[d][r] *= alpha; }
            __builtin_amdgcn_s_setprio(1);
#pragma unroll
            for (int s = 0; s < 2; ++s) { const v4u pw = {pk2(p[8 * s + 0], p[8 * s + 1]), pk2(p[8 * s + 2], p[8 * s + 3]), pk2(p[8 * s + 4], p[8 * s + 5]), pk2(p[8 * s + 6], p[8 * s + 7])};
#pragma unroll
                for (int d = 0; d < 4; ++d) { const LAS unsigned char* vp = Ls + AT_V + (32 * d + r32) * 136 + (32 * j + 16 * s + 4 * hi) * 2;
                    const v2u lo = *(const LAS v2u*)vp, hh = *(const LAS v2u*)(vp + 16);
                    o[d] = __builtin_amdgcn_mfma_f32_32x32x16_bf16(__builtin_bit_cast(bf16x8, (v4u){lo.x, lo.y, hh.x, hh.y}), __builtin_bit_cast(bf16x8, pw), o[d], 0, 0, 0); } }
            __builtin_amdgcn_s_setprio(0);
        }
        if (t + 1 < ntiles) AT_WRITE((t + 1) & 1);
        __syncthreads();
    }
#undef AT_LOAD
#undef AT_WRITE
    const float inv = 1.0f / (l_run + __shfl_xor(l_run, 32));
#pragma unroll
    for (int d = 0; d < 4; ++d)
#pragma unroll
        for (int r = 0; r < 16; ++r) o[d][r] *= inv;
    LAS float* slot = (LAS float*)(L + qb * XCH_SLOT);
    if (mp == 1) {
#pragma unroll
        for (int d = 0; d < 4; ++d)
#pragma unroll
            for (int r = 0; r < 16; ++r) slot[(d * 16 + r) * 64 + lane] = o[d][r];
    }
    __syncthreads();
    if (mp == 0) attn_finish(F, o, slot, lam, row0 + 32 * qb, h, lane);
    __syncthreads();
}

__device__ __forceinline__ void p6b_mixers(Frame& F, int qrun) {
    constexpr int N_HS = NB_S * 4 * 2, N_AS = NB_S * 4 * 8, N_HP = NB_P * 4 * 2, N_AP = NB_P * 4 * 2, N_ALL = N_HS + N_AS + N_HP + N_AP, N_CV = CONV_LATE_P3 ? 0 : (CONV_P9 ? CV_MO / 16 : CV_LATE_N / 16);
    volatile LAS int* qslot = (volatile LAS int*)(F.lds + MISC_OFF + 64);
    for (;;) {
        if (F.tid == 0) *qslot = (int)__hip_atomic_fetch_add(F.ctl + CW_QUEUE + 64 * qrun, 1u, RLX_AGENT);
        __syncthreads();
        int u = *qslot;
        __syncthreads();
        if (u >= N_ALL + N_CV) break;
        if (u >= N_ALL) {
            LAS float* scr = (LAS float*)(F.lds + RING_OFF + F.wave * 16384);
            for (int j = 0; j < 2; ++j) convert_item(F, scr, CV_LATE0 + (u - N_ALL) * 16 + F.wave * 2 + j);
            __syncthreads(); continue; }
#ifdef PROBE_SUB
        if (qrun) { const int cls = u < N_HS ? 0 : u < N_HS + N_AS ? 1 : u < N_HS + N_AS + N_HP ? 2 : 3; if (!((PROBE_SUB >> cls) & 1)) continue; }
#endif
        const bool is_hs = u < N_HS, is_as = !is_hs && u < N_HS + N_AS, is_hp = !is_hs && !is_as && u < N_HS + N_AS + N_HP;
        if (is_hs || is_hp) { const int v = is_hs ? u : u - N_HS - N_AS; const int dir = v & 1, h = (v >> 1) & 3, b = v >> 3;
            hgrn_unit(F, is_hs ? M_P + b * T_S : b * T_P, is_hs ? T_S : T_P, h, dir, is_hs ? F.hsave + (size_t)v * 16384 : nullptr,
                      (is_hs || qrun) ? nullptr : F.out + OUT_S + ((size_t)(b * 2 + dir) * 4 + h) * 16384, dir == 0 ? F.OF : F.OB, is_hs ? HG_HEAD : 0, is_hs ? T_S / 32 : T_P / 32); continue; }
        { const int v = is_as ? u - N_HS : u - N_HS - N_AS - N_HP;
          const int h = is_as ? (v >> 3) & 3 : (v >> 1) & 3, b = is_as ? v >> 5 : v >> 3, qo = is_as ? (v & 7) * 128 : (v & 1) * 128;
          attn_unit(F, is_as ? F.KS + (size_t)b * TK_S * 512 : F.KB + (size_t)b * T_P * 512, is_as ? F.VTS + (size_t)(b * 4 + h) * 128 * TK_S : F.VTP + (size_t)(b * 4 + h) * 128 * T_P,
                    is_as ? TK_S : T_P, (is_as ? M_P + b * T_S : b * T_P) + qo, h); }
    }
}

__device__ __forceinline__ void p7_combine(Frame& F) {
    const int lane = F.lane, xl = (int)blockIdx.x % 8, wl = ((int)blockIdx.x / 8) * NWAVES + F.wave, NWL = (F.G / 8) * NWAVES;
    float nw[8];
#pragma unroll
    for (int j = 0; j < 8; ++j) nw[j] = F.hgrn_out_norm[(8 * lane + j) & 127];
    for (int rl = wl; rl < M / 8; rl += NWL) { const int row = xl * (M / 8) + rl;
        const v4u fa = *(const GAS v4u*)(F.OF + (size_t)row * 512 + 8 * lane), ba = *(const GAS v4u*)(F.OB + (size_t)row * 512 + 8 * lane);
        const float o[8] = {bflo(fa.x) + bflo(ba.x), bfhi(fa.x) + bfhi(ba.x), bflo(fa.y) + bflo(ba.y), bfhi(fa.y) + bfhi(ba.y), bflo(fa.z) + bflo(ba.z), bfhi(fa.z) + bfhi(ba.z), bflo(fa.w) + bflo(ba.w), bfhi(fa.w) + bfhi(ba.w)};
        float ss = 0.f;
#pragma unroll
        for (int j = 0; j < 8; ++j) ss += o[j] * o[j];
        ss += __shfl_xor(ss, 1); ss += __shfl_xor(ss, 2); ss += __shfl_xor(ss, 4); ss += __shfl_xor(ss, 8);
        const float rstd = 1.0f / sqrtf(ss * (1.0f / 128.0f) + EPS);
        const v4u ga = *(const GAS v4u*)(F.PROJ + (size_t)row * NMIX + PC_G + 8 * lane);
        const float g[8] = {bflo(ga.x), bfhi(ga.x), bflo(ga.y), bfhi(ga.y), bflo(ga.z), bfhi(ga.z), bflo(ga.w), bfhi(ga.w)};
        float y[8];
#pragma unroll
        for (int j = 0; j < 8; ++j) y[j] = o[j] * rstd * nw[j] * (g[j] * sigmoid_f(g[j]));
        v4u w; w.x = pk2(y[0], y[1]); w.y = pk2(y[2], y[3]); w.z = pk2(y[4], y[5]); w.w = pk2(y[6], y[7]);
        *(GAS v4u*)(F.ABUF2 + (size_t)row * DM + 8 * lane) = w;
    }
}

struct Args { const float* in[24]; float* out; unsigned char* ws; int ph_lo, ph_hi, use_bar, pad; };
__global__ void __launch_bounds__(NWAVES * 64, 2) hymba_fwd(Args args) {
    extern __shared__ __attribute__((aligned(16))) unsigned char lds[];
    Frame F;
    F.lds = (LAS unsigned char*)lds;
    F.MISC = (volatile LAS unsigned*)(F.lds + MISC_OFF);
    F.tid = threadIdx.x; F.lane = F.tid & 63; F.wave = __builtin_amdgcn_readfirstlane(F.tid >> 6);
    F.G = gridDim.x; { const int bx = blockIdx.x; F.vcu = (F.G % 8 == 0) ? (bx % 8) * (F.G / 8) + bx / 8 : bx; }
    unsigned char* ws = args.ws;
    F.ctl = (gu32*)(ws + WS_CTL);
    F.x_prompt = args.in[0]; F.x_sample = args.in[1]; F.c = args.in[2]; F.cache_k = args.in[3]; F.cache_v = args.in[4]; F.state0 = args.in[5]; F.c_ctx = args.in[6];
    F.w_ada = args.in[7]; F.b_ada = args.in[8]; F.norm_ffn1 = args.in[9]; F.w_ffn1_in = args.in[10]; F.w_ffn1_out = args.in[11]; F.norm_mix = args.in[12]; F.w_mix_in = args.in[13]; F.w_mix_out = args.in[14];
    F.lb_logits = args.in[15]; F.hgrn_out_norm = args.in[16]; F.q_norm = args.in[17]; F.k_norm = args.in[18]; F.attn_lambda = args.in[19]; F.attn_subln = args.in[20]; F.norm_ffn2 = args.in[21];
    F.w_ffn2_in = args.in[22]; F.w_ffn2_out = args.in[23]; F.out = args.out;
    F.mada = (float*)(ws + WS_MADA); F.rope = (float*)(ws + WS_ROPE); F.lbv = (float*)(ws + WS_LB);
    F.W1I = (bf16*)(ws + WS_W1I); F.W1O = (bf16*)(ws + WS_W1O); F.WMI = (bf16*)(ws + WS_WMI); F.WMO = (bf16*)(ws + WS_WMO); F.W2I = (bf16*)(ws + WS_W2I); F.W2O = (bf16*)(ws + WS_W2O);
    F.ABUF = (bf16*)(ws + WS_ABUF); F.ABUF2 = (bf16*)(ws + WS_ABUF2); F.rowss = (float*)(ws + WS_ROWSS); F.bias2m = (float*)(ws + WS_BIAS2); F.bias2f = F.bias2m + 3 * 4096; F.hsave = (float*)(ws + WS_HSAVE); F.HID = (bf16*)(ws + WS_BIG); F.PROJ = (bf16*)(ws + WS_BIG); F.QB = (bf16*)(ws + WS_QB); F.KB = (bf16*)(ws + WS_KB); F.KS = (bf16*)(ws + WS_KS);
    F.VTP = (bf16*)(ws + WS_VTP); F.VTS = (bf16*)(ws + WS_VTS); F.OF = (bf16*)(ws + WS_OF); F.OB = (bf16*)(ws + WS_OB);
    for (int u = F.tid; u < (LDS_BYTES - LDSCTL_OFF) / 4; u += NWAVES * 64) ((LAS unsigned*)(F.lds + LDSCTL_OFF))[u] = 0u;
    __syncthreads();
    XcdBarrier bar; bar.bar = (unsigned*)(F.ctl + CW_BAR); bar.x = 0; bar.st = nullptr;
    if (args.use_bar) bar = xcd_barrier_post((unsigned*)(F.ctl + CW_BAR), F.MISC + 8);
    const int lo = args.ph_lo, hi = args.ph_hi;
#ifndef PROBE_DUP
#define PROBE_DUP 0u
#endif
#define IN(k) (lo <= (k) && (k) < hi)
#define SEAM(k) do { if (IN(k) && IN((k) + 1) && !(MERGE_P01 && (k) == 1)) xcd_barrier(bar); } while (0)
#define PHASE(k, ...) if (IN(k)) { constexpr bool dupk = ((PROBE_DUP) >> (k)) & 1u; \
        if constexpr (dupk) { _Pragma("unroll 1") for (int qrun = 0; qrun < 2; ++qrun) { if (qrun) xcd_barrier(bar); __VA_ARGS__ } } \
        else { constexpr int qrun = 0; (void)qrun; __VA_ARGS__ } } SEAM(k)
#ifdef PROBE_EPI
#define PROBE_EPI_FLAG args.pad
#else
#define PROBE_EPI_FLAG 0
#endif
#ifdef PROBE_BMUL
#define PROBE_GEMM_HOOK if (args.pad) { g.bmul = (PROBE_BMUL) & 1; g.amul = ((PROBE_BMUL) >> 1) & 1; }
#else
#define PROBE_GEMM_HOOK
#endif
#define COMMA ,
#define GEMM_PHASE(EPI, A_, B_, N_, K_, ...) do { Gemm g{A_, B_, M, N_, K_}; PROBE_GEMM_HOOK; StaticOrder S; S.init(M, N_, F.G, (int)blockIdx.x); typedef pg8::EPI EpiT; EpiT E{__VA_ARGS__}; \
        pg8::gemm_phase<EpiT, StaticOrder, PG8_ALIGN, PG8_SP2>(F.lds + RING_OFF, g, S, E); } while (0)
    using pg8::Gemm; using pg8::StaticOrder;
    float* const outS = F.out + (size_t)M_P * DM;
#if FUSE_NORM
    PHASE(0, p0_prologue(F); );
    PHASE(1, norm_mod_phase(F, F.x_prompt, F.x_sample, F.norm_ffn1, 0, 1); bias2_rows(F, F.WMI, NMIX, 3, F.bias2m); bias2_rows(F, F.W2I, NFF, 6, F.bias2f); );
    PHASE(2, GEMM_PHASE(EpiSwiGLU<false>, F.ABUF, F.W1I, NFF, DM, F.HID, DFF, nullptr, nullptr, PROBE_EPI_FLAG); if (CONV_P2TAIL) convert_queue(F, CW_CONVQ, CV_FI, CV_FO + CV_MI); );
    PHASE(3, GEMM_PHASE(EpiResid<true COMMA true>, F.HID, F.W1O, DM, DFF, F.x_prompt, F.x_sample, F.out, F.mada + 2 * 1024, F.ABUF, F.norm_mix, F.mada + 4 * 1024, F.rowss);
             if (CONV_LATE_P3) convert_queue(F, CW_CONVQ + 64, CV_LATE0, CV_LATE_N); );
    PHASE(4, GEMM_PHASE(EpiProj<true>, F.ABUF, F.WMI, NMIX, DM, F.PROJ, F.out + OUT_V, F.lbv, F.rowss, F.bias2m); );
    PHASE(5, p6_phase(F); );
    PHASE(6, p6b_mixers(F, qrun + args.pad); );
    PHASE(7, p7_combine(F); );
    PHASE(8, GEMM_PHASE(EpiResid<true COMMA false>, F.ABUF2, F.WMO, DM, DM, F.out, outS, F.out, F.mada + 5 * 1024, F.ABUF, F.norm_ffn2, F.mada + 7 * 1024, F.rowss); );
    PHASE(9, GEMM_PHASE(EpiSwiGLU<true>, F.ABUF, F.W2I, NFF, DM, F.HID, DFF, F.rowss, F.bias2f, NFF); );
    PHASE(10, GEMM_PHASE(EpiResid<false COMMA true>, F.HID, F.W2O, DM, DFF, F.out, outS, F.out, F.mada + 8 * 1024, nullptr, nullptr, nullptr, nullptr); );
#else
#if MERGE_P01
    PHASE(0, p0_prologue(F); wait_mada01(F); norm_mod_phase(F, F.x_prompt, F.x_sample, F.norm_ffn1, 0, 1); );
    PHASE(1, ; );
#else
    PHASE(0, p0_prologue(F); );
    PHASE(1, norm_mod_phase(F, F.x_prompt, F.x_sample, F.norm_ffn1, 0, 1); );
#endif
    PHASE(2, GEMM_PHASE(EpiSwiGLU<false>, F.ABUF, F.W1I, NFF, DM, F.HID, DFF, nullptr, nullptr, PROBE_EPI_FLAG); if (CONV_P2TAIL) convert_queue(F, CW_CONVQ, CV_FI, CV_FO + CV_MI); );
    PHASE(3, GEMM_PHASE(EpiResid<false COMMA true>, F.HID, F.W1O, DM, DFF, F.x_prompt, F.x_sample, F.out, F.mada + 2 * 1024, nullptr, nullptr, nullptr, nullptr);
             if (CONV_LATE_P3) convert_queue(F, CW_CONVQ + 64, CV_LATE0, CV_LATE_N); );
    PHASE(4, norm_mod_phase(F, F.out, outS, F.norm_mix, 3, 4); );
    PHASE(5, GEMM_PHASE(EpiProj<false>, F.ABUF, F.WMI, NMIX, DM, F.PROJ, F.out + OUT_V, F.lbv, nullptr, nullptr); );
    PHASE(6, p6_phase(F); );
    PHASE(7, p6b_mixers(F, qrun + args.pad); );
    PHASE(8, p7_combine(F); );
    PHASE(9, GEMM_PHASE(EpiResid<false COMMA false>, F.ABUF2, F.WMO, DM, DM, F.out, outS, F.out, F.mada + 5 * 1024, nullptr, nullptr, nullptr, nullptr);
             if (CONV_P9) convert_queue(F, CW_CONVQ + 192, CV_LATE0 + CV_MO, CV_FI + CV_FO); );
    PHASE(10, norm_mod_phase(F, F.out, outS, F.norm_ffn2, 6, 7); );
    PHASE(11, GEMM_PHASE(EpiSwiGLU<false>, F.ABUF, F.W2I, NFF, DM, F.HID, DFF, nullptr, nullptr, 0); );
    PHASE(12, GEMM_PHASE(EpiResid<false COMMA true>, F.HID, F.W2O, DM, DFF, F.out, outS, F.out, F.mada + 8 * 1024, nullptr, nullptr, nullptr, nullptr); );
#endif
#ifdef PROBE_XBAR
#pragma unroll 1
    for (int i = 0; i < PROBE_XBAR; ++i) xcd_barrier(bar);
#endif
#undef IN
#undef SEAM
#undef PHASE
#undef GEMM_PHASE
}

extern "C" void kernel_launch(void* const* d_in, const int* in_sizes, int n_in, void* d_out, int out_size, void* d_ws, size_t ws_size, hipStream_t stream) {
    static int grid = 0;
    if (grid == 0) {
        if (n_in != 24 || in_sizes[0] != M_P * DM || in_sizes[1] != M_S * DM || (size_t)out_size != OUT_END || ws_size < WS_END) {
            fprintf(stderr, "kernel_launch: unexpected shapes (n_in %d, out %d, ws %zu); nothing launched\n", n_in, out_size, ws_size); grid = -1; return; }
        int dev = 0, cus = 0, per_cu = 0;
        if (hipGetDevice(&dev) != hipSuccess || hipDeviceGetAttribute(&cus, hipDeviceAttributeMultiprocessorCount, dev) != hipSuccess) { grid = -1; return; }
        if (hipFuncSetAttribute((const void*)hymba_fwd, hipFuncAttributeMaxDynamicSharedMemorySize, LDS_BYTES) != hipSuccess) { fprintf(stderr, "kernel_launch: hipFuncSetAttribute failed\n"); grid = -1; return; }
        if (hipOccupancyMaxActiveBlocksPerMultiprocessor(&per_cu, (const void*)hymba_fwd, NWAVES * 64, LDS_BYTES) != hipSuccess || per_cu < 1) {
            fprintf(stderr, "kernel_launch: occupancy query reports %d workgroups per CU; nothing launched\n", per_cu); (void)hipGetLastError(); grid = -1; return; }
        grid = cus;
        if (grid % 8 != 0) grid -= grid % 8;
    }
    if (grid < 0) return;
    if (hipMemsetAsync((char*)d_ws + WS_CTL, 0, CTL_ZERO_BYTES, stream) != hipSuccess) return;
    Args a{};
    for (int i = 0; i < 24; ++i) a.in[i] = (const float*)d_in[i];
    a.out = (float*)d_out; a.ws = (unsigned char*)d_ws;
#if MK_ONE_LAUNCH
    a.ph_lo = 0; a.ph_hi = N_PHASES; a.use_bar = 1;
    hipLaunchKernelGGL(hymba_fwd, dim3(grid), dim3(NWAVES * 64), LDS_BYTES, stream, a);
#ifdef PROBE_RELAUNCH
    a.ph_lo = PROBE_RELAUNCH; a.ph_hi = PROBE_RELAUNCH + 1; a.use_bar = 0; a.pad = 1;
    hipLaunchKernelGGL(hymba_fwd, dim3(grid), dim3(NWAVES * 64), LDS_BYTES, stream, a);
#endif
#else
    for (int p = 0; p < N_PHASES; ++p) { a.ph_lo = p; a.ph_hi = p + 1; a.use_bar = 0; hipLaunchKernelGGL(hymba_fwd, dim3(grid), dim3(NWAVES * 64), LDS_BYTES, stream, a); }
#endif
}
```

```cpp
#include <hip/hip_runtime.h>
#include <cstdio>
#include <cstdint>
#define MK_ONE_LAUNCH 1
#define PROBE_DUP 0u
namespace pg8 {
#define PG8_LAS __attribute__((address_space(3)))
typedef unsigned short bf16_t;
typedef short bf16x8 __attribute__((ext_vector_type(8)));
typedef float f32x4 __attribute__((ext_vector_type(4)));
typedef unsigned u32x4 __attribute__((ext_vector_type(4)));
constexpr int BM = 256, BK = 64, HALF = 128, HTB = HALF * BK * 2  , STAGE_BYTES = 8 * HTB, NXCD = 8, WGM = 5;

__host__ __device__ __forceinline__ int lds_byte(int r, int c) { const int st = (r >> 4) * 2 + (c >> 5), rr = r & 15, cc = c & 31, ob = rr * 64 + cc * 2; return st * 1024 + (ob ^ (((ob >> 9) & 1) << 5)); }
__host__ __device__ __forceinline__ void stage_rc(int b, int& R, int& C) { const int st = b / 1024, sb = b % 1024, swz = sb ^ (((sb >> 9) & 1) << 5); R = (st >> 1) * 16 + swz / 64; C = (st & 1) * 32 + (swz % 64) / 2; }
__host__ __device__ __forceinline__ int perm32(int rho) { const int n = rho >> 4, i = rho & 15; return 8 * (i >> 2) + 4 * n + (i & 3); }

struct Unit { int pm, pn, hf, k0, nk, kq; };
struct Gemm { const bf16_t* A; const bf16_t* Bt; int M, N, K; int bmul = 1, amul = 1; };

struct StaticOrder {
    int nM, nN, nwg, G, c;
    __host__ __device__ void init(int M, int N, int G_, int c_) { nM = M / BM; nN = N / BM; nwg = nM * nN; G = G_; c = c_; }
    __host__ __device__ bool next(int i, Unit& u) const {
        const long L = (long)i * G + c; if (L >= nwg) return false; u.hf = 0; u.k0 = 0; u.nk = 0; u.kq = 0;
        int wgid = (int)L; { const int q = nwg / NXCD, r = nwg % NXCD, xcd = wgid % NXCD, off = wgid / NXCD; wgid = (xcd < r ? xcd * (q + 1) : r * (q + 1) + (xcd - r) * q) + off; }
        const int nig = WGM * nN, gid = wgid / nig, fm = gid * WGM, gsz = (nM - fm) < WGM ? (nM - fm) : WGM;
        u.pm = fm + ((wgid % nig) % gsz); u.pn = (wgid % nig) / gsz; return true;
    }
    __device__ __forceinline__ void a_ready(const Unit&) const {}
    __device__ __forceinline__ void done(const Unit&) const {}
};


__device__ __forceinline__ unsigned cvt_pk_bf16(float lo, float hi) { unsigned r; asm volatile("v_cvt_pk_bf16_f32 %0, %1, %2" : "=v"(r) : "v"(lo), "v"(hi)); return r; }
#ifndef EPI_SC1
#define EPI_SC1 0
#endif
__device__ __forceinline__ void store16(void* p, u32x4 v) {
#if EPI_SC1
    asm volatile("global_store_dwordx4 %0, %1, off sc1\n\ts_nop 1" :: "v"(p), "v"(v) : "memory");
#else
    *(u32x4*)p = v;
#endif
}
__device__ __forceinline__ void store16f(void* p, f32x4 v) { store16(p, __builtin_bit_cast(u32x4, v)); }
__device__ __forceinline__ float silu_f(float g) { return g * __builtin_amdgcn_rcpf(1.0f + __builtin_amdgcn_exp2f(-1.4426950408889634f * g)); }

__device__ __forceinline__ float row_rstd(const float* rowss, int row) {
    const f32x4* p = (const f32x4*)(rowss + (size_t)row * 16); const f32x4 a = p[0], b = p[1], c = p[2], d = p[3];
    const float s = ((a[0] + a[1]) + (a[2] + a[3])) + ((b[0] + b[1]) + (b[2] + b[3])) + ((c[0] + c[1]) + (c[2] + c[3])) + ((d[0] + d[1]) + (d[2] + d[3]));
    return 1.0f / sqrtf(s * (1.0f / 1024.0f) + 1e-6f);
}
template <bool RS> struct EpiSwiGLU {
    static constexpr bool PERM = true, AFTER_DRAIN = false;
    bf16_t* H; int ldh; const float* rowss; const float* bias2; int ldb2;
    __device__ __forceinline__ void operator()(const f32x4 (&acc)[2][2][4][2], const Unit& u, int wr, int wc, int fr, int fq) const {
        const int row0 = u.pm * BM + (u.hf == 2 ? HALF : 0) + wr * 64 + fr, col0 = u.pn * HALF + wc * 32 + 8 * fq;
        const int cond = u.pm < 32 ? 0 : 1 + ((u.pm - 32) >> 2);
        f32x4 bz[2][2];
#pragma unroll
        for (int bj = 0; bj < 2; ++bj)
#pragma unroll
            for (int n = 0; n < 2; ++n) { bz[bj][n] = (f32x4){0.f, 0.f, 0.f, 0.f}; if constexpr (RS) bz[bj][n] = *(const f32x4*)(bias2 + (size_t)cond * ldb2 + u.pn * BM + bj * HALF + wc * 32 + 8 * fq + 4 * n); }
#pragma unroll
        for (int ai = 0; ai < 2; ++ai)
#pragma unroll
            for (int m = 0; m < 4; ++m) { if (ai == 1 && u.hf) break; const int row = row0 + ai * HALF + m * 16; bf16_t* rowp = H + (size_t)row * ldh + col0;
                float rs = 1.0f; if constexpr (RS) rs = row_rstd(rowss, row);
                const f32x4 g0 = acc[ai][0][m][0] * rs + bz[0][0], g1 = acc[ai][0][m][1] * rs + bz[0][1], u0 = acc[ai][1][m][0] * rs + bz[1][0], u1 = acc[ai][1][m][1] * rs + bz[1][1];
                u32x4 w;
#ifdef PROBE_EPI
                if (ldb2) { w.x = cvt_pk_bf16(g0[0] * u0[0], g0[1] * u0[1]); w.y = cvt_pk_bf16(g0[2] * u0[2], g0[3] * u0[3]); w.z = cvt_pk_bf16(g1[0] * u1[0], g1[1] * u1[1]); w.w = cvt_pk_bf16(g1[2] * u1[2], g1[3] * u1[3]); store16(rowp, w); continue; }
#endif
                w.x = cvt_pk_bf16(silu_f(g0[0]) * u0[0], silu_f(g0[1]) * u0[1]); w.y = cvt_pk_bf16(silu_f(g0[2]) * u0[2], silu_f(g0[3]) * u0[3]);
                w.z = cvt_pk_bf16(silu_f(g1[0]) * u1[0], silu_f(g1[1]) * u1[1]); w.w = cvt_pk_bf16(silu_f(g1[2]) * u1[2], silu_f(g1[3]) * u1[3]);
                store16(rowp, w); }
    }
};

template <bool NXT, bool HALFG> struct EpiResid {
    static constexpr bool PERM = false, AFTER_DRAIN = false;
    const float* base0; const float* base1; float* out; const float* gate;
    bf16_t* nxtA; const float* nw; const float* sc; float* rowss;
    __device__ __forceinline__ void operator()(const f32x4 (&acc)[2][2][4][2], const Unit& u, int wr, int wc, int fr, int fq) const {
        const int row0 = u.pm * BM + wr * 64 + fr, col0 = u.pn * BM + wc * 32 + 4 * fq;
        const int cond = u.pm < 32 ? 0 : 1 + ((u.pm - 32) >> 2);
        const float* bp = u.pm < 32 ? base0 : base1 - (size_t)8192 * 1024;
        if constexpr (!NXT) {
            constexpr float gsl = HALFG ? 0.5f : 1.0f;
            f32x4 gv[2][2];
#pragma unroll
            for (int bj = 0; bj < 2; ++bj)
#pragma unroll
                for (int n = 0; n < 2; ++n) gv[bj][n] = *(const f32x4*)(gate + cond * 9216 + col0 + bj * HALF + n * 16) * gsl;
#pragma unroll
            for (int ai = 0; ai < 2; ++ai)
#pragma unroll
                for (int m = 0; m < 4; ++m) { const size_t off = (size_t)(row0 + ai * HALF + m * 16) * 1024 + col0;
#pragma unroll
                    for (int bj = 0; bj < 2; ++bj)
#pragma unroll
                        for (int n = 0; n < 2; ++n) { const f32x4 b = *(const f32x4*)(bp + off + bj * HALF + n * 16); store16f(out + off + bj * HALF + n * 16, b + gv[bj][n] * acc[ai][bj][m][n]); } }
            return;
        }
        float ss[2][4];
#pragma unroll
        for (int ai = 0; ai < 2; ++ai)
#pragma unroll
            for (int m = 0; m < 4; ++m) ss[ai][m] = 0.f;
#pragma unroll
        for (int bj = 0; bj < 2; ++bj)
#pragma unroll
            for (int n = 0; n < 2; ++n) { const int c = col0 + bj * HALF + n * 16; constexpr float gsl = HALFG ? 0.5f : 1.0f; const f32x4 gv = *(const f32x4*)(gate + cond * 9216 + c) * gsl;
                f32x4 av = {0.f, 0.f, 0.f, 0.f}; if constexpr (NXT) av = *(const f32x4*)(nw + c) * (*(const f32x4*)(sc + cond * 9216 + c) + 1.0f);
#pragma unroll
                for (int ai = 0; ai < 2; ++ai)
#pragma unroll
                    for (int m = 0; m < 4; ++m) { const size_t off = (size_t)(row0 + ai * HALF + m * 16) * 1024 + c; const f32x4 b = *(const f32x4*)(bp + off); const f32x4 o = b + gv * acc[ai][bj][m][n];
                        *(f32x4*)(out + off) = o;
                        if constexpr (NXT) { ss[ai][m] += (o[0] * o[0] + o[1] * o[1]) + (o[2] * o[2] + o[3] * o[3]); const f32x4 a = o * av;
                            typedef unsigned u32x2 __attribute__((ext_vector_type(2))); *(u32x2*)(nxtA + off) = (u32x2){cvt_pk_bf16(a[0], a[1]), cvt_pk_bf16(a[2], a[3])}; } } }
        if constexpr (NXT) {
#pragma unroll
            for (int ai = 0; ai < 2; ++ai)
#pragma unroll
                for (int m = 0; m < 4; ++m) { float s = ss[ai][m]; s += __shfl_xor(s, 16); s += __shfl_xor(s, 32); if (fq == 0) rowss[(size_t)(row0 + ai * HALF + m * 16) * 16 + u.pn * 4 + wc] = s; } }
    }
};

typedef _Float16 h2_t __attribute__((ext_vector_type(2)));
__device__ __forceinline__ unsigned pkh2(float lo, float hi) { const h2_t h = {(_Float16)lo, (_Float16)hi}; return __builtin_bit_cast(unsigned, h); }
__device__ __forceinline__ float logf_gate(float x, float lb) { const float sg = __builtin_amdgcn_rcpf(1.0f + __builtin_amdgcn_exp2f(-1.4426950408889634f * x)); return 0.6931471805599453f * __builtin_amdgcn_logf(lb + (1.0f - lb) * sg); }
template <bool RS> struct EpiProj {
    static constexpr bool PERM = true, AFTER_DRAIN = false;
    bf16_t* P; float* outv; const float* lbv; const float* rowss; const float* bias2;
    __device__ __forceinline__ void operator()(const f32x4 (&acc)[2][2][4][2], const Unit& u, int wr, int wc, int fr, int fq) const {
        const int row0 = u.pm * BM + (u.hf == 2 ? HALF : 0) + wr * 64 + fr, col0 = u.pn * BM + wc * 32 + 8 * fq;
        const bool wv = (u.pn >= 14) && (u.pm < 32), gate = (u.pn >= 4) && (u.pn < 8);
        const int cond = u.pm < 32 ? 0 : 1 + ((u.pm - 32) >> 2);
        f32x4 lb[2][2], bz[2][2];
#pragma unroll
        for (int bj = 0; bj < 2; ++bj)
#pragma unroll
            for (int n = 0; n < 2; ++n) { lb[bj][n] = gate ? *(const f32x4*)(lbv + ((col0 + bj * HALF + 4 * n) & 511)) : (f32x4){0.f, 0.f, 0.f, 0.f}; bz[bj][n] = (f32x4){0.f, 0.f, 0.f, 0.f}; if constexpr (RS) bz[bj][n] = *(const f32x4*)(bias2 + cond * 4096 + col0 + bj * HALF + 4 * n); }
#pragma unroll
        for (int ai = 0; ai < 2; ++ai)
#pragma unroll
            for (int m = 0; m < 4; ++m) { if (ai == 1 && u.hf) break; const int row = row0 + ai * HALF + m * 16; bf16_t* rowp = P + (size_t)row * 4096 + col0; float rs = 1.0f; if constexpr (RS) rs = row_rstd(rowss, row);
#pragma unroll
                for (int bj = 0; bj < 2; ++bj) { const f32x4 v0 = acc[ai][bj][m][0] * rs + bz[bj][0], v1 = acc[ai][bj][m][1] * rs + bz[bj][1]; u32x4 w;
                    if (gate) { const f32x4 l0 = lb[bj][0], l1 = lb[bj][1];
                        w.x = pkh2(logf_gate(v0[0], l0[0]), logf_gate(v0[1], l0[1])); w.y = pkh2(logf_gate(v0[2], l0[2]), logf_gate(v0[3], l0[3]));
                        w.z = pkh2(logf_gate(v1[0], l1[0]), logf_gate(v1[1], l1[1])); w.w = pkh2(logf_gate(v1[2], l1[2]), logf_gate(v1[3], l1[3])); }
                    else { w.x = cvt_pk_bf16(v0[0], v0[1]); w.y = cvt_pk_bf16(v0[2], v0[3]); w.z = cvt_pk_bf16(v1[0], v1[1]); w.w = cvt_pk_bf16(v1[2], v1[3]); }
                    store16(rowp + bj * HALF, w);
                    if (wv) { float* ov = outv + (size_t)row * 512 + (col0 + bj * HALF - 3584); *(f32x4*)ov = v0; *(f32x4*)(ov + 4) = v1; } } }
    }
};

__device__ __forceinline__ void publish_wave(unsigned* cnt, int local) {
    asm volatile("s_waitcnt vmcnt(0)" ::: "memory");
    if (!local) { __builtin_amdgcn_fence(__ATOMIC_RELEASE, "agent"); asm volatile("s_waitcnt vmcnt(0)" ::: "memory"); }
    if ((threadIdx.x & 63) == 0) (void)__hip_atomic_fetch_add(cnt, 1u, __ATOMIC_RELAXED, __HIP_MEMORY_SCOPE_AGENT);
}
__device__ __forceinline__ void wait_counter_wave(unsigned* cnt, unsigned need) {
    unsigned sp = 0;
    while ((unsigned)__builtin_amdgcn_readfirstlane(__hip_atomic_load(cnt, __ATOMIC_RELAXED, __HIP_MEMORY_SCOPE_AGENT)) < need) { __builtin_amdgcn_s_sleep(2); if (++sp > (1u << 22)) break; }
    __builtin_amdgcn_fence(__ATOMIC_ACQUIRE, "agent"); asm volatile("s_waitcnt vmcnt(0)" ::: "memory");
}
__device__ __forceinline__ void wait_counter_wg(unsigned* cnt, unsigned need) {
    if (threadIdx.x < 64) wait_counter_wave(cnt, need);
    asm volatile("" ::: "memory"); __builtin_amdgcn_s_barrier(); asm volatile("" ::: "memory");
}
struct XccInOrder {
    int x, r; unsigned* pc; int local;
    __device__ __forceinline__ bool next(int i, Unit& u) const { const int j = i * 32 + r; if (j >= 110) return false; u.hf = 0; u.k0 = 0; u.nk = 0; u.kq = 0;
        if (j < 88) { u.pm = 5 * x + (j & 3); u.pn = j >> 2; } else { u.pm = 5 * x + 4; u.pn = j - 88; } return true; }
    __device__ __forceinline__ void a_ready(const Unit&) const {}
    __device__ __forceinline__ void done(const Unit& u) const {
        const int j = (u.pm == 5 * x + 4) ? 88 + u.pn : 4 * u.pn + (u.pm - 5 * x), i = (j - r) >> 5;
        if (i == 0) return;
        Unit p; next(i - 1, p);
        const bool lane0 = (threadIdx.x & 63) == 0;
        if (i == 1) { if (local) { if (lane0) (void)__hip_atomic_fetch_add(pc + 16 * p.pm, 1u, __ATOMIC_RELAXED, __HIP_MEMORY_SCOPE_AGENT); } else publish_wave(pc + 16 * p.pm, 0); return; }
        publish_wave(pc + 16 * u.pm, local);
        if (i == 2 && lane0) (void)__hip_atomic_fetch_add(pc + 16 * p.pm, 1u, __ATOMIC_RELAXED, __HIP_MEMORY_SCOPE_AGENT);
    }
};
struct XccOutOrder {
    int x, r; unsigned* pc;
    __device__ __forceinline__ bool next(int i, Unit& u) const { if (i > 0) return false; u.hf = 0;
        if (r >= 14 && r < 30) { const int q = r - 14; u.pm = 5 * x + (q >> 2); u.pn = q & 3; u.k0 = 0; u.nk = 0; u.kq = 0; }
        else { const int s = r < 14 ? r : r - 16, kq = s & 3; u.pm = 5 * x + 4; u.pn = s >> 2; u.kq = 1 + kq;
               const int it0 = kq == 0 ? 0 : kq == 1 ? 6 : kq == 2 ? 12 : 17, nit = kq < 2 ? 6 : 5; u.k0 = 2 * it0; u.nk = 2 * nit; }
        return true; }
    __device__ __forceinline__ void a_ready(const Unit& u) const { wait_counter_wg(pc + 16 * u.pm, 22u * 8u); }
    __device__ __forceinline__ void done(const Unit&) const {}
};
template <bool HALFG> struct EpiResidSplit {
    static constexpr bool PERM = false, AFTER_DRAIN = false;
    const float* base0; const float* base1; float* out; const float* gate; float* slab; unsigned* uc; int x; int local;
    __device__ __forceinline__ void operator()(f32x4 (&acc)[2][2][4][2], const Unit& u, int wr, int wc, int fr, int fq) const {
        const int tid = threadIdx.x;
        if (u.kq >= 1 && u.kq <= 3) {
            f32x4* s = (f32x4*)(slab + (size_t)((x * 4 + u.pn) * 3 + (u.kq - 1)) * (32 * 512 * 4)) + tid;
#pragma unroll
            for (int ai = 0; ai < 2; ++ai)
#pragma unroll
                for (int bj = 0; bj < 2; ++bj) {
#pragma unroll
                    for (int m = 0; m < 4; ++m)
#pragma unroll
                        for (int n = 0; n < 2; ++n) s[(m * 2 + n) * 512] = acc[ai][bj][m][n];
                    s += 8 * 512; asm volatile("" : "+v"(s) :: "memory"); }
            publish_wave(uc + 16 * (x * 4 + u.pn), local);
            return;
        }
        const bool owner = u.kq == 4;
        const f32x4* sp = (const f32x4*)(slab + (size_t)((x * 4 + u.pn) * 3) * (32 * 512 * 4)) + tid;
        if (owner) wait_counter_wave(uc + 16 * (x * 4 + u.pn), 24u);
        const int row0 = u.pm * BM + wr * 64 + fr, col0 = u.pn * BM + wc * 32 + 4 * fq;
        const int cond = u.pm < 32 ? 0 : 1 + ((u.pm - 32) >> 2);
        const float* bp = u.pm < 32 ? base0 : base1 - (size_t)8192 * 1024;
        constexpr float gsl = HALFG ? 0.5f : 1.0f;
        f32x4 gv[2][2];
#pragma unroll
        for (int bj = 0; bj < 2; ++bj)
#pragma unroll
            for (int n = 0; n < 2; ++n) gv[bj][n] = *(const f32x4*)(gate + cond * 9216 + col0 + bj * HALF + n * 16) * gsl;
#pragma unroll
        for (int ai = 0; ai < 2; ++ai)
#pragma unroll
            for (int m = 0; m < 4; ++m) { const size_t off = (size_t)(row0 + ai * HALF + m * 16) * 1024 + col0;
#pragma unroll
                for (int bj = 0; bj < 2; ++bj)
#pragma unroll
                    for (int n = 0; n < 2; ++n) { f32x4 a = acc[ai][bj][m][n];
                        if (owner) { const f32x4* s = sp + (((ai * 2 + bj) * 4 + m) * 2 + n) * 512; a += (s[0] + s[32 * 512]) + s[2 * 32 * 512]; }
                        const f32x4 b = *(const f32x4*)(bp + off + bj * HALF + n * 16); *(f32x4*)(out + off + bj * HALF + n * 16) = b + gv[bj][n] * a; }
                asm volatile("" ::: "memory"); }
    }
};
template <class Epi, class Sched, bool ALIGN_EPI = false, bool SP2 = false>
__device__ __forceinline__ void gemm_phase(PG8_LAS unsigned char* lds, const Gemm g, const Sched& S, const Epi& E) {
    const int tid = threadIdx.x, wid = __builtin_amdgcn_readfirstlane(tid >> 6), lane = tid & 63, wr = wid >> 2, wc = wid & 3, fr = lane & 15, fq = lane >> 4;
    const int K = g.K, nt = K / BK;
    unsigned voffA[2], voffB[2];
#pragma unroll
    for (int i = 0; i < 2; ++i) { int R, C; stage_rc(tid * 16 + i * 8192, R, C); const int Rb = Epi::PERM ? ((R & ~31) + perm32(R & 31)) : R;
        voffA[i] = (unsigned)(R * K + C) * 2u; voffB[i] = (unsigned)(Rb * K + C) * 2u; }
    const size_t kstep = (size_t)(BK * 2);
    const size_t hstep = (size_t)HALF * K * 2;
    const size_t tstep = 2 * hstep;
    const unsigned ldsw = (unsigned)wid * 1024u;
    const int aoff = lds_byte(wr * 64 + fr, fq * 8), boff = lds_byte(wc * 32 + fr, fq * 8);
#define PG8_SA(b, h) (((b) * 2 + (h)) * HTB)
#define PG8_SB(b, h) ((4 + (b) * 2 + (h)) * HTB)
#define PG8_STAGE(bufoff, gbase, voff) do { _Pragma("unroll") for (int _i = 0; _i < 2; ++_i) \
        __builtin_amdgcn_global_load_lds((const unsigned*)((const char*)(gbase) + (voff)[_i]), (PG8_LAS unsigned*)(lds + (bufoff) + ldsw + _i * 8192), 16, 0, 0); } while (0)
#define PG8_LDA(dst, b, h) do { _Pragma("unroll") for (int m = 0; m < 4; ++m) _Pragma("unroll") for (int k = 0; k < 2; ++k) dst[m][k] = *(const PG8_LAS bf16x8*)(lds + PG8_SA(b, h) + aoff + m * 2048 + k * 1024); } while (0)
#define PG8_LDB(dst, b, h) do { _Pragma("unroll") for (int n = 0; n < 2; ++n) _Pragma("unroll") for (int k = 0; k < 2; ++k) dst[n][k] = *(const PG8_LAS bf16x8*)(lds + PG8_SB(b, h) + boff + n * 2048 + k * 1024); } while (0)
#define PG8_MMA(ai, bj, At, Bt) do { __builtin_amdgcn_s_setprio(1); _Pragma("unroll") for (int m = 0; m < 4; ++m) _Pragma("unroll") for (int n = 0; n < 2; ++n) _Pragma("unroll") for (int k = 0; k < 2; ++k) \
        acc[ai][bj][m][n] = __builtin_amdgcn_mfma_f32_16x16x32_bf16(Bt[n][k], At[m][k], acc[ai][bj][m][n], 0, 0, 0); __builtin_amdgcn_s_setprio(0); } while (0)
#define PG8_WAIT_V(n) asm volatile("s_waitcnt vmcnt(" #n ")" ::: "memory")
#define PG8_WAIT_L(n) asm volatile("s_waitcnt lgkmcnt(" #n ")" ::: "memory")
#define PG8_BAR __builtin_amdgcn_s_barrier()
#define PG8_SCHED __builtin_amdgcn_sched_barrier(0)
    Unit cur, nxt; int ui = 0;
    if (!S.next(0, cur)) return;
    f32x4 acc[2][2][4][2];
#pragma unroll
    for (int a = 0; a < 2; ++a)
#pragma unroll
        for (int b = 0; b < 2; ++b)
#pragma unroll
            for (int m = 0; m < 4; ++m)
#pragma unroll
                for (int n = 0; n < 2; ++n) acc[a][b][m][n] = (f32x4){0.f, 0.f, 0.f, 0.f};
    bf16x8 At[4][2], B0[2][2], B1[2][2];
    const char* cA = (const char*)g.A + (size_t)(cur.pm * g.amul) * tstep + (size_t)cur.k0 * kstep; const char* cB = (const char*)g.Bt + (size_t)(cur.pn * g.bmul) * tstep + (size_t)cur.k0 * kstep;
    S.a_ready(cur);
    if constexpr (SP2) {
        PG8_STAGE(PG8_SB(0, 0), cB, voffB); PG8_STAGE(PG8_SB(0, 1), cB + hstep, voffB); PG8_STAGE(PG8_SA(0, 0), cA, voffA); PG8_STAGE(PG8_SA(0, 1), cA + hstep, voffA);
        if (wr == 1) PG8_BAR;
        PG8_WAIT_V(2); PG8_BAR;
        PG8_STAGE(PG8_SB(1, 0), cB + kstep, voffB); PG8_STAGE(PG8_SA(1, 0), cA + kstep, voffA); PG8_STAGE(PG8_SB(1, 1), cB + hstep + kstep, voffB);
        PG8_WAIT_V(6); PG8_BAR;
    } else {
        PG8_STAGE(PG8_SB(0, 0), cB, voffB); PG8_STAGE(PG8_SA(0, 0), cA, voffA); PG8_STAGE(PG8_SB(0, 1), cB + hstep, voffB); PG8_STAGE(PG8_SA(0, 1), cA + hstep, voffA);
        if (wr == 1) PG8_BAR;
        PG8_WAIT_V(4); PG8_BAR;
        PG8_STAGE(PG8_SB(1, 0), cB + kstep, voffB); PG8_STAGE(PG8_SA(1, 0), cA + kstep, voffA); PG8_STAGE(PG8_SB(1, 1), cB + hstep + kstep, voffB);
        PG8_WAIT_V(6); PG8_BAR;
    }
    for (;;) {
        const bool has_next = S.next(ui + 1, nxt);
        const char* nA = has_next ? (const char*)g.A + (size_t)(nxt.pm * g.amul) * tstep + (size_t)nxt.k0 * kstep : cA; const char* nB = has_next ? (const char*)g.Bt + (size_t)(nxt.pn * g.bmul) * tstep + (size_t)nxt.k0 * kstep : cB;
        const int unt = cur.nk ? cur.nk : nt;
        for (int t = 0; t < unt; t += 2) {
            const bool last = (t == unt - 2);
            const char* a1 = cA + (size_t)(t + 1) * kstep;
            const char* a2 = last ? nA : cA + (size_t)(t + 2) * kstep; const char* b2 = last ? nB : cB + (size_t)(t + 2) * kstep;
            const char* a3 = a2 + kstep; const char* b3 = b2 + kstep;
            if (last && has_next) S.a_ready(nxt);
            if constexpr (SP2) {
            PG8_LDB(B0, 0, 0); PG8_LDB(B1, 0, 1); PG8_SCHED; PG8_LDA(At, 0, 0); PG8_STAGE(PG8_SA(1, 1), a1 + hstep, voffA);
            PG8_WAIT_V(8); PG8_WAIT_L(0); PG8_BAR; PG8_MMA(0, 0, At, B0); PG8_MMA(0, 1, At, B1); PG8_BAR; PG8_SCHED;
            PG8_LDA(At, 0, 1); PG8_STAGE(PG8_SB(0, 0), b2, voffB); PG8_STAGE(PG8_SB(0, 1), b2 + hstep, voffB); PG8_STAGE(PG8_SA(0, 0), a2, voffA);
            PG8_WAIT_V(8); PG8_WAIT_L(0); PG8_BAR; PG8_MMA(1, 0, At, B0); PG8_MMA(1, 1, At, B1); PG8_BAR; PG8_SCHED;
            PG8_LDB(B0, 1, 0); PG8_LDB(B1, 1, 1); PG8_SCHED; PG8_LDA(At, 1, 0); PG8_STAGE(PG8_SA(0, 1), a2 + hstep, voffA);
            PG8_WAIT_V(8); PG8_WAIT_L(0); PG8_BAR; PG8_MMA(0, 0, At, B0); PG8_MMA(0, 1, At, B1); PG8_BAR; PG8_SCHED;
            PG8_LDA(At, 1, 1); PG8_STAGE(PG8_SB(1, 0), b3, voffB); PG8_STAGE(PG8_SB(1, 1), b3 + hstep, voffB); PG8_STAGE(PG8_SA(1, 0), a3, voffA);
            PG8_WAIT_V(8); PG8_WAIT_L(0); PG8_BAR; PG8_MMA(1, 0, At, B0); PG8_MMA(1, 1, At, B1); PG8_BAR; PG8_SCHED;
            } else {
            PG8_LDB(B0, 0, 0); PG8_SCHED; PG8_LDA(At, 0, 0); PG8_STAGE(PG8_SA(1, 1), a1 + hstep, voffA);
            PG8_WAIT_L(8); PG8_BAR; PG8_WAIT_L(0); PG8_MMA(0, 0, At, B0); PG8_BAR; PG8_SCHED;
            PG8_LDB(B1, 0, 1); PG8_STAGE(PG8_SB(0, 0), b2, voffB);
            PG8_BAR; PG8_WAIT_L(0); PG8_MMA(0, 1, At, B1); PG8_BAR;
            PG8_LDA(At, 0, 1); PG8_STAGE(PG8_SA(0, 0), a2, voffA);
            PG8_BAR; PG8_WAIT_L(0); PG8_MMA(1, 0, At, B0); PG8_BAR; PG8_SCHED;
            PG8_STAGE(PG8_SB(0, 1), b2 + hstep, voffB);
            PG8_WAIT_V(6); PG8_BAR; PG8_MMA(1, 1, At, B1); PG8_BAR;
            PG8_LDB(B0, 1, 0); PG8_SCHED; PG8_LDA(At, 1, 0); PG8_STAGE(PG8_SA(0, 1), a2 + hstep, voffA);
            PG8_WAIT_L(8); PG8_BAR; PG8_WAIT_L(0); PG8_MMA(0, 0, At, B0); PG8_BAR; PG8_SCHED;
            PG8_LDB(B1, 1, 1); PG8_STAGE(PG8_SB(1, 0), b3, voffB);
            PG8_BAR; PG8_WAIT_L(0); PG8_MMA(0, 1, At, B1); PG8_BAR;
            PG8_LDA(At, 1, 1); PG8_STAGE(PG8_SA(1, 0), a3, voffA);
            PG8_BAR; PG8_WAIT_L(0); PG8_MMA(1, 0, At, B0); PG8_BAR; PG8_SCHED;
            PG8_STAGE(PG8_SB(1, 1), b3 + hstep, voffB);
            PG8_WAIT_V(6); PG8_BAR; PG8_MMA(1, 1, At, B1); PG8_BAR;
            }
        }
        if constexpr (ALIGN_EPI) { if (wr == 0) PG8_BAR; }
        if constexpr (!Epi::AFTER_DRAIN) { E(acc, cur, wr, wc, fr, fq); S.done(cur); }
        if (!has_next) break;
#pragma unroll
        for (int a = 0; a < 2; ++a)
#pragma unroll
            for (int b = 0; b < 2; ++b)
#pragma unroll
                for (int m = 0; m < 4; ++m)
#pragma unroll
                    for (int n = 0; n < 2; ++n) acc[a][b][m][n] = (f32x4){0.f, 0.f, 0.f, 0.f};
        cur = nxt; cA = nA; cB = nB; ++ui;
        if constexpr (ALIGN_EPI) { if (wr == 1) PG8_BAR; }
    }
    PG8_WAIT_V(0);
    if constexpr (!ALIGN_EPI) { if (wr == 0) PG8_BAR; }
    PG8_BAR;
    if constexpr (Epi::AFTER_DRAIN) { E.fused(acc, cur, wr, wc, fr, fq, lds, wid, lane); S.done(cur); }
#undef PG8_SA
#undef PG8_SB
#undef PG8_STAGE
#undef PG8_LDA
#undef PG8_LDB
#undef PG8_MMA
#undef PG8_WAIT_V
#undef PG8_WAIT_L
#undef PG8_BAR
#undef PG8_SCHED
}
}

#ifndef PG8_SP2
#define PG8_SP2 true
#endif
#ifndef PG8_ALIGN
#define PG8_ALIGN true
#endif
constexpr int NWAVES = 8;
#ifndef MK_ONE_LAUNCH
#define MK_ONE_LAUNCH 1
#endif
#ifndef MERGE_FFN
#define MERGE_FFN 0
#endif
#ifndef MERGE_P01
#define MERGE_P01 0
#endif
#ifndef FUSE_NORM
#define FUSE_NORM 0
#endif
constexpr int N_PHASES = FUSE_NORM ? 11 : 13;
#ifndef CONV_MODE
#define CONV_MODE 0
#endif

constexpr int DM = 1024, M_P = 8192, M_S = 2048, M = M_P + M_S, DFF = 2816, NFF = 2 * DFF, NMIX = 4096;
constexpr int T_P = 256, T_S = 1024, PAST = 512, TK_S = PAST + T_S, NB_P = 32, NB_S = 2;
constexpr float EPS = 1e-6f;
constexpr float QSCALE = 0.125f * 1.4426950408889634f;
constexpr float LAM_INIT = 0.2f;
constexpr size_t OUT_Y = 0, OUT_K = (size_t)M * DM, OUT_V = OUT_K + (size_t)M_P * 512, OUT_S = OUT_V + (size_t)M_P * 512, OUT_END = OUT_S + (size_t)NB_P * 2 * 4 * 128 * 128;
constexpr int PC_Q = 0, PC_I = 512, PC_FF = 1024, PC_FB = 1536, PC_G = 2048, PC_AQ = 2560, PC_AK = 3072, PC_AV = 3584;

constexpr size_t MiB = 1u << 20;
constexpr size_t WS_CTL = 0, CTL_ZERO_BYTES = 192 * 1024;
constexpr size_t WS_MADA = 64 * 1024;
constexpr size_t WS_LB = 1 * MiB + 128 * 1024;
constexpr size_t WS_ROPE = 1 * MiB + 256 * 1024;
constexpr size_t WS_W1I = 2 * MiB, WS_W1O = 13 * MiB, WS_WMI = 19 * MiB, WS_WMO = 27 * MiB, WS_W2I = 29 * MiB, WS_W2O = 40 * MiB;
constexpr size_t WS_ABUF = 46 * MiB;
constexpr size_t WS_BIG = 66 * MiB;
constexpr size_t WS_SLAB = 122 * MiB;
constexpr size_t WS_QB = 146 * MiB;
constexpr size_t WS_KB = 156 * MiB;
constexpr size_t WS_KS = 164 * MiB;
constexpr size_t WS_VTP = 167 * MiB;
constexpr size_t WS_VTS = 175 * MiB;
constexpr size_t WS_OF = 178 * MiB, WS_OB = 198 * MiB;
constexpr size_t WS_ABUF2 = 218 * MiB;
constexpr size_t WS_ROWSS = 238 * MiB;
constexpr size_t WS_BIAS2 = 239 * MiB;
constexpr size_t WS_HSAVE = 240 * MiB;
constexpr size_t WS_END = 241 * MiB;
constexpr int CW_BAR = 4096;
constexpr int CW_QUEUE = 64;
constexpr int CW_MADA = 768;
constexpr int CW_CONVQ = 512;
constexpr int CW_LBAR = 10496;
#ifndef LOCAL_SEAMS
#define LOCAL_SEAMS 1
#endif
constexpr int CW_PANEL1 = 8192, CW_PANEL2 = 8832, CW_UNIT1 = 9472, CW_UNIT2 = 9984;

constexpr int RING_OFF = 0, RING_BYTES = 131072;
constexpr int LDSCTL_OFF = RING_BYTES, MISC_OFF = LDSCTL_OFF + 320;
constexpr int LDS_BYTES = 147456;

#define GAS __attribute__((address_space(1)))
#define LAS __attribute__((address_space(3)))
typedef unsigned short bf16;
typedef unsigned v4u __attribute__((ext_vector_type(4)));
typedef unsigned v2u __attribute__((ext_vector_type(2)));
typedef float f32x4 __attribute__((ext_vector_type(4)));
typedef float f32x2 __attribute__((ext_vector_type(2)));
typedef float f32x16 __attribute__((ext_vector_type(16)));
typedef short bf16x8 __attribute__((ext_vector_type(8)));
typedef short s16x4 __attribute__((ext_vector_type(4)));
typedef GAS unsigned gu32;
#define RLX_AGENT __ATOMIC_RELAXED, __HIP_MEMORY_SCOPE_AGENT
#define LDS_WAIT() asm volatile("s_waitcnt lgkmcnt(0)" ::: "memory")
#define VM_WAIT() asm volatile("s_waitcnt vmcnt(0)" ::: "memory")
#define LDS_BARRIER() do { asm volatile("s_waitcnt lgkmcnt(0)" ::: "memory"); __builtin_amdgcn_s_barrier(); asm volatile("" ::: "memory"); } while (0)
__device__ __forceinline__ unsigned f2bf(float f) { unsigned u = __builtin_bit_cast(unsigned, f); return (u + 0x7fffu + ((u >> 16) & 1u)) >> 16; }
typedef __bf16 bf16x2_t __attribute__((ext_vector_type(2)));
typedef _Float16 h2_t __attribute__((ext_vector_type(2)));
__device__ __forceinline__ unsigned pkh2(float lo, float hi) { const h2_t h = {(_Float16)lo, (_Float16)hi}; return __builtin_bit_cast(unsigned, h); }
__device__ __forceinline__ unsigned pk2(float lo, float hi) { const f32x2 v = {lo, hi}; const bf16x2_t b = __builtin_convertvector(v, bf16x2_t); return __builtin_bit_cast(unsigned, b); }
__device__ __forceinline__ float bflo(unsigned w) { return __builtin_bit_cast(float, w << 16); }
__device__ __forceinline__ float bfhi(unsigned w) { return __builtin_bit_cast(float, w & 0xffff0000u); }
__device__ __forceinline__ float wave_sum(float v) {
#pragma unroll
    for (int o = 1; o < 64; o <<= 1) v += __shfl_xor(v, o);
    return v;
}
__device__ __forceinline__ float sigmoid_f(float x) { return __builtin_amdgcn_rcpf(1.0f + __builtin_amdgcn_exp2f(-1.4426950408889634f * x)); }
#define XB_TMO      128
#define XB_XCNT(j)  (256  + 64 * (j))
#define XB_XSUB(j)  (1280 + 64 * (j))
#define XB_XGEN(j)  (2304 + 64 * (j))
#define XB_TOP      3328
#define XB_TOPGEN   3392
#define XCD_BAR_WORDS 3456
#define XB_SPIN_CAP (1u << 18)

__device__ __forceinline__ unsigned xb_ld(unsigned* p)              { return __hip_atomic_load(p, __ATOMIC_RELAXED, __HIP_MEMORY_SCOPE_AGENT); }
__device__ __forceinline__ unsigned xb_add(unsigned* p, unsigned v) { return __hip_atomic_fetch_add(p, v, __ATOMIC_RELAXED, __HIP_MEMORY_SCOPE_AGENT); }
__device__ __forceinline__ unsigned xb_xcc_id() { return (unsigned)__builtin_amdgcn_s_getreg((3 << 11) | 20) & 0xFu; }
#define XB_SPIN(cond, bar) do { unsigned _sp = 0; while (cond) { __builtin_amdgcn_s_sleep(1); \
    if ((++_sp & 255u) == 0u) { if (xb_ld(&(bar)[XB_TMO])) break; if (_sp > XB_SPIN_CAP) { atomicAdd(&(bar)[XB_TMO], 1u); break; } } } } while (0)

struct XcdBarrier {
    unsigned* bar; unsigned x;
    volatile LAS unsigned* st;
};

__device__ __forceinline__ XcdBarrier xcd_barrier_post(unsigned* bar, volatile LAS unsigned* st) {
    XcdBarrier b; b.bar = bar; b.x = xb_xcc_id(); b.st = st;
    if (threadIdx.x == 0) st[2] = xb_add(&bar[XB_XCNT(b.x)], 1u);
    return b;
}
__device__ __forceinline__ void xcd_barrier_complete(unsigned* bar, unsigned x, unsigned& nloc, unsigned& nx) {
    const unsigned G = gridDim.x * gridDim.y * gridDim.z;
    unsigned sum, cnt, mine, sp = 0u;
    for (;;) {
        sum = 0u; cnt = 0u; mine = 0u;
#pragma unroll
        for (unsigned j = 0; j < 16; ++j) { const unsigned c = xb_ld(&bar[XB_XCNT(j)]); sum += c; cnt += (c > 0u) ? 1u : 0u; mine = (j == x) ? c : mine; }
        if (sum == G) break;
        __builtin_amdgcn_s_sleep(1);
        if ((++sp & 255u) == 0u) { if (xb_ld(&bar[XB_TMO])) break; if (sp > XB_SPIN_CAP) { atomicAdd(&bar[XB_TMO], 1u); break; } }
    }
    nloc = mine > 0u ? mine : 1u; nx = cnt > 0u ? cnt : 1u;
}
__device__ __forceinline__ unsigned xcd_census_even(unsigned* bar) {
    const unsigned G = gridDim.x * gridDim.y * gridDim.z; bool ok = (G % 8u) == 0u;
#pragma unroll
    for (unsigned j = 0; j < 16; ++j) { const unsigned c = xb_ld(&bar[XB_XCNT(j)]); ok = ok && (c == (j < 8u ? G / 8u : 0u)); }
    return ok ? 1u : 2u;
}

__device__ __forceinline__ void xcd_barrier(const XcdBarrier& b) {
    asm volatile("s_waitcnt vmcnt(0)" ::: "memory");
    __syncthreads();
    if (threadIdx.x == 0) {
        unsigned* bar = b.bar;
        __builtin_amdgcn_s_waitcnt(0);
        unsigned nloc = b.st[0], nx = b.st[1];
        if (nloc == 0u) { xcd_barrier_complete(bar, b.x, nloc, nx); b.st[0] = nloc; b.st[1] = nx; b.st[3] = xcd_census_even(bar); }
        const unsigned old = xb_add(&bar[XB_XSUB(b.x)], 1u);
        const unsigned gen = old / nloc;
        if (old + 1u == (gen + 1u) * nloc) {
            __builtin_amdgcn_fence(__ATOMIC_RELEASE, "agent");
            asm volatile("s_waitcnt vmcnt(0)" ::: "memory");
            const unsigned og = xb_add(&bar[XB_TOP], 1u);
            const unsigned tg = og / nx;
            if (og + 1u == (tg + 1u) * nx) xb_add(&bar[XB_TOPGEN], 1u);
            else XB_SPIN(xb_ld(&bar[XB_TOPGEN]) == tg, bar);
            __builtin_amdgcn_fence(__ATOMIC_ACQUIRE, "agent");
            xb_add(&bar[XB_XGEN(b.x)], 1u);
            asm volatile("s_waitcnt vmcnt(0)" ::: "memory");
        } else {
            XB_SPIN(xb_ld(&bar[XB_XGEN(b.x)]) == gen, bar);
            __builtin_amdgcn_fence(__ATOMIC_ACQUIRE, "agent");
            asm volatile("s_waitcnt vmcnt(0)" ::: "memory");
        }
    }
    __syncthreads();
}

__device__ __forceinline__ void xcc_barrier(const XcdBarrier& b, unsigned* lsub) {
    asm volatile("s_waitcnt vmcnt(0)" ::: "memory");
    __syncthreads();
    if (threadIdx.x == 0) {
        const unsigned nloc = b.st[0];
        unsigned* c = lsub + 64 * b.x;
        const unsigned old = xb_add(c, 1u), target = (old / nloc + 1u) * nloc;
        XB_SPIN(xb_ld(c) < target, b.bar);
        __builtin_amdgcn_fence(__ATOMIC_ACQUIRE, "agent");
        asm volatile("s_waitcnt vmcnt(0)" ::: "memory");
    }
    __syncthreads();
}

struct Frame {
    LAS unsigned char* lds;
    volatile LAS unsigned* MISC;
    gu32* ctl;
    int tid, lane, wave;
    int vcu, G;
    int xl, xr, xok;
    const float *x_prompt, *x_sample, *c, *cache_k, *cache_v, *state0, *c_ctx, *w_ada, *b_ada, *norm_ffn1, *w_ffn1_in, *w_ffn1_out, *norm_mix, *w_mix_in, *w_mix_out,
                *lb_logits, *hgrn_out_norm, *q_norm, *k_norm, *attn_lambda, *attn_subln, *norm_ffn2, *w_ffn2_in, *w_ffn2_out;
    float* out;
    float *mada, *rope, *lbv, *bias2m, *bias2f, *rowss, *hsave; bf16 *W1I, *W1O, *WMI, *WMO, *W2I, *W2O, *ABUF, *ABUF2, *HID, *PROJ, *QB, *KB, *KS, *VTP, *VTS, *OF, *OB;
};

constexpr int CV_FI = (DM / 64) * (NFF / 32), CV_FO = (DFF / 64) * (DM / 32), CV_MI = (DM / 64) * (NMIX / 32), CV_MO = (DM / 64) * (DM / 32);
#ifndef CONV_P9
#define CONV_P9 0
#endif
#ifndef CONV_LATE_P3
#define CONV_LATE_P3 0
#endif
#ifndef CONV_P2TAIL
#define CONV_P2TAIL 1
#endif
constexpr int CV_P0_N = CONV_P2TAIL ? CV_FI : CV_FI + CV_FO + CV_MI;
constexpr int CV_LATE0 = CV_FI + CV_FO + CV_MI, CV_LATE_N = CV_MO + CV_FI + CV_FO;
template <int MODE>
__device__ __forceinline__ void p0_transpose_item(const float* W, int K, int N, bf16* WT, LAS float* scr, int item, int lane) {
    const int nblk = N / 32, kb = item / nblk, nb = item % nblk, k0 = 64 * kb, n0 = 32 * nb;
    int drow0 = n0;
    if (MODE == 1) { const int half = n0 / DFF, r = n0 % DFF; drow0 = (r / 128) * 256 + half * 128 + (r % 128); }
    float tv[32];
    const float* wp = W + (size_t)(k0 + (lane >> 5)) * N + n0 + (lane & 31);
#pragma unroll
    for (int i = 0; i < 32; ++i) tv[i] = __builtin_nontemporal_load(wp + (size_t)(2 * i) * N);
#pragma unroll
    for (int i = 0; i < 32; ++i) scr[(2 * i + (lane >> 5)) * 33 + (lane & 31)] = tv[i];
    LDS_WAIT(); asm volatile("" ::: "memory");
    const int c = lane & 7;
#pragma unroll
    for (int j = 0; j < 4; ++j) { const int n = (lane >> 3) + 8 * j; const LAS float* s = scr + (8 * c) * 33 + n;
        v4u o; o.x = pk2(s[0 * 33], s[1 * 33]); o.y = pk2(s[2 * 33], s[3 * 33]); o.z = pk2(s[4 * 33], s[5 * 33]); o.w = pk2(s[6 * 33], s[7 * 33]);
        *(GAS v4u*)(WT + (size_t)(drow0 + n) * K + k0 + 8 * c) = o; }
    LDS_WAIT(); asm volatile("" ::: "memory");
}

__device__ __forceinline__ void convert_item(Frame& F, LAS float* scr, int it) {
    int r = it;
    if (r < CV_FI) { p0_transpose_item<1>(F.w_ffn1_in, DM, NFF, F.W1I, scr, r, F.lane); return; } r -= CV_FI;
    if (r < CV_FO) { p0_transpose_item<0>(F.w_ffn1_out, DFF, DM, F.W1O, scr, r, F.lane); return; } r -= CV_FO;
    if (r < CV_MI) { p0_transpose_item<0>(F.w_mix_in, DM, NMIX, F.WMI, scr, r, F.lane); return; } r -= CV_MI;
    if (r < CV_MO) { p0_transpose_item<0>(F.w_mix_out, DM, DM, F.WMO, scr, r, F.lane); return; } r -= CV_MO;
    if (r < CV_FI) { p0_transpose_item<1>(F.w_ffn2_in, DM, NFF, F.W2I, scr, r, F.lane); return; } r -= CV_FI;
    p0_transpose_item<0>(F.w_ffn2_out, DFF, DM, F.W2O, scr, r, F.lane);
}
__device__ __forceinline__ void convert_queue(Frame& F, int qword, int first, int n) {
    LAS float* scr = (LAS float*)(F.lds + RING_OFF + F.wave * 16384);
    volatile LAS int* qslot = (volatile LAS int*)(F.lds + MISC_OFF + 64);
    for (;;) {
        if (F.tid == 0) *qslot = (int)__hip_atomic_fetch_add(F.ctl + qword, 1u, RLX_AGENT);
        __syncthreads();
        const int bt = *qslot;
        __syncthreads();
        if (bt * 8 >= n) break;
        { const int it = bt * 8 + F.wave; if (it < n) convert_item(F, scr, first + it); }
    }
}
__device__ __forceinline__ void p0_prologue(Frame& F) {
    if (F.vcu < 144) {
        LAS float* sS = (LAS float*)(F.lds);
        LAS float* red = (LAS float*)(F.lds + 12288);
        for (int i = F.tid; i < 3072; i += NWAVES * 64) { const int cond = i >> 10, k = i & 1023; const float cv = cond == 0 ? F.c_ctx[k] : F.c[(cond - 1) * 1024 + k]; sS[i] = cv * sigmoid_f(cv); }
        __syncthreads();
        const int cb = F.vcu % 36, kq = F.vcu / 36, col = cb * 256 + 4 * F.lane, k0 = kq * 256 + F.wave * 32;
        f32x4 a0 = {0.f, 0.f, 0.f, 0.f}, a1 = a0, a2 = a0;
#pragma unroll
        for (int hb = 0; hb < 2; ++hb) { f32x4 wv[16];
#pragma unroll
            for (int kk = 0; kk < 16; ++kk) wv[kk] = __builtin_nontemporal_load((const f32x4*)(F.w_ada + (size_t)(k0 + hb * 16 + kk) * 9216 + col));
#pragma unroll
            for (int kk = 0; kk < 16; ++kk) { const int k = k0 + hb * 16 + kk; a0 += wv[kk] * sS[k]; a1 += wv[kk] * sS[1024 + k]; a2 += wv[kk] * sS[2048 + k]; } }
        *(LAS f32x4*)(red + (F.wave * 3 + 0) * 256 + 4 * F.lane) = a0; *(LAS f32x4*)(red + (F.wave * 3 + 1) * 256 + 4 * F.lane) = a1; *(LAS f32x4*)(red + (F.wave * 3 + 2) * 256 + 4 * F.lane) = a2;
        __syncthreads();
        for (int o = F.tid; o < 768; o += NWAVES * 64) { const int cond = o >> 8, cc = o & 255; float s = kq == 0 ? F.b_ada[cb * 256 + cc] : 0.f;
#pragma unroll
            for (int w = 0; w < 8; ++w) s += red[(w * 3 + cond) * 256 + cc];
            atomicAdd(F.mada + cond * 9216 + cb * 256 + cc, s); }
        asm volatile("s_waitcnt vmcnt(0)" ::: "memory");
        __syncthreads();
        if (cb < 8 && F.tid == 0) { __builtin_amdgcn_fence(__ATOMIC_RELEASE, "agent"); asm volatile("s_waitcnt vmcnt(0)" ::: "memory"); (void)__hip_atomic_fetch_add(F.ctl + CW_MADA, 1u, RLX_AGENT); }
    }
    if (F.vcu == F.G - 1) { const int k = F.tid; F.lbv[k] = 1.0f / (1.0f + __expf(F.lb_logits[512 + k] - F.lb_logits[k])); }
    { const int gid = (F.vcu * NWAVES + F.wave) * 64 + F.lane;
      if (gid < 1024 * 32) { const int t = gid >> 5, j = gid & 31, i = j & 15; const float pos = (j < 16) ? (float)(t >> 6) : (float)(t & 63);
          const float inv = exp2f(-(float)i * (13.287712379549449f / 16.0f));
          float sn, cs; sincosf(pos * inv, &sn, &cs); F.rope[gid] = cs; F.rope[32768 + gid] = sn; } }
    LAS float* scr = (LAS float*)(F.lds + RING_OFF + F.wave * 16384);
    const int gw = F.vcu * NWAVES + F.wave, NGW = F.G * NWAVES;
#if CONV_MODE == 0
    (void)gw; (void)NGW; (void)scr; convert_queue(F, CW_CONVQ + 128, 0, CV_P0_N);
#else
    for (int it = gw; it < CV_FI; it += NGW) p0_transpose_item<1>(F.w_ffn1_in, DM, NFF, F.W1I, scr, it, F.lane);
#endif
}
__device__ __forceinline__ void wait_mada01(Frame& F) {
    if (F.tid == 0) { unsigned sp = 0;
        while (__hip_atomic_load(F.ctl + CW_MADA, RLX_AGENT) < 32u) { __builtin_amdgcn_s_sleep(2); if (++sp > (1u << 22)) break; }
        __builtin_amdgcn_fence(__ATOMIC_ACQUIRE, "agent"); asm volatile("s_waitcnt vmcnt(0)" ::: "memory"); }
    __syncthreads();
}
__device__ __forceinline__ void norm_mod_phase(Frame& F, const float* src0, const float* src1, const float* nw, int sh_chunk, int sc_chunk) {
    const int xl = F.xl, wl = F.xr * NWAVES + F.wave, NWL = (F.G / 8) * NWAVES;
    f32x4 a4[4], h4[4]; int cur = -1;
    for (int rl = wl; rl < M / 8; rl += NWL) { const int row = xl * (M / 8) + rl;
        const float* xr = row < M_P ? src0 + (size_t)row * DM : src1 + (size_t)(row - M_P) * DM;
        const int cond = row < M_P ? 0 : 1 + ((row - M_P) >> 10);
        f32x4 v[4]; float ss = 0.f;
#pragma unroll
        for (int j = 0; j < 4; ++j) { v[j] = ((const GAS f32x4*)xr)[F.lane + 64 * j]; ss += (v[j].x * v[j].x + v[j].y * v[j].y) + (v[j].z * v[j].z + v[j].w * v[j].w); }
        if (cond != cur) { cur = cond; const float* sh = F.mada + cond * 9216 + sh_chunk * 1024; const float* sc = F.mada + cond * 9216 + sc_chunk * 1024;
#pragma unroll
            for (int j = 0; j < 4; ++j) { const int q = F.lane + 64 * j; a4[j] = ((const GAS f32x4*)nw)[q] * (((const GAS f32x4*)sc)[q] + 1.0f); h4[j] = ((const GAS f32x4*)sh)[q]; } }
        const float rstd = 1.0f / sqrtf(wave_sum(ss) * (1.0f / DM) + EPS);
        GAS v2u* o8 = (GAS v2u*)(F.ABUF + (size_t)row * DM);
#pragma unroll
        for (int j = 0; j < 4; ++j) { const int q = F.lane + 64 * j; const f32x4 o = v[j] * rstd * a4[j] + h4[j]; v2u w; w.x = pk2(o.x, o.y); w.y = pk2(o.z, o.w); o8[q] = w; }
    }
}

__device__ __forceinline__ void bias2_rows(Frame& F, const bf16* Wt, int N, int sh_chunk, float* dst) {
    const int gw = F.vcu * NWAVES + F.wave, NGW = F.G * NWAVES, lane = F.lane;
    float sh[3][16];
#pragma unroll
    for (int c = 0; c < 3; ++c)
#pragma unroll
        for (int j = 0; j < 16; ++j) sh[c][j] = F.mada[c * 9216 + sh_chunk * 1024 + (j < 8 ? 8 * lane + j : 512 + 8 * lane + (j - 8))];
    for (int n = gw; n < N; n += NGW) {
        const v4u w0 = *(const GAS v4u*)(Wt + (size_t)n * DM + 8 * lane), w1 = *(const GAS v4u*)(Wt + (size_t)n * DM + 512 + 8 * lane);
        const float wv[16] = {bflo(w0.x), bfhi(w0.x), bflo(w0.y), bfhi(w0.y), bflo(w0.z), bfhi(w0.z), bflo(w0.w), bfhi(w0.w), bflo(w1.x), bfhi(w1.x), bflo(w1.y), bfhi(w1.y), bflo(w1.z), bfhi(w1.z), bflo(w1.w), bfhi(w1.w)};
        float a0 = 0.f, a1 = 0.f, a2 = 0.f;
#pragma unroll
        for (int j = 0; j < 16; ++j) { a0 += wv[j] * sh[0][j]; a1 += wv[j] * sh[1][j]; a2 += wv[j] * sh[2][j]; }
        a0 = wave_sum(a0); a1 = wave_sum(a1); a2 = wave_sum(a2);
        if (lane == 0) { dst[n] = a0; dst[N + n] = a1; dst[2 * N + n] = a2; }
    }
}

constexpr int N_HEADWG = NB_S * 4 * 2, HG_HEAD = 6;
template <bool SRC_F32>
__device__ __forceinline__ void vt_item(const void* src, size_t src_pitch  , bf16* dst, size_t dst_pitch, LAS unsigned short* scr, int lane) {
#pragma unroll
    for (int i = 0; i < 8; ++i) { const int id = i * 64 + lane, r = id >> 3, ch = id & 7; v4u w;
        if (SRC_F32) { const float* p = (const float*)src + (size_t)r * src_pitch + ch * 8; const f32x4 a = *(const GAS f32x4*)p, b = *(const GAS f32x4*)(p + 4);
            w.x = pk2(a.x, a.y); w.y = pk2(a.z, a.w); w.z = pk2(b.x, b.y); w.w = pk2(b.z, b.w); }
        else w = *(const GAS v4u*)((const bf16*)src + (size_t)r * src_pitch + ch * 8);
        *(LAS v4u*)(scr + r * 72 + ch * 8) = w; }
    LDS_WAIT(); asm volatile("" ::: "memory");
#pragma unroll
    for (int i = 0; i < 8; ++i) { const int id = i * 64 + lane, c = id >> 3, rc = id & 7; const LAS unsigned short* s = scr + (rc * 8) * 72 + c; v4u w;
        w.x = (unsigned)s[0] | ((unsigned)s[72] << 16); w.y = (unsigned)s[2 * 72] | ((unsigned)s[3 * 72] << 16); w.z = (unsigned)s[4 * 72] | ((unsigned)s[5 * 72] << 16); w.w = (unsigned)s[6 * 72] | ((unsigned)s[7 * 72] << 16);
        *(GAS v4u*)(dst + (size_t)c * dst_pitch + rc * 8) = w; }
    LDS_WAIT(); asm volatile("" ::: "memory");
}

__device__ __forceinline__ void p6a_prep(Frame& F) {
    const int gw = ((int)blockIdx.x - N_HEADWG) * NWAVES + F.wave, NGW = (F.G - N_HEADWG) * NWAVES, lane = F.lane;
    const int d0 = 8 * (lane & 7);
    float qw[8], kw[8];
#pragma unroll
    for (int j = 0; j < 8; ++j) { qw[j] = F.q_norm[d0 + j]; kw[j] = F.k_norm[d0 + j]; }
    for (int row = gw; row < M; row += NGW) {
        const bf16* pr = F.PROJ + (size_t)row * NMIX;
        const v4u qa = *(const GAS v4u*)(pr + PC_AQ + 8 * lane), ka = *(const GAS v4u*)(pr + PC_AK + 8 * lane);
        float q[8] = {bflo(qa.x), bfhi(qa.x), bflo(qa.y), bfhi(qa.y), bflo(qa.z), bfhi(qa.z), bflo(qa.w), bfhi(qa.w)};
        float k[8] = {bflo(ka.x), bfhi(ka.x), bflo(ka.y), bfhi(ka.y), bflo(ka.z), bfhi(ka.z), bflo(ka.w), bfhi(ka.w)};
        float sq = 0.f, sk = 0.f;
#pragma unroll
        for (int j = 0; j < 8; ++j) { sq += q[j] * q[j]; sk += k[j] * k[j]; }
        sq += __shfl_xor(sq, 1); sq += __shfl_xor(sq, 2); sq += __shfl_xor(sq, 4);
        sk += __shfl_xor(sk, 1); sk += __shfl_xor(sk, 2); sk += __shfl_xor(sk, 4);
        const float rq = 1.0f / sqrtf(sq * (1.0f / 64.0f) + EPS), rk = 1.0f / sqrtf(sk * (1.0f / 64.0f) + EPS);
#pragma unroll
        for (int j = 0; j < 8; ++j) { q[j] = q[j] * rq * qw[j]; k[j] = k[j] * rk * kw[j]; }
        if (row < M_P) {
            float* ok = F.out + OUT_K + (size_t)row * 512 + 8 * lane;
            *(GAS f32x4*)ok = (f32x4){k[0], k[1], k[2], k[3]}; *(GAS f32x4*)(ok + 4) = (f32x4){k[4], k[5], k[6], k[7]};
            v4u w; w.x = pk2(k[0], k[1]); w.y = pk2(k[2], k[3]); w.z = pk2(k[4], k[5]); w.w = pk2(k[6], k[7]);
            *(GAS v4u*)(F.KB + (size_t)row * 512 + 8 * lane) = w;
        } else {
            const int rs = row - M_P, b = rs >> 10, t = rs & 1023, g8 = lane & 7;
            const bool first = (g8 & 2) == 0; const int tc = ((g8 >= 4) ? 16 : 0) + 8 * (g8 & 1);
            const float* cs = F.rope + t * 32 + tc; const float* sn = F.rope + 32768 + t * 32 + tc;
#pragma unroll
            for (int j = 0; j < 8; ++j) { const float c = cs[j], s = sn[j]; const float pq = __shfl_xor(q[j], 2), pk = __shfl_xor(k[j], 2);
                q[j] = first ? q[j] * c - pq * s : q[j] * c + pq * s; k[j] = first ? k[j] * c - pk * s : k[j] * c + pk * s; }
            v4u w; w.x = pk2(k[0], k[1]); w.y = pk2(k[2], k[3]); w.z = pk2(k[4], k[5]); w.w = pk2(k[6], k[7]);
            *(GAS v4u*)(F.KS + ((size_t)b * TK_S + PAST + t) * 512 + 8 * lane) = w;
        }
        v4u w; w.x = pk2(q[0] * QSCALE, q[1] * QSCALE); w.y = pk2(q[2] * QSCALE, q[3] * QSCALE); w.z = pk2(q[4] * QSCALE, q[5] * QSCALE); w.w = pk2(q[6] * QSCALE, q[7] * QSCALE);
        *(GAS v4u*)(F.QB + (size_t)row * 512 + 8 * lane) = w;
    }
    for (int r = gw; r < NB_S * PAST; r += NGW) { const int b = r >> 9, j = r & 511; const float* p = F.cache_k + (size_t)r * 512 + 8 * lane;
        const f32x4 a = *(const GAS f32x4*)p, bb = *(const GAS f32x4*)(p + 4); v4u w; w.x = pk2(a.x, a.y); w.y = pk2(a.z, a.w); w.z = pk2(bb.x, bb.y); w.w = pk2(bb.z, bb.w);
        *(GAS v4u*)(F.KS + ((size_t)b * TK_S + j) * 512 + 8 * lane) = w; }
    LAS unsigned short* scr = (LAS unsigned short*)(F.lds + RING_OFF + F.wave * 16384);
    constexpr int IT_P = NB_P * 4 * 4 * 2, IT_SL = NB_S * 4 * 16 * 2, IT_SC = NB_S * 4 * 8 * 2;
    for (int it = gw; it < IT_P + IT_SL + IT_SC; it += NGW) {
        if (it < IT_P) { const int bh = it >> 3, tb = (it >> 1) & 3, db = it & 1, b = bh >> 2, h = bh & 3;
            vt_item<false>(F.PROJ + ((size_t)b * T_P + tb * 64) * NMIX + PC_AV + h * 128 + db * 64, NMIX, F.VTP + ((size_t)bh * 128 + db * 64) * T_P + tb * 64, T_P, scr, lane); }
        else if (it < IT_P + IT_SL) { const int r = it - IT_P, bh = r >> 5, tb = (r >> 1) & 15, db = r & 1, b = bh >> 2, h = bh & 3;
            vt_item<false>(F.PROJ + ((size_t)M_P + b * T_S + tb * 64) * NMIX + PC_AV + h * 128 + db * 64, NMIX, F.VTS + ((size_t)bh * 128 + db * 64) * TK_S + PAST + tb * 64, TK_S, scr, lane); }
        else { const int r = it - IT_P - IT_SL, bh = r >> 4, tb = (r >> 1) & 7, db = r & 1, b = bh >> 2, h = bh & 3;
            vt_item<true>(F.cache_v + ((size_t)b * PAST + tb * 64) * 512 + h * 128 + db * 64, 512, F.VTS + ((size_t)bh * 128 + db * 64) * TK_S + tb * 64, TK_S, scr, lane); }
    }
}

constexpr int HG_QT = 0, HG_KT = 8192, HG_KH = 16384, HG_VT = 24576, HG_PE = 32768, HG_BUF = 33792, HG_GT = 2 * HG_BUF, HG_GTB = 4096;
#define MFMA16(a, b, c) __builtin_amdgcn_mfma_f32_16x16x32_bf16(a, b, c, 0, 0, 0)
__device__ __forceinline__ void hgrn_unit(Frame& F, int row_base, int T, int h, int dir, const float* s0, float* sfin, bf16* obuf, int c_begin, int c_end) {
    LAS unsigned char* L = F.lds;
    int tid_ = F.tid; asm volatile("" : "+v"(tid_));
    const int tid = tid_, lane = tid & 63, w = F.wave, r = lane & 15, g = lane >> 4, kp = tid & 63, tg = w;
    f32x4 S[8];
#pragma unroll
    for (int t8 = 0; t8 < 8; ++t8)
#pragma unroll
        for (int i = 0; i < 4; ++i) S[t8][i] = s0 ? s0[(size_t)(16 * t8 + 4 * g + i) * 128 + 16 * w + r] : 0.f;
    const int cq = PC_Q + h * 128 + 2 * kp, cf = (dir == 0 ? PC_FF : PC_FB) + h * 128 + 2 * kp, ci = PC_I + h * 128 + 2 * kp;
    unsigned rq[4], rx[4], rv[4];
    const int tsgn = dir == 0 ? 1 : -1, tbase = dir == 0 ? 0 : T - 1;
    const int nch = c_end;
#define HG_L(c_) do { const int cc_ = (c_) < nch ? (c_) : nch - 1;     \
        _Pragma("unroll") for (int i = 0; i < 4; ++i) { const int tt = 32 * cc_ + 4 * tg + i, ta = tbase + tsgn * tt; const bf16* pr = F.PROJ + (size_t)(row_base + ta) * NMIX; \
        rq[i] = *(const GAS unsigned*)(pr + cq); rx[i] = *(const GAS unsigned*)(pr + cf); rv[i] = *(const GAS unsigned*)(pr + ci); } } while (0)
#define HG_P1(c_) do { { float acc0 = 0.f, acc1 = 0.f; \
        _Pragma("unroll") for (int i = 0; i < 4; ++i) { const h2_t lf = __builtin_bit_cast(h2_t, rx[i]); acc0 += (float)lf[0]; acc1 += (float)lf[1]; } \
        *(LAS f32x2*)(L + HG_GT + ((c_) & 1) * HG_GTB + (tg * 128 + 2 * kp) * 4) = (f32x2){acc0, acc1}; } } while (0)
#define HG_P2(c_) do { { LAS unsigned char* Lb = L + ((c_) & 1) * HG_BUF; const LAS unsigned char* Gt = L + HG_GT + ((c_) & 1) * HG_GTB; f32x2 off = {0.f, 0.f}, be = {0.f, 0.f}; \
        _Pragma("unroll") for (int g2 = 0; g2 < 8; ++g2) { const f32x2 v2 = *(const LAS f32x2*)(Gt + (g2 * 128 + 2 * kp) * 4); if (g2 < tg) off += v2; be += v2; } \
        float kh[2][4]; float b0 = off.x, b1 = off.y; \
        _Pragma("unroll") for (int i = 0; i < 4; ++i) { const int t = 4 * tg + i; const h2_t lf = __builtin_bit_cast(h2_t, rx[i]); const float l0 = (float)lf[0], l1 = (float)lf[1]; b0 += l0; b1 += l1; \
            const float B0 = fmaxf(b0, -80.f), B1 = fmaxf(b1, -80.f); \
            const float qt0 = bflo(rq[i]) * __expf(B0), qt1 = bfhi(rq[i]) * __expf(B1), kt0 = (1.0f - __expf(l0)) * __expf(-B0), kt1 = (1.0f - __expf(l1)) * __expf(-B1); kh[0][i] = kt0; kh[1][i] = kt1; \
            const int a = t * 256 + ((((kp >> 2) ^ (t & 15))) << 4) + (kp & 3) * 4; \
            *(LAS unsigned*)(Lb + HG_QT + a) = pk2(qt0, qt1); *(LAS unsigned*)(Lb + HG_KT + a) = pk2(kt0, kt1); } \
        _Pragma("unroll") for (int e = 0; e < 2; ++e) { const int k = 2 * kp + e; const int a = (((k >> 4) * 4 + (tg >> 1)) * 16 + (k & 15)) * 16 + 8 * (tg & 1); \
            *(LAS v2u*)(Lb + HG_KH + a) = (v2u){pk2(kh[e][0], kh[e][1]), pk2(kh[e][2], kh[e][3])}; \
            v2u vw; if (e == 0) { vw.x = (rv[0] & 0xffffu) | (rv[1] << 16); vw.y = (rv[2] & 0xffffu) | (rv[3] << 16); } else { vw.x = (rv[0] >> 16) | (rv[1] & 0xffff0000u); vw.y = (rv[2] >> 16) | (rv[3] & 0xffff0000u); } \
            *(LAS v2u*)(Lb + HG_VT + a) = vw; } \
        if (tg == 0) *(LAS f32x2*)(Lb + HG_PE + 2 * kp * 4) = (f32x2){__expf(be.x), __expf(be.y)}; } } while (0)
    HG_L(c_begin);
    for (int c = c_begin; c < nch; ++c) {
        HG_P1(c);
        LDS_BARRIER();
        HG_P2(c); HG_L(c + 1);
        LDS_BARRIER();
        const LAS unsigned char* Lb = L + (c & 1) * HG_BUF;
        f32x4 d00 = {0.f, 0.f, 0.f, 0.f}, d01 = d00, d11 = d00;
#pragma unroll
        for (int ks = 0; ks < 4; ++ks) { const int co = (((4 * ks + g) ^ r) << 4);
            const bf16x8 kt0 = *(const LAS bf16x8*)(Lb + HG_KT + r * 256 + co), kt1 = *(const LAS bf16x8*)(Lb + HG_KT + (16 + r) * 256 + co);
            const bf16x8 qt0 = *(const LAS bf16x8*)(Lb + HG_QT + r * 256 + co), qt1 = *(const LAS bf16x8*)(Lb + HG_QT + (16 + r) * 256 + co);
            d00 = MFMA16(kt0, qt0, d00); d01 = MFMA16(kt0, qt1, d01); d11 = MFMA16(kt1, qt1, d11); }
        asm volatile("" ::: "memory");
#pragma unroll
        for (int i = 0; i < 4; ++i) if (4 * g + i > r) { d00[i] = 0.f; d11[i] = 0.f; }
        const v4u a0w = {pk2(d00[0], d00[1]), pk2(d00[2], d00[3]), 0u, 0u}, a1w = {pk2(d01[0], d01[1]), pk2(d01[2], d01[3]), pk2(d11[0], d11[1]), pk2(d11[2], d11[3])};
        const v2u vpl = *(const LAS v2u*)(Lb + HG_VT + ((w * 4 + (g >> 1)) * 16 + r) * 16 + 8 * (g & 1)), vph = *(const LAS v2u*)(Lb + HG_VT + ((w * 4 + 2 + (g >> 1)) * 16 + r) * 16 + 8 * (g & 1));
        const bf16x8 vperm = __builtin_bit_cast(bf16x8, (v4u){vpl.x, vpl.y, vph.x, vph.y});
        const bf16x8 vnat = *(const LAS bf16x8*)(Lb + HG_VT + ((w * 4 + g) * 16 + r) * 16);
        f32x4 o0 = MFMA16(__builtin_bit_cast(bf16x8, a0w), vperm, ((f32x4){0.f, 0.f, 0.f, 0.f})), o1 = MFMA16(__builtin_bit_cast(bf16x8, a1w), vperm, ((f32x4){0.f, 0.f, 0.f, 0.f}));
        asm volatile("" ::: "memory");
#pragma unroll
        for (int kk = 0; kk < 4; ++kk) {
            const v4u sw = {pk2(S[2 * kk][0], S[2 * kk][1]), pk2(S[2 * kk][2], S[2 * kk][3]), pk2(S[2 * kk + 1][0], S[2 * kk + 1][1]), pk2(S[2 * kk + 1][2], S[2 * kk + 1][3])};
            const int c_lo = (((4 * kk + (g >> 1)) ^ r) << 4) + 8 * (g & 1), c_hi = (((4 * kk + 2 + (g >> 1)) ^ r) << 4) + 8 * (g & 1);
            const v2u p0l = *(const LAS v2u*)(Lb + HG_QT + r * 256 + c_lo), p0h = *(const LAS v2u*)(Lb + HG_QT + r * 256 + c_hi);
            const v2u p1l = *(const LAS v2u*)(Lb + HG_QT + (16 + r) * 256 + c_lo), p1h = *(const LAS v2u*)(Lb + HG_QT + (16 + r) * 256 + c_hi);
            o0 = MFMA16(__builtin_bit_cast(bf16x8, (v4u){p0l.x, p0l.y, p0h.x, p0h.y}), __builtin_bit_cast(bf16x8, sw), o0);
            o1 = MFMA16(__builtin_bit_cast(bf16x8, (v4u){p1l.x, p1l.y, p1h.x, p1h.y}), __builtin_bit_cast(bf16x8, sw), o1); }
#pragma unroll
        for (int i = 0; i < 4; ++i) { const int t0 = 32 * c + 4 * g + i, t1 = t0 + 16, ta0 = tbase + tsgn * t0, ta1 = tbase + tsgn * t1;
            obuf[(size_t)(row_base + ta0) * 512 + h * 128 + 16 * w + r] = (bf16)(pk2(o0[i], 0.f) & 0xffffu); obuf[(size_t)(row_base + ta1) * 512 + h * 128 + 16 * w + r] = (bf16)(pk2(o1[i], 0.f) & 0xffffu); }
#pragma unroll
        for (int t8 = 0; t8 < 8; ++t8) { const bf16x8 khf = *(const LAS bf16x8*)(Lb + HG_KH + ((t8 * 4 + g) * 16 + r) * 16); const f32x4 pe = *(const LAS f32x4*)(Lb + HG_PE + (16 * t8 + 4 * g) * 4);
            S[t8] = MFMA16(khf, vnat, S[t8]) * pe; }
    }
#undef HG_L
#undef HG_P1
#undef HG_P2
    if (sfin) {
#pragma unroll
        for (int t8 = 0; t8 < 8; ++t8)
#pragma unroll
            for (int i = 0; i < 4; ++i) sfin[(size_t)(16 * t8 + 4 * g + i) * 128 + 16 * w + r] = S[t8][i];
    }
    __syncthreads();
}

__device__ __forceinline__ void p6_phase(Frame& F) {
    if ((int)blockIdx.x < N_HEADWG) { const int v = (int)blockIdx.x, dir = v & 1, h = (v >> 1) & 3, b = v >> 3;
        hgrn_unit(F, M_P + b * T_S, T_S, h, dir, F.state0 + ((size_t)(b * 2 + dir) * 4 + h) * 16384, F.hsave + (size_t)v * 16384, dir == 0 ? F.OF : F.OB, 0, HG_HEAD); }
    else p6a_prep(F);
}

__device__ __forceinline__ int crow(int r, int hi) { return (r & 3) + 8 * (r >> 2) + 4 * hi; }
constexpr int AT_K = 0, AT_V = 16384, AT_STAGE = 16384 + 128 * 136, XCH_SLOT = 64 * 64 * 4;
__device__ __forceinline__ void attn_finish(Frame& F, const f32x16 (&o)[4], const LAS float* slot, float lam, int row0, int h, int lane) {
    const int r32 = lane & 31, hi = lane >> 5;
    f32x16 d[4]; float ss = 0.f;
#pragma unroll
    for (int dv = 0; dv < 4; ++dv)
#pragma unroll
        for (int r = 0; r < 16; ++r) { const float x = o[dv][r] - lam * slot[(dv * 16 + r) * 64 + lane]; d[dv][r] = x; ss += x * x; }
    ss += __shfl_xor(ss, 32);
    const float rstd = (1.0f - LAM_INIT) / sqrtf(ss * (1.0f / 128.0f) + EPS);
    bf16* orow = F.ABUF2 + (size_t)(row0 + r32) * DM + 512 + h * 128;
#pragma unroll
    for (int dv = 0; dv < 4; ++dv)
#pragma unroll
        for (int g = 0; g < 4; ++g) { const int c = 32 * dv + 8 * g + 4 * hi; const f32x4 w4 = *(const GAS f32x4*)(F.attn_subln + c);
            v2u w; w.x = pk2(d[dv][4 * g] * rstd * w4.x, d[dv][4 * g + 1] * rstd * w4.y); w.y = pk2(d[dv][4 * g + 2] * rstd * w4.z, d[dv][4 * g + 3] * rstd * w4.w);
            *(GAS v2u*)(orow + c) = w; }
}
__device__ __forceinline__ float attn_lam(Frame& F) {
    const float a = F.attn_lambda[F.lane] * F.attn_lambda[64 + F.lane], b = F.attn_lambda[128 + F.lane] * F.attn_lambda[192 + F.lane];
    return __expf(wave_sum(a)) - __expf(wave_sum(b)) + LAM_INIT;
}
__device__ __forceinline__ void attn_unit(Frame& F, const bf16* Kb, const bf16* VTb, int TK, int row0, int h) {
    LAS unsigned char* L = F.lds;
    int tid_ = F.tid; asm volatile("" : "+v"(tid_));
    const int tid = tid_, w = F.wave, lane = tid & 63, mp = w >> 2, qb = w & 3, r32 = lane & 31, hi = lane >> 5;
    const float lam = attn_lam(F);
    bf16x8 qf[4];
    { const bf16* Qp = F.QB + (size_t)(row0 + 32 * qb + r32) * 512 + h * 128 + mp * 64 + 8 * hi;
#pragma unroll
      for (int s = 0; s < 4; ++s) qf[s] = *(const GAS bf16x8*)(Qp + 16 * s); }
    f32x16 o[4];
#pragma unroll
    for (int d = 0; d < 4; ++d) o[d] = f32x16{};
    float m_run = -1e30f, l_run = 0.f;
    v4u kreg[2], vreg[2];
    const int krow0 = tid >> 4, kch = tid & 15, vrow0 = tid >> 3, vch = tid & 7;
#define AT_LOAD(kv0_) do { _Pragma("unroll") for (int i = 0; i < 2; ++i) { kreg[i] = *(const GAS v4u*)(Kb + (size_t)((kv0_) + krow0 + 32 * i) * 512 + h * 128 + kch * 8); \
        vreg[i] = *(const GAS v4u*)(VTb + (size_t)(vrow0 + 64 * i) * TK + (kv0_) + vch * 8); } } while (0)
#define AT_WRITE(st_) do { LAS unsigned char* Ls_ = L + (st_) * AT_STAGE; _Pragma("unroll") for (int i = 0; i < 2; ++i) { const int kr = krow0 + 32 * i, vr = vrow0 + 64 * i; \
        *(LAS v4u*)(Ls_ + AT_K + kr * 256 + ((kch ^ (kr & 15)) << 4)) = kreg[i]; \
        *(LAS v2u*)(Ls_ + AT_V + vr * 136 + vch * 16) = (v2u){vreg[i].x, vreg[i].y}; *(LAS v2u*)(Ls_ + AT_V + vr * 136 + vch * 16 + 8) = (v2u){vreg[i].z, vreg[i].w}; } } while (0)
    const int ntiles = TK >> 6;
    AT_LOAD(0); AT_WRITE(0);
    __syncthreads();
    for (int t = 0; t < ntiles; ++t) {
        if (t + 1 < ntiles) AT_LOAD((t + 1) * 64);
        const LAS unsigned char* Ls = L + (t & 1) * AT_STAGE;
#pragma unroll
        for (int j = 0; j < 2; ++j) {
            f32x16 p = f32x16{};
            __builtin_amdgcn_s_setprio(1);
#pragma unroll
            for (int s = 0; s < 4; ++s) { const bf16x8 kf = *(const LAS bf16x8*)(Ls + AT_K + (32 * j + r32) * 256 + (((mp * 8 + 2 * s + hi) ^ (r32 & 15)) << 4));
                p = __builtin_amdgcn_mfma_f32_32x32x16_bf16(kf, qf[s], p, 0, 0, 0); }
            __builtin_amdgcn_s_setprio(0);
            float mx = p[0];
#pragma unroll
            for (int r = 1; r < 16; ++r) mx = fmaxf(mx, p[r]);
            mx = fmaxf(mx, __shfl_xor(mx, 32));
            const float mnew = (mx > m_run + 8.0f) ? mx : m_run, alpha = __builtin_amdgcn_exp2f(m_run - mnew); m_run = mnew;
            float ls = 0.f;
#pragma unroll
            for (int r = 0; r < 16; ++r) { p[r] = __builtin_amdgcn_exp2f(p[r] - mnew); ls += p[r]; }
            l_run = l_run * alpha + ls;
            if (__any(alpha != 1.0f)) {
#pragma unroll
                for (int d = 0; d < 4; ++d)
#pragma unroll
                    for (int r = 0; r < 16; ++r) o[d][r] *= alpha; }
            __builtin_amdgcn_s_setprio(1);
#pragma unroll
            for (int s = 0; s < 2; ++s) { const v4u pw = {pk2(p[8 * s + 0], p[8 * s + 1]), pk2(p[8 * s + 2], p[8 * s + 3]), pk2(p[8 * s + 4], p[8 * s + 5]), pk2(p[8 * s + 6], p[8 * s + 7])};
#pragma unroll
                for (int d = 0; d < 4; ++d) { const LAS unsigned char* vp = Ls + AT_V + (32 * d + r32) * 136 + (32 * j + 16 * s + 4 * hi) * 2;
                    const v2u lo = *(const LAS v2u*)vp, hh = *(const LAS v2u*)(vp + 16);
                    o[d] = __builtin_amdgcn_mfma_f32_32x32x16_bf16(__builtin_bit_cast(bf16x8, (v4u){lo.x, lo.y, hh.x, hh.y}), __builtin_bit_cast(bf16x8, pw), o[d], 0, 0, 0); } }
            __builtin_amdgcn_s_setprio(0);
        }
        if (t + 1 < ntiles) AT_WRITE((t + 1) & 1);
        __syncthreads();
    }
#undef AT_LOAD
#undef AT_WRITE
    const float inv = 1.0f / (l_run + __shfl_xor(l_run, 32));
#pragma unroll
    for (int d = 0; d < 4; ++d)
#pragma unroll
        for (int r = 0; r < 16; ++r) o[d][r] *= inv;
    LAS float* slot = (LAS float*)(L + qb * XCH_SLOT);
    if (mp == 1) {
#pragma unroll
        for (int d = 0; d < 4; ++d)
#pragma unroll
            for (int r = 0; r < 16; ++r) slot[(d * 16 + r) * 64 + lane] = o[d][r];
    }
    __syncthreads();
    if (mp == 0) attn_finish(F, o, slot, lam, row0 + 32 * qb, h, lane);
    __syncthreads();
}

__device__ __forceinline__ void p6b_mixers(Frame& F, int qrun) {
    constexpr int N_HS = NB_S * 4 * 2, N_AS = NB_S * 4 * 8, N_HP = NB_P * 4 * 2, N_AP = NB_P * 4 * 2, N_ALL = N_HS + N_AS + N_HP + N_AP, N_CV = CONV_LATE_P3 ? 0 : (CONV_P9 ? CV_MO / 16 : CV_LATE_N / 16);
    volatile LAS int* qslot = (volatile LAS int*)(F.lds + MISC_OFF + 64);
    for (;;) {
        if (F.tid == 0) *qslot = (int)__hip_atomic_fetch_add(F.ctl + CW_QUEUE + 64 * qrun, 1u, RLX_AGENT);
        __syncthreads();
        int u = *qslot;
        __syncthreads();
        if (u >= N_ALL + N_CV) break;
        if (u >= N_ALL) {
            LAS float* scr = (LAS float*)(F.lds + RING_OFF + F.wave * 16384);
            for (int j = 0; j < 2; ++j) convert_item(F, scr, CV_LATE0 + (u - N_ALL) * 16 + F.wave * 2 + j);
            __syncthreads(); continue; }
#ifdef PROBE_SUB
        if (qrun) { const int cls = u < N_HS ? 0 : u < N_HS + N_AS ? 1 : u < N_HS + N_AS + N_HP ? 2 : 3; if (!((PROBE_SUB >> cls) & 1)) continue; }
#endif
        const bool is_hs = u < N_HS, is_as = !is_hs && u < N_HS + N_AS, is_hp = !is_hs && !is_as && u < N_HS + N_AS + N_HP;
        if (is_hs || is_hp) { const int v = is_hs ? u : u - N_HS - N_AS; const int dir = v & 1, h = (v >> 1) & 3, b = v >> 3;
            hgrn_unit(F, is_hs ? M_P + b * T_S : b * T_P, is_hs ? T_S : T_P, h, dir, is_hs ? F.hsave + (size_t)v * 16384 : nullptr,
                      (is_hs || qrun) ? nullptr : F.out + OUT_S + ((size_t)(b * 2 + dir) * 4 + h) * 16384, dir == 0 ? F.OF : F.OB, is_hs ? HG_HEAD : 0, is_hs ? T_S / 32 : T_P / 32); continue; }
        { const int v = is_as ? u - N_HS : u - N_HS - N_AS - N_HP;
          const int h = is_as ? (v >> 3) & 3 : (v >> 1) & 3, b = is_as ? v >> 5 : v >> 3, qo = is_as ? (v & 7) * 128 : (v & 1) * 128;
          attn_unit(F, is_as ? F.KS + (size_t)b * TK_S * 512 : F.KB + (size_t)b * T_P * 512, is_as ? F.VTS + (size_t)(b * 4 + h) * 128 * TK_S : F.VTP + (size_t)(b * 4 + h) * 128 * T_P,
                    is_as ? TK_S : T_P, (is_as ? M_P + b * T_S : b * T_P) + qo, h); }
    }
}

__device__ __forceinline__ void p7_combine(Frame& F) {
    const int lane = F.lane, xl = F.xl, wl = F.xr * NWAVES + F.wave, NWL = (F.G / 8) * NWAVES;
    float nw[8];
#pragma unroll
    for (int j = 0; j < 8; ++j) nw[j] = F.hgrn_out_norm[(8 * lane + j) & 127];
    for (int rl = wl; rl < M / 8; rl += NWL) { const int row = xl * (M / 8) + rl;
        const v4u fa = *(const GAS v4u*)(F.OF + (size_t)row * 512 + 8 * lane), ba = *(const GAS v4u*)(F.OB + (size_t)row * 512 + 8 * lane);
        const float o[8] = {bflo(fa.x) + bflo(ba.x), bfhi(fa.x) + bfhi(ba.x), bflo(fa.y) + bflo(ba.y), bfhi(fa.y) + bfhi(ba.y), bflo(fa.z) + bflo(ba.z), bfhi(fa.z) + bfhi(ba.z), bflo(fa.w) + bflo(ba.w), bfhi(fa.w) + bfhi(ba.w)};
        float ss = 0.f;
#pragma unroll
        for (int j = 0; j < 8; ++j) ss += o[j] * o[j];
        ss += __shfl_xor(ss, 1); ss += __shfl_xor(ss, 2); ss += __shfl_xor(ss, 4); ss += __shfl_xor(ss, 8);
        const float rstd = 1.0f / sqrtf(ss * (1.0f / 128.0f) + EPS);
        const v4u ga = *(const GAS v4u*)(F.PROJ + (size_t)row * NMIX + PC_G + 8 * lane);
        const float g[8] = {bflo(ga.x), bfhi(ga.x), bflo(ga.y), bfhi(ga.y), bflo(ga.z), bfhi(ga.z), bflo(ga.w), bfhi(ga.w)};
        float y[8];
#pragma unroll
        for (int j = 0; j < 8; ++j) y[j] = o[j] * rstd * nw[j] * (g[j] * sigmoid_f(g[j]));
        v4u w; w.x = pk2(y[0], y[1]); w.y = pk2(y[2], y[3]); w.z = pk2(y[4], y[5]); w.w = pk2(y[6], y[7]);
        *(GAS v4u*)(F.ABUF2 + (size_t)row * DM + 8 * lane) = w;
    }
}

struct Args { const float* in[24]; float* out; unsigned char* ws; int ph_lo, ph_hi, use_bar, pad; };
__global__ void __launch_bounds__(NWAVES * 64, 2) hymba_fwd(Args args) {
    extern __shared__ __attribute__((aligned(16))) unsigned char lds[];
    Frame F;
    F.lds = (LAS unsigned char*)lds;
    F.MISC = (volatile LAS unsigned*)(F.lds + MISC_OFF);
    F.tid = threadIdx.x; F.lane = F.tid & 63; F.wave = __builtin_amdgcn_readfirstlane(F.tid >> 6);
    F.G = gridDim.x; { const int bx = blockIdx.x; F.vcu = (F.G % 8 == 0) ? (bx % 8) * (F.G / 8) + bx / 8 : bx; }
    unsigned char* ws = args.ws;
    F.ctl = (gu32*)(ws + WS_CTL);
    F.x_prompt = args.in[0]; F.x_sample = args.in[1]; F.c = args.in[2]; F.cache_k = args.in[3]; F.cache_v = args.in[4]; F.state0 = args.in[5]; F.c_ctx = args.in[6];
    F.w_ada = args.in[7]; F.b_ada = args.in[8]; F.norm_ffn1 = args.in[9]; F.w_ffn1_in = args.in[10]; F.w_ffn1_out = args.in[11]; F.norm_mix = args.in[12]; F.w_mix_in = args.in[13]; F.w_mix_out = args.in[14];
    F.lb_logits = args.in[15]; F.hgrn_out_norm = args.in[16]; F.q_norm = args.in[17]; F.k_norm = args.in[18]; F.attn_lambda = args.in[19]; F.attn_subln = args.in[20]; F.norm_ffn2 = args.in[21];
    F.w_ffn2_in = args.in[22]; F.w_ffn2_out = args.in[23]; F.out = args.out;
    F.mada = (float*)(ws + WS_MADA); F.rope = (float*)(ws + WS_ROPE); F.lbv = (float*)(ws + WS_LB);
    F.W1I = (bf16*)(ws + WS_W1I); F.W1O = (bf16*)(ws + WS_W1O); F.WMI = (bf16*)(ws + WS_WMI); F.WMO = (bf16*)(ws + WS_WMO); F.W2I = (bf16*)(ws + WS_W2I); F.W2O = (bf16*)(ws + WS_W2O);
    F.ABUF = (bf16*)(ws + WS_ABUF); F.ABUF2 = (bf16*)(ws + WS_ABUF2); F.rowss = (float*)(ws + WS_ROWSS); F.bias2m = (float*)(ws + WS_BIAS2); F.bias2f = F.bias2m + 3 * 4096; F.hsave = (float*)(ws + WS_HSAVE); F.HID = (bf16*)(ws + WS_BIG); F.PROJ = (bf16*)(ws + WS_BIG); F.QB = (bf16*)(ws + WS_QB); F.KB = (bf16*)(ws + WS_KB); F.KS = (bf16*)(ws + WS_KS);
    F.VTP = (bf16*)(ws + WS_VTP); F.VTS = (bf16*)(ws + WS_VTS); F.OF = (bf16*)(ws + WS_OF); F.OB = (bf16*)(ws + WS_OB);
    for (int u = F.tid; u < (LDS_BYTES - LDSCTL_OFF) / 4; u += NWAVES * 64) ((LAS unsigned*)(F.lds + LDSCTL_OFF))[u] = 0u;
    __syncthreads();
    XcdBarrier bar; bar.bar = (unsigned*)(F.ctl + CW_BAR); bar.x = 0; bar.st = nullptr;
    if (args.use_bar) bar = xcd_barrier_post((unsigned*)(F.ctl + CW_BAR), F.MISC + 8);
    const int lo = args.ph_lo, hi = args.ph_hi;
#ifndef PROBE_DUP
#define PROBE_DUP 0u
#endif
#define IN(k) (lo <= (k) && (k) < hi)
#define SEAM_LOCAL(k) (LOCAL_SEAMS && !FUSE_NORM && !MERGE_FFN && ((k) == 1 || (k) == 3 || (k) == 9 || (k) == 10 || (k) == 11))
#define SEAM(k) do { if (IN(k) && IN((k) + 1) && !(MERGE_FFN && !FUSE_NORM && ((k) == 2 || (k) == 11))) { if (SEAM_LOCAL(k) && F.xok) xcc_barrier(bar, cw + CW_LBAR); else xcd_barrier(bar); } } while (0)
#define PHASE(k, ...) if (IN(k)) { constexpr bool dupk = ((PROBE_DUP) >> (k)) & 1u; \
        if constexpr (dupk) { _Pragma("unroll 1") for (int qrun = 0; qrun < 2; ++qrun) { if (qrun) xcd_barrier(bar); __VA_ARGS__ } } \
        else { constexpr int qrun = 0; (void)qrun; __VA_ARGS__ } } SEAM(k)
#ifdef PROBE_EPI
#define PROBE_EPI_FLAG args.pad
#else
#define PROBE_EPI_FLAG 0
#endif
#ifdef PROBE_BMUL
#define PROBE_GEMM_HOOK if (args.pad) { g.bmul = (PROBE_BMUL) & 1; g.amul = ((PROBE_BMUL) >> 1) & 1; }
#else
#define PROBE_GEMM_HOOK
#endif
#ifndef PROBE_FFN_PART
#define PROBE_FFN_PART 0
#endif
#ifndef PROBE_FORCE_LOCAL
#define PROBE_FORCE_LOCAL 0
#endif
#define COMMA ,
#define GEMM_PHASE(EPI, A_, B_, N_, K_, ...) do { Gemm g{A_, B_, M, N_, K_}; PROBE_GEMM_HOOK; StaticOrder S; S.init(M, N_, F.G, F.xr * 8 + F.xl); typedef pg8::EPI EpiT; EpiT E{__VA_ARGS__}; \
        pg8::gemm_phase<EpiT, StaticOrder, PG8_ALIGN, PG8_SP2>(F.lds + RING_OFF, g, S, E); } while (0)
    using pg8::Gemm; using pg8::StaticOrder;
    float* const outS = F.out + (size_t)M_P * DM;
    F.xl = (int)blockIdx.x % 8; F.xr = (int)blockIdx.x / 8; F.xok = PROBE_FORCE_LOCAL;
#define RELABEL() do { if (args.use_bar && IN(0) && IN(1)) { const unsigned verdict = F.MISC[11], rk = F.MISC[10]; if (verdict == 1u && rk < (unsigned)(F.G / 8)) { F.xok = 1; F.xl = (int)bar.x; F.xr = (int)rk; } } } while (0)
    unsigned* const cw = (unsigned*)F.ctl;
#if FUSE_NORM
    PHASE(0, p0_prologue(F); );
    PHASE(1, norm_mod_phase(F, F.x_prompt, F.x_sample, F.norm_ffn1, 0, 1); bias2_rows(F, F.WMI, NMIX, 3, F.bias2m); bias2_rows(F, F.W2I, NFF, 6, F.bias2f); );
    PHASE(2, GEMM_PHASE(EpiSwiGLU<false>, F.ABUF, F.W1I, NFF, DM, F.HID, DFF, nullptr, nullptr, PROBE_EPI_FLAG); if (CONV_P2TAIL) convert_queue(F, CW_CONVQ, CV_FI, CV_FO + CV_MI); );
    PHASE(3, GEMM_PHASE(EpiResid<true COMMA true>, F.HID, F.W1O, DM, DFF, F.x_prompt, F.x_sample, F.out, F.mada + 2 * 1024, F.ABUF, F.norm_mix, F.mada + 4 * 1024, F.rowss);
             if (CONV_LATE_P3) convert_queue(F, CW_CONVQ + 64, CV_LATE0, CV_LATE_N); );
    PHASE(4, GEMM_PHASE(EpiProj<true>, F.ABUF, F.WMI, NMIX, DM, F.PROJ, F.out + OUT_V, F.lbv, F.rowss, F.bias2m); );
    PHASE(5, p6_phase(F); );
    PHASE(6, p6b_mixers(F, qrun + args.pad); );
    PHASE(7, p7_combine(F); );
    PHASE(8, GEMM_PHASE(EpiResid<true COMMA false>, F.ABUF2, F.WMO, DM, DM, F.out, outS, F.out, F.mada + 5 * 1024, F.ABUF, F.norm_ffn2, F.mada + 7 * 1024, F.rowss); );
    PHASE(9, GEMM_PHASE(EpiSwiGLU<true>, F.ABUF, F.W2I, NFF, DM, F.HID, DFF, F.rowss, F.bias2f, NFF); );
    PHASE(10, GEMM_PHASE(EpiResid<false COMMA true>, F.HID, F.W2O, DM, DFF, F.out, outS, F.out, F.mada + 8 * 1024, nullptr, nullptr, nullptr, nullptr); );
#else
    PHASE(0, p0_prologue(F); );
    RELABEL();
    PHASE(1, norm_mod_phase(F, F.x_prompt, F.x_sample, F.norm_ffn1, 0, 1); );
#if MERGE_FFN
#define FFN_MERGED(AIN, WIN, WOUT, B0, B1, GATE, PC, UC) do { \
        if (!(args.pad && PROBE_FFN_PART == 2)) { Gemm g{AIN, WIN, M, NFF, DM}; pg8::XccInOrder S{F.xl, F.xr, cw + (PC) + 4096 * args.pad, F.xok}; typedef pg8::EpiSwiGLU<false> EpiT; EpiT E{F.HID, DFF, nullptr, nullptr, 0}; \
          pg8::gemm_phase<EpiT, pg8::XccInOrder, PG8_ALIGN, PG8_SP2>(F.lds + RING_OFF, g, S, E); } \
        if (!(args.pad && PROBE_FFN_PART == 1)) { Gemm g{F.HID, WOUT, M, DM, DFF}; pg8::XccOutOrder S{F.xl, F.xr, cw + (PC) + (PROBE_FFN_PART == 2 ? 0 : 4096 * args.pad)}; typedef pg8::EpiResidSplit<true> EpiT; EpiT E{B0, B1, args.pad ? (float*)(args.ws + WS_OF) : F.out, GATE, (float*)(args.ws + WS_SLAB), cw + (UC) + 4096 * args.pad, F.xl, F.xok};     \
          pg8::gemm_phase<EpiT, pg8::XccOutOrder, PG8_ALIGN, PG8_SP2>(F.lds + RING_OFF, g, S, E); } } while (0)
    PHASE(2, FFN_MERGED(F.ABUF, F.W1I, F.W1O, F.x_prompt, F.x_sample, F.mada + 2 * 1024, CW_PANEL1, CW_UNIT1); );
    PHASE(3, ; );
#else
    PHASE(2, GEMM_PHASE(EpiSwiGLU<false>, F.ABUF, F.W1I, NFF, DM, F.HID, DFF, nullptr, nullptr, PROBE_EPI_FLAG); if (CONV_P2TAIL) convert_queue(F, CW_CONVQ, CV_FI, CV_FO + CV_MI); );
    PHASE(3, GEMM_PHASE(EpiResid<false COMMA true>, F.HID, F.W1O, DM, DFF, F.x_prompt, F.x_sample, F.out, F.mada + 2 * 1024, nullptr, nullptr, nullptr, nullptr);
             if (CONV_LATE_P3) convert_queue(F, CW_CONVQ + 64, CV_LATE0, CV_LATE_N); );
#endif
    PHASE(4, norm_mod_phase(F, F.out, outS, F.norm_mix, 3, 4); );
    PHASE(5, GEMM_PHASE(EpiProj<false>, F.ABUF, F.WMI, NMIX, DM, F.PROJ, F.out + OUT_V, F.lbv, nullptr, nullptr); );
    PHASE(6, p6_phase(F); );
    PHASE(7, p6b_mixers(F, qrun + args.pad); );
    PHASE(8, p7_combine(F); );
    PHASE(9, GEMM_PHASE(EpiResid<false COMMA false>, F.ABUF2, F.WMO, DM, DM, F.out, outS, F.out, F.mada + 5 * 1024, nullptr, nullptr, nullptr, nullptr);
             if (CONV_P9) convert_queue(F, CW_CONVQ + 192, CV_LATE0 + CV_MO, CV_FI + CV_FO); );
    PHASE(10, norm_mod_phase(F, F.out, outS, F.norm_ffn2, 6, 7); );
#if MERGE_FFN
    PHASE(11, FFN_MERGED(F.ABUF, F.W2I, F.W2O, F.out, outS, F.mada + 8 * 1024, CW_PANEL2, CW_UNIT2); );
    PHASE(12, ; );
#else
    PHASE(11, GEMM_PHASE(EpiSwiGLU<false>, F.ABUF, F.W2I, NFF, DM, F.HID, DFF, nullptr, nullptr, 0); );
    PHASE(12, GEMM_PHASE(EpiResid<false COMMA true>, F.HID, F.W2O, DM, DFF, F.out, outS, F.out, F.mada + 8 * 1024, nullptr, nullptr, nullptr, nullptr); );
#endif
#endif
#ifdef PROBE_XBAR
#pragma unroll 1
    for (int i = 0; i < PROBE_XBAR; ++i) xcd_barrier(bar);
#endif
#undef IN
#undef SEAM
#undef PHASE
#undef GEMM_PHASE
}

extern "C" void kernel_launch(void* const* d_in, const int* in_sizes, int n_in, void* d_out, int out_size, void* d_ws, size_t ws_size, hipStream_t stream) {
    static int grid = 0;
    if (grid == 0) {
        if (n_in != 24 || in_sizes[0] != M_P * DM || in_sizes[1] != M_S * DM || (size_t)out_size != OUT_END || ws_size < WS_END) {
            fprintf(stderr, "kernel_launch: unexpected shapes (n_in %d, out %d, ws %zu); nothing launched\n", n_in, out_size, ws_size); grid = -1; return; }
        int dev = 0, cus = 0, per_cu = 0;
        if (hipGetDevice(&dev) != hipSuccess || hipDeviceGetAttribute(&cus, hipDeviceAttributeMultiprocessorCount, dev) != hipSuccess) { grid = -1; return; }
        if (hipFuncSetAttribute((const void*)hymba_fwd, hipFuncAttributeMaxDynamicSharedMemorySize, LDS_BYTES) != hipSuccess) { fprintf(stderr, "kernel_launch: hipFuncSetAttribute failed\n"); grid = -1; return; }
        if (hipOccupancyMaxActiveBlocksPerMultiprocessor(&per_cu, (const void*)hymba_fwd, NWAVES * 64, LDS_BYTES) != hipSuccess || per_cu < 1) {
            fprintf(stderr, "kernel_launch: occupancy query reports %d workgroups per CU; nothing launched\n", per_cu); (void)hipGetLastError(); grid = -1; return; }
        grid = cus;
        if (grid % 8 != 0) grid -= grid % 8;
        if (MERGE_FFN && grid != 256) { fprintf(stderr, "kernel_launch: this build needs a 256-CU device (got %d workgroups); nothing launched\n", grid); grid = -1; return; }
    }
    if (grid < 0) return;
    if (hipMemsetAsync((char*)d_ws + WS_CTL, 0, CTL_ZERO_BYTES, stream) != hipSuccess) return;
    Args a{};
    for (int i = 0; i < 24; ++i) a.in[i] = (const float*)d_in[i];
    a.out = (float*)d_out; a.ws = (unsigned char*)d_ws;
#if MK_ONE_LAUNCH
    a.ph_lo = 0; a.ph_hi = N_PHASES; a.use_bar = 1;
    hipLaunchKernelGGL(hymba_fwd, dim3(grid), dim3(NWAVES * 64), LDS_BYTES, stream, a);
#ifdef PROBE_RELAUNCH
    a.ph_lo = PROBE_RELAUNCH; a.ph_hi = PROBE_RELAUNCH + 1; a.use_bar = 0; a.pad = 1;
    hipLaunchKernelGGL(hymba_fwd, dim3(grid), dim3(NWAVES * 64), LDS_BYTES, stream, a);
#endif
#else
    for (int p = 0; p < N_PHASES; ++p) { a.ph_lo = p; a.ph_hi = p + 1; a.use_bar = 0; hipLaunchKernelGGL(hymba_fwd, dim3(grid), dim3(NWAVES * 64), LDS_BYTES, stream, a); }
#endif
}
```

```cpp
#include <hip/hip_runtime.h>
#include <cstdio>
#include <cstdint>
#define MK_ONE_LAUNCH 1
#define PROBE_DUP 0u
#ifndef FP8_FFN_IN
#define FP8_FFN_IN 1
#endif
constexpr float F8_SA = 8.0f, F8_SW = 128.0f, F8_ACC = 1.0f / (F8_SA * F8_SW);
namespace pg8 {
#define PG8_LAS __attribute__((address_space(3)))
typedef unsigned short bf16_t;
typedef short bf16x8 __attribute__((ext_vector_type(8)));
typedef float f32x4 __attribute__((ext_vector_type(4)));
typedef unsigned u32x4 __attribute__((ext_vector_type(4)));
constexpr int BM = 256, BK = 64, HALF = 128, HTB = HALF * BK * 2  , STAGE_BYTES = 8 * HTB, NXCD = 8, WGM = 5;

__host__ __device__ __forceinline__ int lds_byte(int r, int c) { const int st = (r >> 4) * 2 + (c >> 5), rr = r & 15, cc = c & 31, ob = rr * 64 + cc * 2; return st * 1024 + (ob ^ (((ob >> 9) & 1) << 5)); }
__host__ __device__ __forceinline__ void stage_rc(int b, int& R, int& C) { const int st = b / 1024, sb = b % 1024, swz = sb ^ (((sb >> 9) & 1) << 5); R = (st >> 1) * 16 + swz / 64; C = (st & 1) * 32 + (swz % 64) / 2; }
__host__ __device__ __forceinline__ int perm32(int rho) { const int n = rho >> 4, i = rho & 15; return 8 * (i >> 2) + 4 * n + (i & 3); }

struct Unit { int pm, pn, k0, nk, kq; };
__host__ __device__ __forceinline__ int pmap(int t) { const unsigned q = (unsigned)(t - 30); return q <= 5u ? t + (int)((0x055554u >> (4u * q)) & 15u) - 4 : t; }
__device__ __forceinline__ void publish_wave(unsigned* cnt, int local);
struct Gemm { const bf16_t* A; const bf16_t* Bt; int M, N, K; int bmul = 1, amul = 1; };

struct StaticOrder {
    int nM, nN, nwg, G, c;
    int sf = 0; unsigned* sc = nullptr; int local = 0;
    __host__ __device__ void init(int M, int N, int G_, int c_) { nM = M / BM; nN = N / BM; nwg = nM * nN; G = G_; c = c_; }
    __host__ __device__ bool next(int i, Unit& u) const {
        int pm, pn, kq = 0; bool ok;
        if (sf && (c & 7) >= 6) {
            const int x = c & 7, r = c >> 3;
            const int j = (r < 8 || i == 0) ? r + 32 * i : 40 + (r - 8) + 24 * (i - 1);
            ok = (r < 8) ? (i < 2) : (i <= 2 && j < 80);
            const int jj = j - 40, j2 = jj - 16;
            const int p = j < 40 ? 1 + (j & 3) : (jj < 16 ? 0 : 1 + (j2 & 3));
            pn = j < 40 ? (j >> 2) : (jj < 16 ? jj : 10 + (j2 >> 2)); pm = pmap(5 * x + p); kq = j < 40 ? 9 : 0;
        } else {
            const long L = (long)i * G + c; ok = L < nwg;
            int wgid = ok ? (int)L : 0; { const int q = nwg / NXCD, r = nwg % NXCD, xcd = wgid % NXCD, off = wgid / NXCD; wgid = (xcd < r ? xcd * (q + 1) : r * (q + 1) + (xcd - r) * q) + off; }
            const int nig = WGM * nN, gid = wgid / nig, fm = gid * WGM, gsz = (nM - fm) < WGM ? (nM - fm) : WGM;
            pm = pmap(fm + ((wgid % nig) % gsz)); pn = (wgid % nig) / gsz;
        }
        u.pm = pm; u.pn = pn; u.k0 = 0; u.nk = 0; u.kq = kq; return ok;
    }
    __device__ __forceinline__ void a_ready(const Unit&) const {}
    __device__ __forceinline__ void done(const Unit& u) const { if (sf && u.kq == 9) publish_wave(sc, local); }
};


__device__ __forceinline__ unsigned cvt_pk_bf16(float lo, float hi) { unsigned r; asm volatile("v_cvt_pk_bf16_f32 %0, %1, %2" : "=v"(r) : "v"(lo), "v"(hi)); return r; }
#ifndef EPI_SC1
#define EPI_SC1 0
#endif
__device__ __forceinline__ void store16(void* p, u32x4 v) {
#if EPI_SC1
    asm volatile("global_store_dwordx4 %0, %1, off sc1\n\ts_nop 1" :: "v"(p), "v"(v) : "memory");
#else
    *(u32x4*)p = v;
#endif
}
__device__ __forceinline__ void store16f(void* p, f32x4 v) { store16(p, __builtin_bit_cast(u32x4, v)); }
__device__ __forceinline__ float silu_f(float g) { return g * __builtin_amdgcn_rcpf(1.0f + __builtin_amdgcn_exp2f(-1.4426950408889634f * g)); }

__device__ __forceinline__ float row_rstd(const float* rowss, int row) {
    const f32x4* p = (const f32x4*)(rowss + (size_t)row * 16); const f32x4 a = p[0], b = p[1], c = p[2], d = p[3];
    const float s = ((a[0] + a[1]) + (a[2] + a[3])) + ((b[0] + b[1]) + (b[2] + b[3])) + ((c[0] + c[1]) + (c[2] + c[3])) + ((d[0] + d[1]) + (d[2] + d[3]));
    return 1.0f / sqrtf(s * (1.0f / 1024.0f) + 1e-6f);
}
template <bool RS> struct EpiSwiGLU {
    static constexpr bool PERM = true, AFTER_DRAIN = false, F8 = FP8_FFN_IN && !RS;
    bf16_t* H; int ldh; const float* rowss; const float* bias2; int ldb2;
    __device__ __forceinline__ void operator()(const f32x4 (&acc)[2][2][4][2], const Unit& u, int wr, int wc, int fr, int fq) const {
        const int row0 = u.pm * BM + wr * 64 + fr, col0 = u.pn * HALF + wc * 32 + 8 * fq;
        const int cond = u.pm < 32 ? 0 : 1 + ((u.pm - 32) >> 2);
        f32x4 bz[2][2];
#pragma unroll
        for (int bj = 0; bj < 2; ++bj)
#pragma unroll
            for (int n = 0; n < 2; ++n) { bz[bj][n] = (f32x4){0.f, 0.f, 0.f, 0.f}; if constexpr (RS) bz[bj][n] = *(const f32x4*)(bias2 + (size_t)cond * ldb2 + u.pn * BM + bj * HALF + wc * 32 + 8 * fq + 4 * n); }
#pragma unroll
        for (int ai = 0; ai < 2; ++ai)
#pragma unroll
            for (int m = 0; m < 4; ++m) { const int row = row0 + ai * HALF + m * 16; bf16_t* rowp = H + (size_t)row * ldh + col0;
                float rs = F8 ? F8_ACC : 1.0f; if constexpr (RS) rs = row_rstd(rowss, row);
                const f32x4 g0 = acc[ai][0][m][0] * rs + bz[0][0], g1 = acc[ai][0][m][1] * rs + bz[0][1], u0 = acc[ai][1][m][0] * rs + bz[1][0], u1 = acc[ai][1][m][1] * rs + bz[1][1];
                u32x4 w;
#ifdef PROBE_EPI
                if (ldb2) { w.x = cvt_pk_bf16(g0[0] * u0[0], g0[1] * u0[1]); w.y = cvt_pk_bf16(g0[2] * u0[2], g0[3] * u0[3]); w.z = cvt_pk_bf16(g1[0] * u1[0], g1[1] * u1[1]); w.w = cvt_pk_bf16(g1[2] * u1[2], g1[3] * u1[3]); store16(rowp, w); continue; }
#endif
                w.x = cvt_pk_bf16(silu_f(g0[0]) * u0[0], silu_f(g0[1]) * u0[1]); w.y = cvt_pk_bf16(silu_f(g0[2]) * u0[2], silu_f(g0[3]) * u0[3]);
                w.z = cvt_pk_bf16(silu_f(g1[0]) * u1[0], silu_f(g1[1]) * u1[1]); w.w = cvt_pk_bf16(silu_f(g1[2]) * u1[2], silu_f(g1[3]) * u1[3]);
                store16(rowp, w); }
    }
};

template <bool NXT, bool HALFG> struct EpiResid {
    static constexpr bool PERM = false, AFTER_DRAIN = false, F8 = false;
    const float* base0; const float* base1; float* out; const float* gate;
    bf16_t* nxtA; const float* nw; const float* sc; float* rowss;
    __device__ __forceinline__ void operator()(const f32x4 (&acc)[2][2][4][2], const Unit& u, int wr, int wc, int fr, int fq) const {
        const int row0 = u.pm * BM + wr * 64 + fr, col0 = u.pn * BM + wc * 32 + 4 * fq;
        const int cond = u.pm < 32 ? 0 : 1 + ((u.pm - 32) >> 2);
        const float* bp = u.pm < 32 ? base0 : base1 - (size_t)8192 * 1024;
        if constexpr (!NXT) {
            constexpr float gsl = HALFG ? 0.5f : 1.0f;
            f32x4 gv[2][2];
#pragma unroll
            for (int bj = 0; bj < 2; ++bj)
#pragma unroll
                for (int n = 0; n < 2; ++n) gv[bj][n] = *(const f32x4*)(gate + cond * 9216 + col0 + bj * HALF + n * 16) * gsl;
#pragma unroll
            for (int ai = 0; ai < 2; ++ai)
#pragma unroll
                for (int m = 0; m < 4; ++m) { const size_t off = (size_t)(row0 + ai * HALF + m * 16) * 1024 + col0;
#pragma unroll
                    for (int bj = 0; bj < 2; ++bj)
#pragma unroll
                        for (int n = 0; n < 2; ++n) { const f32x4 b = *(const f32x4*)(bp + off + bj * HALF + n * 16); store16f(out + off + bj * HALF + n * 16, b + gv[bj][n] * acc[ai][bj][m][n]); } }
            return;
        }
        float ss[2][4];
#pragma unroll
        for (int ai = 0; ai < 2; ++ai)
#pragma unroll
            for (int m = 0; m < 4; ++m) ss[ai][m] = 0.f;
#pragma unroll
        for (int bj = 0; bj < 2; ++bj)
#pragma unroll
            for (int n = 0; n < 2; ++n) { const int c = col0 + bj * HALF + n * 16; constexpr float gsl = HALFG ? 0.5f : 1.0f; const f32x4 gv = *(const f32x4*)(gate + cond * 9216 + c) * gsl;
                f32x4 av = {0.f, 0.f, 0.f, 0.f}; if constexpr (NXT) av = *(const f32x4*)(nw + c) * (*(const f32x4*)(sc + cond * 9216 + c) + 1.0f);
#pragma unroll
                for (int ai = 0; ai < 2; ++ai)
#pragma unroll
                    for (int m = 0; m < 4; ++m) { const size_t off = (size_t)(row0 + ai * HALF + m * 16) * 1024 + c; const f32x4 b = *(const f32x4*)(bp + off); const f32x4 o = b + gv * acc[ai][bj][m][n];
                        *(f32x4*)(out + off) = o;
                        if constexpr (NXT) { ss[ai][m] += (o[0] * o[0] + o[1] * o[1]) + (o[2] * o[2] + o[3] * o[3]); const f32x4 a = o * av;
                            typedef unsigned u32x2 __attribute__((ext_vector_type(2))); *(u32x2*)(nxtA + off) = (u32x2){cvt_pk_bf16(a[0], a[1]), cvt_pk_bf16(a[2], a[3])}; } } }
        if constexpr (NXT) {
#pragma unroll
            for (int ai = 0; ai < 2; ++ai)
#pragma unroll
                for (int m = 0; m < 4; ++m) { float s = ss[ai][m]; s += __shfl_xor(s, 16); s += __shfl_xor(s, 32); if (fq == 0) rowss[(size_t)(row0 + ai * HALF + m * 16) * 16 + u.pn * 4 + wc] = s; } }
    }
};

typedef _Float16 h2_t __attribute__((ext_vector_type(2)));
__device__ __forceinline__ unsigned pkh2(float lo, float hi) { const h2_t h = {(_Float16)lo, (_Float16)hi}; return __builtin_bit_cast(unsigned, h); }
__device__ __forceinline__ float logf_gate(float x, float lb) { const float sg = __builtin_amdgcn_rcpf(1.0f + __builtin_amdgcn_exp2f(-1.4426950408889634f * x)); return 0.6931471805599453f * __builtin_amdgcn_logf(lb + (1.0f - lb) * sg); }
template <bool RS> struct EpiProj {
    static constexpr bool PERM = true, AFTER_DRAIN = false, F8 = false;
    bf16_t* P; float* outv; const float* lbv; const float* rowss; const float* bias2;
    __device__ __forceinline__ void operator()(const f32x4 (&acc)[2][2][4][2], const Unit& u, int wr, int wc, int fr, int fq) const {
        const int row0 = u.pm * BM + wr * 64 + fr, col0 = u.pn * BM + wc * 32 + 8 * fq;
        const bool wv = (u.pn >= 14) && (u.pm < 32), gate = (u.pn >= 4) && (u.pn < 8);
        const int cond = u.pm < 32 ? 0 : 1 + ((u.pm - 32) >> 2);
        f32x4 lb[2][2], bz[2][2];
#pragma unroll
        for (int bj = 0; bj < 2; ++bj)
#pragma unroll
            for (int n = 0; n < 2; ++n) { lb[bj][n] = gate ? *(const f32x4*)(lbv + ((col0 + bj * HALF + 4 * n) & 511)) : (f32x4){0.f, 0.f, 0.f, 0.f}; bz[bj][n] = (f32x4){0.f, 0.f, 0.f, 0.f}; if constexpr (RS) bz[bj][n] = *(const f32x4*)(bias2 + cond * 4096 + col0 + bj * HALF + 4 * n); }
#pragma unroll
        for (int ai = 0; ai < 2; ++ai)
#pragma unroll
            for (int m = 0; m < 4; ++m) { const int row = row0 + ai * HALF + m * 16; bf16_t* rowp = P + (size_t)row * 4096 + col0; float rs = 1.0f; if constexpr (RS) rs = row_rstd(rowss, row);
#pragma unroll
                for (int bj = 0; bj < 2; ++bj) { const f32x4 v0 = acc[ai][bj][m][0] * rs + bz[bj][0], v1 = acc[ai][bj][m][1] * rs + bz[bj][1]; u32x4 w;
                    if (gate) { const f32x4 l0 = lb[bj][0], l1 = lb[bj][1];
                        w.x = pkh2(logf_gate(v0[0], l0[0]), logf_gate(v0[1], l0[1])); w.y = pkh2(logf_gate(v0[2], l0[2]), logf_gate(v0[3], l0[3]));
                        w.z = pkh2(logf_gate(v1[0], l1[0]), logf_gate(v1[1], l1[1])); w.w = pkh2(logf_gate(v1[2], l1[2]), logf_gate(v1[3], l1[3])); }
                    else { w.x = cvt_pk_bf16(v0[0], v0[1]); w.y = cvt_pk_bf16(v0[2], v0[3]); w.z = cvt_pk_bf16(v1[0], v1[1]); w.w = cvt_pk_bf16(v1[2], v1[3]); }
                    store16(rowp + bj * HALF, w);
                    if (wv) { float* ov = outv + (size_t)row * 512 + (col0 + bj * HALF - 3584); *(f32x4*)ov = v0; *(f32x4*)(ov + 4) = v1; } } }
    }
};

__device__ __forceinline__ void publish_wave(unsigned* cnt, int local) {
    asm volatile("s_waitcnt vmcnt(0)" ::: "memory");
    if (!local) { __builtin_amdgcn_fence(__ATOMIC_RELEASE, "agent"); asm volatile("s_waitcnt vmcnt(0)" ::: "memory"); }
    if ((threadIdx.x & 63) == 0) (void)__hip_atomic_fetch_add(cnt, 1u, __ATOMIC_RELAXED, __HIP_MEMORY_SCOPE_AGENT);
}
__device__ __forceinline__ void wait_counter_wave(unsigned* cnt, unsigned need) {
    unsigned sp = 0;
    while ((unsigned)__builtin_amdgcn_readfirstlane(__hip_atomic_load(cnt, __ATOMIC_RELAXED, __HIP_MEMORY_SCOPE_AGENT)) < need) { __builtin_amdgcn_s_sleep(2); if (++sp > (1u << 22)) break; }
    __builtin_amdgcn_fence(__ATOMIC_ACQUIRE, "agent"); asm volatile("s_waitcnt vmcnt(0)" ::: "memory");
}
__device__ __forceinline__ void wait_counter_wg(unsigned* cnt, unsigned need) {
    if (threadIdx.x < 64) wait_counter_wave(cnt, need);
    asm volatile("" ::: "memory"); __builtin_amdgcn_s_barrier(); asm volatile("" ::: "memory");
}
struct XccInOrder {
    int x, r; unsigned* pc; int local;
    __device__ __forceinline__ bool next(int i, Unit& u) const { const int j = i * 32 + r; if (j >= 110) return false; u.k0 = 0; u.nk = 0; u.kq = 0;
        if (j < 88) { u.pm = 5 * x + (j & 3); u.pn = j >> 2; } else { u.pm = 5 * x + 4; u.pn = j - 88; } return true; }
    __device__ __forceinline__ void a_ready(const Unit&) const {}
    __device__ __forceinline__ void done(const Unit& u) const {
        const int j = (u.pm == 5 * x + 4) ? 88 + u.pn : 4 * u.pn + (u.pm - 5 * x), i = (j - r) >> 5;
        if (i == 0) return;
        Unit p; next(i - 1, p);
        const bool lane0 = (threadIdx.x & 63) == 0;
        if (i == 1) { if (local) { if (lane0) (void)__hip_atomic_fetch_add(pc + 16 * p.pm, 1u, __ATOMIC_RELAXED, __HIP_MEMORY_SCOPE_AGENT); } else publish_wave(pc + 16 * p.pm, 0); return; }
        publish_wave(pc + 16 * u.pm, local);
        if (i == 2 && lane0) (void)__hip_atomic_fetch_add(pc + 16 * p.pm, 1u, __ATOMIC_RELAXED, __HIP_MEMORY_SCOPE_AGENT);
    }
};
struct XccOutOrder {
    int x, r; unsigned* pc;
    __device__ __forceinline__ bool next(int i, Unit& u) const { if (i > 0) return false;
        if (r >= 14 && r < 30) { const int q = r - 14; u.pm = 5 * x + (q >> 2); u.pn = q & 3; u.k0 = 0; u.nk = 0; u.kq = 0; }
        else { const int s = r < 14 ? r : r - 16, kq = s & 3; u.pm = 5 * x + 4; u.pn = s >> 2; u.kq = 1 + kq;
               const int it0 = kq == 0 ? 0 : kq == 1 ? 6 : kq == 2 ? 12 : 17, nit = kq < 2 ? 6 : 5; u.k0 = 2 * it0; u.nk = 2 * nit; }
        return true; }
    __device__ __forceinline__ void a_ready(const Unit& u) const { wait_counter_wg(pc + 16 * u.pm, 22u * 8u); }
    __device__ __forceinline__ void done(const Unit&) const {}
};
template <bool HALFG> struct EpiResidSplit {
    static constexpr bool PERM = false, AFTER_DRAIN = false, F8 = false;
    const float* base0; const float* base1; float* out; const float* gate; float* slab; unsigned* uc; int x; int local;
    __device__ __forceinline__ void operator()(f32x4 (&acc)[2][2][4][2], const Unit& u, int wr, int wc, int fr, int fq) const {
        const int tid = threadIdx.x;
        if (u.kq >= 1 && u.kq <= 3) {
            f32x4* s = (f32x4*)(slab + (size_t)((x * 4 + u.pn) * 3 + (u.kq - 1)) * (32 * 512 * 4)) + tid;
#pragma unroll
            for (int ai = 0; ai < 2; ++ai)
#pragma unroll
                for (int bj = 0; bj < 2; ++bj) {
#pragma unroll
                    for (int m = 0; m < 4; ++m)
#pragma unroll
                        for (int n = 0; n < 2; ++n) s[(m * 2 + n) * 512] = acc[ai][bj][m][n];
                    s += 8 * 512; asm volatile("" : "+v"(s) :: "memory"); }
            publish_wave(uc + 16 * (x * 4 + u.pn), local);
            return;
        }
        const bool owner = u.kq == 4;
        const f32x4* sp = (const f32x4*)(slab + (size_t)((x * 4 + u.pn) * 3) * (32 * 512 * 4)) + tid;
        if (owner) wait_counter_wave(uc + 16 * (x * 4 + u.pn), 24u);
        const int row0 = u.pm * BM + wr * 64 + fr, col0 = u.pn * BM + wc * 32 + 4 * fq;
        const int cond = u.pm < 32 ? 0 : 1 + ((u.pm - 32) >> 2);
        const float* bp = u.pm < 32 ? base0 : base1 - (size_t)8192 * 1024;
        constexpr float gsl = HALFG ? 0.5f : 1.0f;
        f32x4 gv[2][2];
#pragma unroll
        for (int bj = 0; bj < 2; ++bj)
#pragma unroll
            for (int n = 0; n < 2; ++n) gv[bj][n] = *(const f32x4*)(gate + cond * 9216 + col0 + bj * HALF + n * 16) * gsl;
#pragma unroll
        for (int ai = 0; ai < 2; ++ai)
#pragma unroll
            for (int m = 0; m < 4; ++m) { const size_t off = (size_t)(row0 + ai * HALF + m * 16) * 1024 + col0;
#pragma unroll
                for (int bj = 0; bj < 2; ++bj)
#pragma unroll
                    for (int n = 0; n < 2; ++n) { f32x4 a = acc[ai][bj][m][n];
                        if (owner) { const f32x4* s = sp + (((ai * 2 + bj) * 4 + m) * 2 + n) * 512; a += (s[0] + s[32 * 512]) + s[2 * 32 * 512]; }
                        const f32x4 b = *(const f32x4*)(bp + off + bj * HALF + n * 16); *(f32x4*)(out + off + bj * HALF + n * 16) = b + gv[bj][n] * a; }
                asm volatile("" ::: "memory"); }
    }
};
typedef int i32x8 __attribute__((ext_vector_type(8)));
typedef int i32x4 __attribute__((ext_vector_type(4)));
__device__ __forceinline__ i32x8 pg8_ld8(const PG8_LAS unsigned char* p) { const i32x4 lo = *(const PG8_LAS i32x4*)p, hi = *(const PG8_LAS i32x4*)(p + 1024); return __builtin_shufflevector(lo, hi, 0, 1, 2, 3, 4, 5, 6, 7); }
__device__ __forceinline__ void pg8_mfma_f8(f32x4& c, const i32x8& a, const i32x8& b) { asm("v_mfma_f32_16x16x128_f8f6f4 %0, %1, %2, %0" : "+v"(c) : "v"(a), "v"(b)); }
template <class Epi, class Sched, bool ALIGN_EPI = false, bool SP2 = false>
__device__ __forceinline__ void gemm_phase(PG8_LAS unsigned char* lds, const Gemm g, const Sched& S, const Epi& E) {
    const int tid = threadIdx.x, wid = __builtin_amdgcn_readfirstlane(tid >> 6), lane = tid & 63, wr = wid >> 2, wc = wid & 3, fr = lane & 15, fq = lane >> 4;
    const int K = g.K, nt = K / BK;
    unsigned voffA[2], voffB[2];
#pragma unroll
    for (int i = 0; i < 2; ++i) { int R, C; stage_rc(tid * 16 + i * 8192, R, C); const int Rb = Epi::PERM ? ((R & ~31) + perm32(R & 31)) : R;
        voffA[i] = (unsigned)(R * K + C) * 2u; voffB[i] = (unsigned)(Rb * K + C) * 2u; }
    const size_t kstep = (size_t)(BK * 2);
    const size_t hstep = (size_t)HALF * K * 2;
    const size_t tstep = 2 * hstep;
    const unsigned ldsw = (unsigned)wid * 1024u;
    const int aoff = lds_byte(wr * 64 + fr, fq * 8), boff = lds_byte(wc * 32 + fr, fq * 8);
#define PG8_SA(b, h) (((b) * 2 + (h)) * HTB)
#define PG8_SB(b, h) ((4 + (b) * 2 + (h)) * HTB)
#define PG8_STAGE(bufoff, gbase, voff) do { _Pragma("unroll") for (int _i = 0; _i < 2; ++_i) \
        __builtin_amdgcn_global_load_lds((const unsigned*)((const char*)(gbase) + (voff)[_i]), (PG8_LAS unsigned*)(lds + (bufoff) + ldsw + _i * 8192), 16, 0, 0); } while (0)
#define PG8_LDA(dst, b, h) do { if constexpr (Epi::F8) { _Pragma("unroll") for (int m = 0; m < 4; ++m) dst##8[m] = pg8_ld8(lds + PG8_SA(b, h) + aoff + m * 2048); } else { \
        _Pragma("unroll") for (int m = 0; m < 4; ++m) _Pragma("unroll") for (int k = 0; k < 2; ++k) dst[m][k] = *(const PG8_LAS bf16x8*)(lds + PG8_SA(b, h) + aoff + m * 2048 + k * 1024); } } while (0)
#define PG8_LDB(dst, b, h) do { if constexpr (Epi::F8) { _Pragma("unroll") for (int n = 0; n < 2; ++n) dst##8[n] = pg8_ld8(lds + PG8_SB(b, h) + boff + n * 2048); } else { \
        _Pragma("unroll") for (int n = 0; n < 2; ++n) _Pragma("unroll") for (int k = 0; k < 2; ++k) dst[n][k] = *(const PG8_LAS bf16x8*)(lds + PG8_SB(b, h) + boff + n * 2048 + k * 1024); } } while (0)
#define PG8_MMA(ai, bj, At, Bt) do { __builtin_amdgcn_s_setprio(1); _Pragma("unroll") for (int m = 0; m < 4; ++m) _Pragma("unroll") for (int n = 0; n < 2; ++n) { \
        if constexpr (Epi::F8) { pg8_mfma_f8(acc[ai][bj][m][n], Bt##8[n], At##8[m]); } \
        else { _Pragma("unroll") for (int k = 0; k < 2; ++k) acc[ai][bj][m][n] = __builtin_amdgcn_mfma_f32_16x16x32_bf16(Bt[n][k], At[m][k], acc[ai][bj][m][n], 0, 0, 0); } } __builtin_amdgcn_s_setprio(0); } while (0)
#define PG8_WAIT_V(n) asm volatile("s_waitcnt vmcnt(" #n ")" ::: "memory")
#define PG8_WAIT_L(n) asm volatile("s_waitcnt lgkmcnt(" #n ")" ::: "memory")
#define PG8_BAR __builtin_amdgcn_s_barrier()
#define PG8_SCHED __builtin_amdgcn_sched_barrier(0)
    Unit cur, nxt; int ui = 0;
    if (!S.next(0, cur)) return;
    f32x4 acc[2][2][4][2];
#pragma unroll
    for (int a = 0; a < 2; ++a)
#pragma unroll
        for (int b = 0; b < 2; ++b)
#pragma unroll
            for (int m = 0; m < 4; ++m)
#pragma unroll
                for (int n = 0; n < 2; ++n) acc[a][b][m][n] = (f32x4){0.f, 0.f, 0.f, 0.f};
    bf16x8 At[4][2], B0[2][2], B1[2][2];
    i32x8 At8[4], B08[2], B18[2];
    const char* cA = (const char*)g.A + (size_t)(cur.pm * g.amul) * tstep + (size_t)cur.k0 * kstep; const char* cB = (const char*)g.Bt + (size_t)(cur.pn * g.bmul) * tstep + (size_t)cur.k0 * kstep;
    S.a_ready(cur);
    if constexpr (SP2) {
        PG8_STAGE(PG8_SB(0, 0), cB, voffB); PG8_STAGE(PG8_SB(0, 1), cB + hstep, voffB); PG8_STAGE(PG8_SA(0, 0), cA, voffA); PG8_STAGE(PG8_SA(0, 1), cA + hstep, voffA);
        if (wr == 1) PG8_BAR;
        PG8_WAIT_V(2); PG8_BAR;
        PG8_STAGE(PG8_SB(1, 0), cB + kstep, voffB); PG8_STAGE(PG8_SA(1, 0), cA + kstep, voffA); PG8_STAGE(PG8_SB(1, 1), cB + hstep + kstep, voffB);
        PG8_WAIT_V(6); PG8_BAR;
    } else {
        PG8_STAGE(PG8_SB(0, 0), cB, voffB); PG8_STAGE(PG8_SA(0, 0), cA, voffA); PG8_STAGE(PG8_SB(0, 1), cB + hstep, voffB); PG8_STAGE(PG8_SA(0, 1), cA + hstep, voffA);
        if (wr == 1) PG8_BAR;
        PG8_WAIT_V(4); PG8_BAR;
        PG8_STAGE(PG8_SB(1, 0), cB + kstep, voffB); PG8_STAGE(PG8_SA(1, 0), cA + kstep, voffA); PG8_STAGE(PG8_SB(1, 1), cB + hstep + kstep, voffB);
        PG8_WAIT_V(6); PG8_BAR;
    }
    for (;;) {
        const bool has_next = S.next(ui + 1, nxt);
        const char* nA = has_next ? (const char*)g.A + (size_t)(nxt.pm * g.amul) * tstep + (size_t)nxt.k0 * kstep : cA; const char* nB = has_next ? (const char*)g.Bt + (size_t)(nxt.pn * g.bmul) * tstep + (size_t)nxt.k0 * kstep : cB;
        const int unt = cur.nk ? cur.nk : nt;
#pragma unroll 1
        for (int t = 0; t < unt; t += 2) {
            const bool last = (t == unt - 2);
            const char* a1 = cA + (size_t)(t + 1) * kstep;
            const char* a2 = last ? nA : cA + (size_t)(t + 2) * kstep; const char* b2 = last ? nB : cB + (size_t)(t + 2) * kstep;
            const char* a3 = a2 + kstep; const char* b3 = b2 + kstep;
            if (last && has_next) S.a_ready(nxt);
            if constexpr (SP2) {
            PG8_LDB(B0, 0, 0); PG8_LDB(B1, 0, 1); PG8_SCHED; PG8_LDA(At, 0, 0); PG8_STAGE(PG8_SA(1, 1), a1 + hstep, voffA);
            PG8_WAIT_V(8); PG8_WAIT_L(0); PG8_BAR; PG8_MMA(0, 0, At, B0); PG8_MMA(0, 1, At, B1); PG8_BAR; PG8_SCHED;
            PG8_LDA(At, 0, 1); PG8_STAGE(PG8_SB(0, 0), b2, voffB); PG8_STAGE(PG8_SB(0, 1), b2 + hstep, voffB); PG8_STAGE(PG8_SA(0, 0), a2, voffA);
            PG8_WAIT_V(8); PG8_WAIT_L(0); PG8_BAR; PG8_MMA(1, 0, At, B0); PG8_MMA(1, 1, At, B1); PG8_BAR; PG8_SCHED;
            PG8_LDB(B0, 1, 0); PG8_LDB(B1, 1, 1); PG8_SCHED; PG8_LDA(At, 1, 0); PG8_STAGE(PG8_SA(0, 1), a2 + hstep, voffA);
            PG8_WAIT_V(8); PG8_WAIT_L(0); PG8_BAR; PG8_MMA(0, 0, At, B0); PG8_MMA(0, 1, At, B1); PG8_BAR; PG8_SCHED;
            PG8_LDA(At, 1, 1); PG8_STAGE(PG8_SB(1, 0), b3, voffB); PG8_STAGE(PG8_SB(1, 1), b3 + hstep, voffB); PG8_STAGE(PG8_SA(1, 0), a3, voffA);
            PG8_WAIT_V(8); PG8_WAIT_L(0); PG8_BAR; PG8_MMA(1, 0, At, B0); PG8_MMA(1, 1, At, B1); PG8_BAR; PG8_SCHED;
            } else {
            PG8_LDB(B0, 0, 0); PG8_SCHED; PG8_LDA(At, 0, 0); PG8_STAGE(PG8_SA(1, 1), a1 + hstep, voffA);
            PG8_WAIT_L(8); PG8_BAR; PG8_WAIT_L(0); PG8_MMA(0, 0, At, B0); PG8_BAR; PG8_SCHED;
            PG8_LDB(B1, 0, 1); PG8_STAGE(PG8_SB(0, 0), b2, voffB);
            PG8_BAR; PG8_WAIT_L(0); PG8_MMA(0, 1, At, B1); PG8_BAR;
            PG8_LDA(At, 0, 1); PG8_STAGE(PG8_SA(0, 0), a2, voffA);
            PG8_BAR; PG8_WAIT_L(0); PG8_MMA(1, 0, At, B0); PG8_BAR; PG8_SCHED;
            PG8_STAGE(PG8_SB(0, 1), b2 + hstep, voffB);
            PG8_WAIT_V(6); PG8_BAR; PG8_MMA(1, 1, At, B1); PG8_BAR;
            PG8_LDB(B0, 1, 0); PG8_SCHED; PG8_LDA(At, 1, 0); PG8_STAGE(PG8_SA(0, 1), a2 + hstep, voffA);
            PG8_WAIT_L(8); PG8_BAR; PG8_WAIT_L(0); PG8_MMA(0, 0, At, B0); PG8_BAR; PG8_SCHED;
            PG8_LDB(B1, 1, 1); PG8_STAGE(PG8_SB(1, 0), b3, voffB);
            PG8_BAR; PG8_WAIT_L(0); PG8_MMA(0, 1, At, B1); PG8_BAR;
            PG8_LDA(At, 1, 1); PG8_STAGE(PG8_SA(1, 0), a3, voffA);
            PG8_BAR; PG8_WAIT_L(0); PG8_MMA(1, 0, At, B0); PG8_BAR; PG8_SCHED;
            PG8_STAGE(PG8_SB(1, 1), b3 + hstep, voffB);
            PG8_WAIT_V(6); PG8_BAR; PG8_MMA(1, 1, At, B1); PG8_BAR;
            }
        }
        if constexpr (Epi::F8) { asm volatile("s_nop 15\n\ts_nop 15" ::: "memory"); PG8_SCHED; }
        if constexpr (ALIGN_EPI) { if (wr == 0) PG8_BAR; }
        if constexpr (!Epi::AFTER_DRAIN) { E(acc, cur, wr, wc, fr, fq); S.done(cur); }
        if (!has_next) break;
#pragma unroll
        for (int a = 0; a < 2; ++a)
#pragma unroll
            for (int b = 0; b < 2; ++b)
#pragma unroll
                for (int m = 0; m < 4; ++m)
#pragma unroll
                    for (int n = 0; n < 2; ++n) acc[a][b][m][n] = (f32x4){0.f, 0.f, 0.f, 0.f};
        cur = nxt; cA = nA; cB = nB; ++ui;
        if constexpr (ALIGN_EPI) { if (wr == 1) PG8_BAR; }
    }
    PG8_WAIT_V(0);
    if constexpr (!ALIGN_EPI) { if (wr == 0) PG8_BAR; }
    PG8_BAR;
    if constexpr (Epi::AFTER_DRAIN) { E.fused(acc, cur, wr, wc, fr, fq, lds, wid, lane); S.done(cur); }
#undef PG8_SA
#undef PG8_SB
#undef PG8_STAGE
#undef PG8_LDA
#undef PG8_LDB
#undef PG8_MMA
#undef PG8_WAIT_V
#undef PG8_WAIT_L
#undef PG8_BAR
#undef PG8_SCHED
}
}

#ifndef PG8_SP2
#define PG8_SP2 true
#endif
#ifndef PG8_ALIGN
#define PG8_ALIGN true
#endif
constexpr int NWAVES = 8;
#ifndef MK_ONE_LAUNCH
#define MK_ONE_LAUNCH 1
#endif
#ifndef MERGE_FFN
#define MERGE_FFN 0
#endif
#ifndef MERGE_P01
#define MERGE_P01 0
#endif
#ifndef FUSE_NORM
#define FUSE_NORM 0
#endif
constexpr int N_PHASES = FUSE_NORM ? 11 : 13;
static_assert(!(FP8_FFN_IN && (FUSE_NORM || MERGE_FFN)), "the fp8 ffn-in path is wired into the plain 13-phase program only");
#ifndef CONV_MODE
#define CONV_MODE 0
#endif

constexpr int DM = 1024, M_P = 8192, M_S = 2048, M = M_P + M_S, DFF = 2816, NFF = 2 * DFF, NMIX = 4096;
constexpr int T_P = 256, T_S = 1024, PAST = 512, TK_S = PAST + T_S, NB_P = 32, NB_S = 2;
constexpr float EPS = 1e-6f;
constexpr float QSCALE = 0.125f * 1.4426950408889634f;
constexpr float LAM_INIT = 0.2f;
constexpr size_t OUT_Y = 0, OUT_K = (size_t)M * DM, OUT_V = OUT_K + (size_t)M_P * 512, OUT_S = OUT_V + (size_t)M_P * 512, OUT_END = OUT_S + (size_t)NB_P * 2 * 4 * 128 * 128;
constexpr int PC_Q = 0, PC_I = 512, PC_FF = 1024, PC_FB = 1536, PC_G = 2048, PC_AQ = 2560, PC_AK = 3072, PC_AV = 3584;

constexpr size_t MiB = 1u << 20;
constexpr size_t WS_CTL = 0, CTL_ZERO_BYTES = 192 * 1024;
constexpr size_t WS_MADA = 64 * 1024;
constexpr size_t WS_LB = 1 * MiB + 128 * 1024;
constexpr size_t WS_ROPE = 1 * MiB + 256 * 1024;
constexpr size_t WS_W1I = 2 * MiB, WS_W1O = 13 * MiB, WS_WMI = 19 * MiB, WS_WMO = 27 * MiB, WS_W2I = 29 * MiB, WS_W2O = 40 * MiB;
constexpr size_t WS_ABUF = 46 * MiB;
constexpr size_t WS_BIG = 66 * MiB;
constexpr size_t WS_SLAB = 122 * MiB;
constexpr size_t WS_QB = 146 * MiB;
constexpr size_t WS_KB = 156 * MiB;
constexpr size_t WS_KS = 164 * MiB;
constexpr size_t WS_VTP = 167 * MiB;
constexpr size_t WS_VTS = 175 * MiB;
constexpr size_t WS_OF = 178 * MiB, WS_OB = 198 * MiB;
constexpr size_t WS_ABUF2 = 218 * MiB;
constexpr size_t WS_ROWSS = 238 * MiB;
constexpr size_t WS_BIAS2 = 239 * MiB;
constexpr size_t WS_HSAVE = 240 * MiB;
constexpr size_t WS_END = 241 * MiB;
constexpr int CW_BAR = 4096;
constexpr int CW_QUEUE = 64;
constexpr int CW_MADA = 768;
constexpr int CW_CONVQ = 512;
constexpr int CW_SAMP = 11520, CW_GDONE = 11776;
constexpr int CW_LBAR = 10496;
#ifndef EARLY_CHAINS
#define EARLY_CHAINS 1
#endif
#ifndef LOCAL_SEAMS
#define LOCAL_SEAMS 1
#endif
constexpr int CW_PANEL1 = 8192, CW_PANEL2 = 8832, CW_UNIT1 = 9472, CW_UNIT2 = 9984;

constexpr int RING_OFF = 0, RING_BYTES = 131072;
constexpr int LDSCTL_OFF = RING_BYTES, MISC_OFF = LDSCTL_OFF + 320;
constexpr int LDS_BYTES = 147456;

#define GAS __attribute__((address_space(1)))
#define LAS __attribute__((address_space(3)))
typedef unsigned short bf16;
typedef unsigned v4u __attribute__((ext_vector_type(4)));
typedef unsigned v2u __attribute__((ext_vector_type(2)));
typedef float f32x4 __attribute__((ext_vector_type(4)));
typedef float f32x2 __attribute__((ext_vector_type(2)));
typedef float f32x16 __attribute__((ext_vector_type(16)));
typedef short bf16x8 __attribute__((ext_vector_type(8)));
typedef short s16x4 __attribute__((ext_vector_type(4)));
typedef GAS unsigned gu32;
#define RLX_AGENT __ATOMIC_RELAXED, __HIP_MEMORY_SCOPE_AGENT
#define LDS_WAIT() asm volatile("s_waitcnt lgkmcnt(0)" ::: "memory")
#define VM_WAIT() asm volatile("s_waitcnt vmcnt(0)" ::: "memory")
#define LDS_BARRIER() do { asm volatile("s_waitcnt lgkmcnt(0)" ::: "memory"); __builtin_amdgcn_s_barrier(); asm volatile("" ::: "memory"); } while (0)
__device__ __forceinline__ unsigned f2bf(float f) { unsigned u = __builtin_bit_cast(unsigned, f); return (u + 0x7fffu + ((u >> 16) & 1u)) >> 16; }
typedef __bf16 bf16x2_t __attribute__((ext_vector_type(2)));
typedef _Float16 h2_t __attribute__((ext_vector_type(2)));
__device__ __forceinline__ unsigned pkh2(float lo, float hi) { const h2_t h = {(_Float16)lo, (_Float16)hi}; return __builtin_bit_cast(unsigned, h); }
__device__ __forceinline__ unsigned pk2(float lo, float hi) { const f32x2 v = {lo, hi}; const bf16x2_t b = __builtin_convertvector(v, bf16x2_t); return __builtin_bit_cast(unsigned, b); }
__device__ __forceinline__ float f8_clamp(float x) { return __builtin_fminf(__builtin_fmaxf(x, -448.0f), 448.0f); }
__device__ __forceinline__ unsigned pk4_f8(float a, float b, float c, float d) { int w = 0; w = __builtin_amdgcn_cvt_pk_fp8_f32(f8_clamp(a), f8_clamp(b), w, false); w = __builtin_amdgcn_cvt_pk_fp8_f32(f8_clamp(c), f8_clamp(d), w, true); return (unsigned)w; }
__device__ __forceinline__ float bflo(unsigned w) { return __builtin_bit_cast(float, w << 16); }
__device__ __forceinline__ float bfhi(unsigned w) { return __builtin_bit_cast(float, w & 0xffff0000u); }
__device__ __forceinline__ float wave_sum(float v) {
#pragma unroll
    for (int o = 1; o < 64; o <<= 1) v += __shfl_xor(v, o);
    return v;
}
__device__ __forceinline__ float sigmoid_f(float x) { return __builtin_amdgcn_rcpf(1.0f + __builtin_amdgcn_exp2f(-1.4426950408889634f * x)); }
#define XB_TMO      128
#define XB_XCNT(j)  (256  + 64 * (j))
#define XB_XSUB(j)  (1280 + 64 * (j))
#define XB_XGEN(j)  (2304 + 64 * (j))
#define XB_TOP      3328
#define XB_TOPGEN   3392
#define XCD_BAR_WORDS 3456
#define XB_SPIN_CAP (1u << 18)

__device__ __forceinline__ unsigned xb_ld(unsigned* p)              { return __hip_atomic_load(p, __ATOMIC_RELAXED, __HIP_MEMORY_SCOPE_AGENT); }
__device__ __forceinline__ unsigned xb_add(unsigned* p, unsigned v) { return __hip_atomic_fetch_add(p, v, __ATOMIC_RELAXED, __HIP_MEMORY_SCOPE_AGENT); }
__device__ __forceinline__ unsigned xb_xcc_id() { return (unsigned)__builtin_amdgcn_s_getreg((3 << 11) | 20) & 0xFu; }
#define XB_SPIN(cond, bar) do { unsigned _sp = 0; while (cond) { __builtin_amdgcn_s_sleep(1); \
    if ((++_sp & 255u) == 0u) { if (xb_ld(&(bar)[XB_TMO])) break; if (_sp > XB_SPIN_CAP) { atomicAdd(&(bar)[XB_TMO], 1u); break; } } } } while (0)

struct XcdBarrier {
    unsigned* bar; unsigned x;
    volatile LAS unsigned* st;
};

__device__ __forceinline__ XcdBarrier xcd_barrier_post(unsigned* bar, volatile LAS unsigned* st) {
    XcdBarrier b; b.bar = bar; b.x = xb_xcc_id(); b.st = st;
    if (threadIdx.x == 0) st[2] = xb_add(&bar[XB_XCNT(b.x)], 1u);
    return b;
}
__device__ __forceinline__ void xcd_barrier_complete(unsigned* bar, unsigned x, unsigned& nloc, unsigned& nx) {
    const unsigned G = gridDim.x * gridDim.y * gridDim.z;
    unsigned sum, cnt, mine, sp = 0u;
    for (;;) {
        sum = 0u; cnt = 0u; mine = 0u;
#pragma unroll
        for (unsigned j = 0; j < 16; ++j) { const unsigned c = xb_ld(&bar[XB_XCNT(j)]); sum += c; cnt += (c > 0u) ? 1u : 0u; mine = (j == x) ? c : mine; }
        if (sum == G) break;
        __builtin_amdgcn_s_sleep(1);
        if ((++sp & 255u) == 0u) { if (xb_ld(&bar[XB_TMO])) break; if (sp > XB_SPIN_CAP) { atomicAdd(&bar[XB_TMO], 1u); break; } }
    }
    nloc = mine > 0u ? mine : 1u; nx = cnt > 0u ? cnt : 1u;
}
__device__ __forceinline__ unsigned xcd_census_even(unsigned* bar) {
    const unsigned G = gridDim.x * gridDim.y * gridDim.z; bool ok = (G % 8u) == 0u;
#pragma unroll
    for (unsigned j = 0; j < 16; ++j) { const unsigned c = xb_ld(&bar[XB_XCNT(j)]); ok = ok && (c == (j < 8u ? G / 8u : 0u)); }
    return ok ? 1u : 2u;
}

__device__ __forceinline__ void xcd_barrier(const XcdBarrier& b) {
    asm volatile("s_waitcnt vmcnt(0)" ::: "memory");
    __syncthreads();
    if (threadIdx.x == 0) {
        unsigned* bar = b.bar;
        __builtin_amdgcn_s_waitcnt(0);
        unsigned nloc = b.st[0], nx = b.st[1];
        if (nloc == 0u) { xcd_barrier_complete(bar, b.x, nloc, nx); b.st[0] = nloc; b.st[1] = nx; b.st[3] = xcd_census_even(bar); }
        const unsigned old = xb_add(&bar[XB_XSUB(b.x)], 1u);
        const unsigned gen = old / nloc;
        if (old + 1u == (gen + 1u) * nloc) {
            __builtin_amdgcn_fence(__ATOMIC_RELEASE, "agent");
            asm volatile("s_waitcnt vmcnt(0)" ::: "memory");
            const unsigned og = xb_add(&bar[XB_TOP], 1u);
            const unsigned tg = og / nx;
            if (og + 1u == (tg + 1u) * nx) xb_add(&bar[XB_TOPGEN], 1u);
            else XB_SPIN(xb_ld(&bar[XB_TOPGEN]) == tg, bar);
            __builtin_amdgcn_fence(__ATOMIC_ACQUIRE, "agent");
            xb_add(&bar[XB_XGEN(b.x)], 1u);
            asm volatile("s_waitcnt vmcnt(0)" ::: "memory");
        } else {
            XB_SPIN(xb_ld(&bar[XB_XGEN(b.x)]) == gen, bar);
            __builtin_amdgcn_fence(__ATOMIC_ACQUIRE, "agent");
            asm volatile("s_waitcnt vmcnt(0)" ::: "memory");
        }
    }
    __syncthreads();
}

__device__ __forceinline__ void xcc_barrier(const XcdBarrier& b, unsigned* lsub) {
    asm volatile("s_waitcnt vmcnt(0)" ::: "memory");
    __syncthreads();
    if (threadIdx.x == 0) {
        const unsigned nloc = b.st[0];
        unsigned* c = lsub + 64 * b.x;
        const unsigned old = xb_add(c, 1u), target = (old / nloc + 1u) * nloc;
        XB_SPIN(xb_ld(c) < target, b.bar);
        __builtin_amdgcn_fence(__ATOMIC_ACQUIRE, "agent");
        asm volatile("s_waitcnt vmcnt(0)" ::: "memory");
    }
    __syncthreads();
}

struct Frame {
    LAS unsigned char* lds;
    volatile LAS unsigned* MISC;
    gu32* ctl;
    int tid, lane, wave;
    int vcu, G;
    int xl, xr, xok;
    const float *x_prompt, *x_sample, *c, *cache_k, *cache_v, *state0, *c_ctx, *w_ada, *b_ada, *norm_ffn1, *w_ffn1_in, *w_ffn1_out, *norm_mix, *w_mix_in, *w_mix_out,
                *lb_logits, *hgrn_out_norm, *q_norm, *k_norm, *attn_lambda, *attn_subln, *norm_ffn2, *w_ffn2_in, *w_ffn2_out;
    float* out;
    float *mada, *rope, *lbv, *bias2m, *bias2f, *rowss, *hsave; int* hidx; bf16 *W1I, *W1O, *WMI, *WMO, *W2I, *W2O, *ABUF, *ABUF2, *HID, *PROJ, *QB, *KB, *KS, *VTP, *VTS, *OF, *OB;
};

constexpr int CV_FI = (DM / 64) * (NFF / 32), CV_FO = (DFF / 64) * (DM / 32), CV_MI = (DM / 64) * (NMIX / 32), CV_MO = (DM / 64) * (DM / 32);
#ifndef CONV_P5TAIL
#define CONV_P5TAIL 0
#endif
#ifndef CONV_P6
#define CONV_P6 0
#endif
#ifndef CONV_P9
#define CONV_P9 0
#endif
#ifndef CONV_LATE_P3
#define CONV_LATE_P3 0
#endif
#ifndef CONV_P2TAIL
#define CONV_P2TAIL 1
#endif
constexpr int CV_P0_N = CONV_P2TAIL ? CV_FI : CV_FI + CV_FO + CV_MI;
constexpr int CV_LATE0 = CV_FI + CV_FO + CV_MI, CV_LATE_N = CV_MO + CV_FI + CV_FO;
template <int MODE, bool F8 = false>
__device__ __forceinline__ void p0_transpose_item(const float* W, int K, int N, bf16* WT, LAS float* scr, int item, int lane) {
    const int nblk = N / 32, kb = item / nblk, nb = item % nblk, k0 = 64 * kb, n0 = 32 * nb;
    int drow0 = n0;
    if (MODE == 1) { const int half = n0 / DFF, r = n0 % DFF; drow0 = (r / 128) * 256 + half * 128 + (r % 128); }
    float tv[32];
    const float* wp = W + (size_t)(k0 + (lane >> 5)) * N + n0 + (lane & 31);
#pragma unroll
    for (int i = 0; i < 32; ++i) tv[i] = __builtin_nontemporal_load(wp + (size_t)(2 * i) * N);
#pragma unroll
    for (int i = 0; i < 32; ++i) scr[(2 * i + (lane >> 5)) * 33 + (lane & 31)] = tv[i];
    LDS_WAIT(); asm volatile("" ::: "memory");
    const int c = lane & 7;
#pragma unroll
    for (int j = 0; j < 4; ++j) { const int n = (lane >> 3) + 8 * j; const LAS float* s = scr + (8 * c) * 33 + n;
        if constexpr (F8) { v2u o; o.x = pk4_f8(s[0 * 33] * F8_SW, s[1 * 33] * F8_SW, s[2 * 33] * F8_SW, s[3 * 33] * F8_SW); o.y = pk4_f8(s[4 * 33] * F8_SW, s[5 * 33] * F8_SW, s[6 * 33] * F8_SW, s[7 * 33] * F8_SW);
            *(GAS v2u*)((unsigned char*)WT + (size_t)(drow0 + n) * K + k0 + 8 * c) = o; }
        else { v4u o; o.x = pk2(s[0 * 33], s[1 * 33]); o.y = pk2(s[2 * 33], s[3 * 33]); o.z = pk2(s[4 * 33], s[5 * 33]); o.w = pk2(s[6 * 33], s[7 * 33]);
            *(GAS v4u*)(WT + (size_t)(drow0 + n) * K + k0 + 8 * c) = o; } }
    LDS_WAIT(); asm volatile("" ::: "memory");
}

__device__ __forceinline__ void convert_item(Frame& F, LAS float* scr, int it) {
    int r = it;
    if (r < CV_FI) { p0_transpose_item<1, FP8_FFN_IN != 0>(F.w_ffn1_in, DM, NFF, F.W1I, scr, r, F.lane); return; } r -= CV_FI;
    if (r < CV_FO) { p0_transpose_item<0>(F.w_ffn1_out, DFF, DM, F.W1O, scr, r, F.lane); return; } r -= CV_FO;
    if (r < CV_MI) { p0_transpose_item<0>(F.w_mix_in, DM, NMIX, F.WMI, scr, r, F.lane); return; } r -= CV_MI;
    if (r < CV_MO) { p0_transpose_item<0>(F.w_mix_out, DM, DM, F.WMO, scr, r, F.lane); return; } r -= CV_MO;
    if (r < CV_FI) { p0_transpose_item<1, FP8_FFN_IN != 0>(F.w_ffn2_in, DM, NFF, F.W2I, scr, r, F.lane); return; } r -= CV_FI;
    p0_transpose_item<0>(F.w_ffn2_out, DFF, DM, F.W2O, scr, r, F.lane);
}
__device__ __forceinline__ void convert_queue(Frame& F, int qword, int first, int n) {
    LAS float* scr = (LAS float*)(F.lds + RING_OFF + F.wave * 16384);
    volatile LAS int* qslot = (volatile LAS int*)(F.lds + MISC_OFF + 64);
    for (;;) {
        if (F.tid == 0) *qslot = (int)__hip_atomic_fetch_add(F.ctl + qword, 1u, RLX_AGENT);
        __syncthreads();
        const int bt = *qslot;
        __syncthreads();
        if (bt * 8 >= n) break;
        { const int it = bt * 8 + F.wave; if (it < n) convert_item(F, scr, first + it); }
    }
}
__device__ __forceinline__ void p0_prologue(Frame& F) {
    if (F.vcu < 144) {
        LAS float* sS = (LAS float*)(F.lds);
        LAS float* red = (LAS float*)(F.lds + 12288);
        for (int i = F.tid; i < 3072; i += NWAVES * 64) { const int cond = i >> 10, k = i & 1023; const float cv = cond == 0 ? F.c_ctx[k] : F.c[(cond - 1) * 1024 + k]; sS[i] = cv * sigmoid_f(cv); }
        __syncthreads();
        const int cb = F.vcu % 36, kq = F.vcu / 36, col = cb * 256 + 4 * F.lane, k0 = kq * 256 + F.wave * 32;
        f32x4 a0 = {0.f, 0.f, 0.f, 0.f}, a1 = a0, a2 = a0;
#pragma unroll
        for (int hb = 0; hb < 2; ++hb) { f32x4 wv[16];
#pragma unroll
            for (int kk = 0; kk < 16; ++kk) wv[kk] = __builtin_nontemporal_load((const f32x4*)(F.w_ada + (size_t)(k0 + hb * 16 + kk) * 9216 + col));
#pragma unroll
            for (int kk = 0; kk < 16; ++kk) { const int k = k0 + hb * 16 + kk; a0 += wv[kk] * sS[k]; a1 += wv[kk] * sS[1024 + k]; a2 += wv[kk] * sS[2048 + k]; } }
        *(LAS f32x4*)(red + (F.wave * 3 + 0) * 256 + 4 * F.lane) = a0; *(LAS f32x4*)(red + (F.wave * 3 + 1) * 256 + 4 * F.lane) = a1; *(LAS f32x4*)(red + (F.wave * 3 + 2) * 256 + 4 * F.lane) = a2;
        __syncthreads();
        for (int o = F.tid; o < 768; o += NWAVES * 64) { const int cond = o >> 8, cc = o & 255; float s = kq == 0 ? F.b_ada[cb * 256 + cc] : 0.f;
#pragma unroll
            for (int w = 0; w < 8; ++w) s += red[(w * 3 + cond) * 256 + cc];
            atomicAdd(F.mada + cond * 9216 + cb * 256 + cc, s); }
        asm volatile("s_waitcnt vmcnt(0)" ::: "memory");
        __syncthreads();
        if (cb < 8 && F.tid == 0) { __builtin_amdgcn_fence(__ATOMIC_RELEASE, "agent"); asm volatile("s_waitcnt vmcnt(0)" ::: "memory"); (void)__hip_atomic_fetch_add(F.ctl + CW_MADA, 1u, RLX_AGENT); }
    }
    if (F.vcu == F.G - 1) { const int k = F.tid; F.lbv[k] = 1.0f / (1.0f + __expf(F.lb_logits[512 + k] - F.lb_logits[k])); }
    { const int gid = (F.vcu * NWAVES + F.wave) * 64 + F.lane;
      if (gid < 1024 * 32) { const int t = gid >> 5, j = gid & 31, i = j & 15; const float pos = (j < 16) ? (float)(t >> 6) : (float)(t & 63);
          const float inv = exp2f(-(float)i * (13.287712379549449f / 16.0f));
          float sn, cs; sincosf(pos * inv, &sn, &cs); F.rope[gid] = cs; F.rope[32768 + gid] = sn; } }
    LAS float* scr = (LAS float*)(F.lds + RING_OFF + F.wave * 16384);
    const int gw = F.vcu * NWAVES + F.wave, NGW = F.G * NWAVES;
#if CONV_MODE == 0
    (void)gw; (void)NGW; (void)scr; convert_queue(F, CW_CONVQ + 128, 0, CV_P0_N);
#else
    for (int it = gw; it < CV_FI; it += NGW) p0_transpose_item<1>(F.w_ffn1_in, DM, NFF, F.W1I, scr, it, F.lane);
#endif
}
__device__ __forceinline__ void wait_mada01(Frame& F) {
    if (F.tid == 0) { unsigned sp = 0;
        while (__hip_atomic_load(F.ctl + CW_MADA, RLX_AGENT) < 32u) { __builtin_amdgcn_s_sleep(2); if (++sp > (1u << 22)) break; }
        __builtin_amdgcn_fence(__ATOMIC_ACQUIRE, "agent"); asm volatile("s_waitcnt vmcnt(0)" ::: "memory"); }
    __syncthreads();
}
template <bool F8>
__device__ __forceinline__ void norm_mod_phase(Frame& F, const float* src0, const float* src1, const float* nw, int sh_chunk, int sc_chunk) {
    const int xl = F.xl, wl = F.xr * NWAVES + F.wave, NWL = (F.G / 8) * NWAVES;
    f32x4 a4[4], h4[4]; int cur = -1;
    for (int rl = wl; rl < M / 8; rl += NWL) { const int row = pg8::pmap(5 * xl + (rl >> 8)) * 256 + (rl & 255);
        const float* xr = row < M_P ? src0 + (size_t)row * DM : src1 + (size_t)(row - M_P) * DM;
        const int cond = row < M_P ? 0 : 1 + ((row - M_P) >> 10);
        f32x4 v[4]; float ss = 0.f;
#pragma unroll
        for (int j = 0; j < 4; ++j) { v[j] = ((const GAS f32x4*)xr)[F.lane + 64 * j]; ss += (v[j].x * v[j].x + v[j].y * v[j].y) + (v[j].z * v[j].z + v[j].w * v[j].w); }
        if (cond != cur) { cur = cond; const float* sh = F.mada + cond * 9216 + sh_chunk * 1024; const float* sc = F.mada + cond * 9216 + sc_chunk * 1024;
#pragma unroll
            for (int j = 0; j < 4; ++j) { const int q = F.lane + 64 * j; a4[j] = ((const GAS f32x4*)nw)[q] * (((const GAS f32x4*)sc)[q] + 1.0f); h4[j] = ((const GAS f32x4*)sh)[q]; } }
        const float rstd = 1.0f / sqrtf(wave_sum(ss) * (1.0f / DM) + EPS);
        if constexpr (F8) { GAS unsigned* o4 = (GAS unsigned*)((GAS unsigned char*)F.ABUF + (size_t)row * DM);
#pragma unroll
            for (int j = 0; j < 4; ++j) { const int q = F.lane + 64 * j; const f32x4 o = (v[j] * rstd * a4[j] + h4[j]) * F8_SA; o4[q] = pk4_f8(o.x, o.y, o.z, o.w); } }
        else { GAS v2u* o8 = (GAS v2u*)(F.ABUF + (size_t)row * DM);
#pragma unroll
            for (int j = 0; j < 4; ++j) { const int q = F.lane + 64 * j; const f32x4 o = v[j] * rstd * a4[j] + h4[j]; v2u w; w.x = pk2(o.x, o.y); w.y = pk2(o.z, o.w); o8[q] = w; } }
    }
}

__device__ __forceinline__ void bias2_rows(Frame& F, const bf16* Wt, int N, int sh_chunk, float* dst) {
    const int gw = F.vcu * NWAVES + F.wave, NGW = F.G * NWAVES, lane = F.lane;
    float sh[3][16];
#pragma unroll
    for (int c = 0; c < 3; ++c)
#pragma unroll
        for (int j = 0; j < 16; ++j) sh[c][j] = F.mada[c * 9216 + sh_chunk * 1024 + (j < 8 ? 8 * lane + j : 512 + 8 * lane + (j - 8))];
    for (int n = gw; n < N; n += NGW) {
        const v4u w0 = *(const GAS v4u*)(Wt + (size_t)n * DM + 8 * lane), w1 = *(const GAS v4u*)(Wt + (size_t)n * DM + 512 + 8 * lane);
        const float wv[16] = {bflo(w0.x), bfhi(w0.x), bflo(w0.y), bfhi(w0.y), bflo(w0.z), bfhi(w0.z), bflo(w0.w), bfhi(w0.w), bflo(w1.x), bfhi(w1.x), bflo(w1.y), bfhi(w1.y), bflo(w1.z), bfhi(w1.z), bflo(w1.w), bfhi(w1.w)};
        float a0 = 0.f, a1 = 0.f, a2 = 0.f;
#pragma unroll
        for (int j = 0; j < 16; ++j) { a0 += wv[j] * sh[0][j]; a1 += wv[j] * sh[1][j]; a2 += wv[j] * sh[2][j]; }
        a0 = wave_sum(a0); a1 = wave_sum(a1); a2 = wave_sum(a2);
        if (lane == 0) { dst[n] = a0; dst[N + n] = a1; dst[2 * N + n] = a2; }
    }
}

constexpr int N_HEADWG = NB_S * 4 * 2, HG_HEAD = 6;
template <bool SRC_F32>
__device__ __forceinline__ void vt_item(const void* src, size_t src_pitch  , bf16* dst, size_t dst_pitch, LAS unsigned short* scr, int lane) {
#pragma unroll
    for (int i = 0; i < 8; ++i) { const int id = i * 64 + lane, r = id >> 3, ch = id & 7; v4u w;
        if (SRC_F32) { const float* p = (const float*)src + (size_t)r * src_pitch + ch * 8; const f32x4 a = *(const GAS f32x4*)p, b = *(const GAS f32x4*)(p + 4);
            w.x = pk2(a.x, a.y); w.y = pk2(a.z, a.w); w.z = pk2(b.x, b.y); w.w = pk2(b.z, b.w); }
        else w = *(const GAS v4u*)((const bf16*)src + (size_t)r * src_pitch + ch * 8);
        *(LAS v4u*)(scr + r * 72 + ch * 8) = w; }
    LDS_WAIT(); asm volatile("" ::: "memory");
#pragma unroll
    for (int i = 0; i < 8; ++i) { const int id = i * 64 + lane, c = id >> 3, rc = id & 7; const LAS unsigned short* s = scr + (rc * 8) * 72 + c; v4u w;
        w.x = (unsigned)s[0] | ((unsigned)s[72] << 16); w.y = (unsigned)s[2 * 72] | ((unsigned)s[3 * 72] << 16); w.z = (unsigned)s[4 * 72] | ((unsigned)s[5 * 72] << 16); w.w = (unsigned)s[6 * 72] | ((unsigned)s[7 * 72] << 16);
        *(GAS v4u*)(dst + (size_t)c * dst_pitch + rc * 8) = w; }
    LDS_WAIT(); asm volatile("" ::: "memory");
}

__device__ __forceinline__ void p6a_prep(Frame& F, int dense) {
    const int gw = dense * NWAVES + F.wave, NGW = (F.G - N_HEADWG) * NWAVES, lane = F.lane;
    const int d0 = 8 * (lane & 7);
    float qw[8], kw[8];
#pragma unroll
    for (int j = 0; j < 8; ++j) { qw[j] = F.q_norm[d0 + j]; kw[j] = F.k_norm[d0 + j]; }
    for (int row = gw; row < M; row += NGW) {
        const bf16* pr = F.PROJ + (size_t)row * NMIX;
        const v4u qa = *(const GAS v4u*)(pr + PC_AQ + 8 * lane), ka = *(const GAS v4u*)(pr + PC_AK + 8 * lane);
        float q[8] = {bflo(qa.x), bfhi(qa.x), bflo(qa.y), bfhi(qa.y), bflo(qa.z), bfhi(qa.z), bflo(qa.w), bfhi(qa.w)};
        float k[8] = {bflo(ka.x), bfhi(ka.x), bflo(ka.y), bfhi(ka.y), bflo(ka.z), bfhi(ka.z), bflo(ka.w), bfhi(ka.w)};
        float sq = 0.f, sk = 0.f;
#pragma unroll
        for (int j = 0; j < 8; ++j) { sq += q[j] * q[j]; sk += k[j] * k[j]; }
        sq += __shfl_xor(sq, 1); sq += __shfl_xor(sq, 2); sq += __shfl_xor(sq, 4);
        sk += __shfl_xor(sk, 1); sk += __shfl_xor(sk, 2); sk += __shfl_xor(sk, 4);
        const float rq = 1.0f / sqrtf(sq * (1.0f / 64.0f) + EPS), rk = 1.0f / sqrtf(sk * (1.0f / 64.0f) + EPS);
#pragma unroll
        for (int j = 0; j < 8; ++j) { q[j] = q[j] * rq * qw[j]; k[j] = k[j] * rk * kw[j]; }
        if (row < M_P) {
            float* ok = F.out + OUT_K + (size_t)row * 512 + 8 * lane;
            *(GAS f32x4*)ok = (f32x4){k[0], k[1], k[2], k[3]}; *(GAS f32x4*)(ok + 4) = (f32x4){k[4], k[5], k[6], k[7]};
            v4u w; w.x = pk2(k[0], k[1]); w.y = pk2(k[2], k[3]); w.z = pk2(k[4], k[5]); w.w = pk2(k[6], k[7]);
            *(GAS v4u*)(F.KB + (size_t)row * 512 + 8 * lane) = w;
        } else {
            const int rs = row - M_P, b = rs >> 10, t = rs & 1023, g8 = lane & 7;
            const bool first = (g8 & 2) == 0; const int tc = ((g8 >= 4) ? 16 : 0) + 8 * (g8 & 1);
            const float* cs = F.rope + t * 32 + tc; const float* sn = F.rope + 32768 + t * 32 + tc;
#pragma unroll
            for (int j = 0; j < 8; ++j) { const float c = cs[j], s = sn[j]; const float pq = __shfl_xor(q[j], 2), pk = __shfl_xor(k[j], 2);
                q[j] = first ? q[j] * c - pq * s : q[j] * c + pq * s; k[j] = first ? k[j] * c - pk * s : k[j] * c + pk * s; }
            v4u w; w.x = pk2(k[0], k[1]); w.y = pk2(k[2], k[3]); w.z = pk2(k[4], k[5]); w.w = pk2(k[6], k[7]);
            *(GAS v4u*)(F.KS + ((size_t)b * TK_S + PAST + t) * 512 + 8 * lane) = w;
        }
        v4u w; w.x = pk2(q[0] * QSCALE, q[1] * QSCALE); w.y = pk2(q[2] * QSCALE, q[3] * QSCALE); w.z = pk2(q[4] * QSCALE, q[5] * QSCALE); w.w = pk2(q[6] * QSCALE, q[7] * QSCALE);
        *(GAS v4u*)(F.QB + (size_t)row * 512 + 8 * lane) = w;
    }
    for (int r = gw; r < NB_S * PAST; r += NGW) { const int b = r >> 9, j = r & 511; const float* p = F.cache_k + (size_t)r * 512 + 8 * lane;
        const f32x4 a = *(const GAS f32x4*)p, bb = *(const GAS f32x4*)(p + 4); v4u w; w.x = pk2(a.x, a.y); w.y = pk2(a.z, a.w); w.z = pk2(bb.x, bb.y); w.w = pk2(bb.z, bb.w);
        *(GAS v4u*)(F.KS + ((size_t)b * TK_S + j) * 512 + 8 * lane) = w; }
    LAS unsigned short* scr = (LAS unsigned short*)(F.lds + RING_OFF + F.wave * 16384);
    constexpr int IT_P = NB_P * 4 * 4 * 2, IT_SL = NB_S * 4 * 16 * 2, IT_SC = NB_S * 4 * 8 * 2;
    for (int it = gw; it < IT_P + IT_SL + IT_SC; it += NGW) {
        if (it < IT_P) { const int bh = it >> 3, tb = (it >> 1) & 3, db = it & 1, b = bh >> 2, h = bh & 3;
            vt_item<false>(F.PROJ + ((size_t)b * T_P + tb * 64) * NMIX + PC_AV + h * 128 + db * 64, NMIX, F.VTP + ((size_t)bh * 128 + db * 64) * T_P + tb * 64, T_P, scr, lane); }
        else if (it < IT_P + IT_SL) { const int r = it - IT_P, bh = r >> 5, tb = (r >> 1) & 15, db = r & 1, b = bh >> 2, h = bh & 3;
            vt_item<false>(F.PROJ + ((size_t)M_P + b * T_S + tb * 64) * NMIX + PC_AV + h * 128 + db * 64, NMIX, F.VTS + ((size_t)bh * 128 + db * 64) * TK_S + PAST + tb * 64, TK_S, scr, lane); }
        else { const int r = it - IT_P - IT_SL, bh = r >> 4, tb = (r >> 1) & 7, db = r & 1, b = bh >> 2, h = bh & 3;
            vt_item<true>(F.cache_v + ((size_t)b * PAST + tb * 64) * 512 + h * 128 + db * 64, 512, F.VTS + ((size_t)bh * 128 + db * 64) * TK_S + tb * 64, TK_S, scr, lane); }
    }
}

constexpr int HG_QT = 0, HG_KT = 8192, HG_KH = 16384, HG_VT = 24576, HG_PE = 32768, HG_BUF = 33792, HG_GT = 2 * HG_BUF, HG_GTB = 4096, HG_FLAG = HG_GT + 2 * HG_GTB;
#define MFMA16(a, b, c) __builtin_amdgcn_mfma_f32_16x16x32_bf16(a, b, c, 0, 0, 0)
__device__ __forceinline__ int hgrn_unit(Frame& F, int row_base, int T, int h, int dir, const float* s0, float* sfin, bf16* obuf, int c_begin, int c_end, const unsigned* stopc = nullptr, unsigned stopneed = 0u) {
    LAS unsigned char* L = F.lds;
    int tid_ = F.tid; asm volatile("" : "+v"(tid_));
    const int tid = tid_, lane = tid & 63, w = F.wave, r = lane & 15, g = lane >> 4, kp = tid & 63, tg = w;
    f32x4 S[8];
#pragma unroll
    for (int t8 = 0; t8 < 8; ++t8)
#pragma unroll
        for (int i = 0; i < 4; ++i) S[t8][i] = s0 ? s0[(size_t)(16 * t8 + 4 * g + i) * 128 + 16 * w + r] : 0.f;
    const int cq = PC_Q + h * 128 + 2 * kp, cf = (dir == 0 ? PC_FF : PC_FB) + h * 128 + 2 * kp, ci = PC_I + h * 128 + 2 * kp;
    unsigned rq[4], rx[4], rv[4];
    const int tsgn = dir == 0 ? 1 : -1, tbase = dir == 0 ? 0 : T - 1;
    const int nch = c_end;
#define HG_L(c_) do { const int cc_ = (c_) < nch ? (c_) : nch - 1;     \
        _Pragma("unroll") for (int i = 0; i < 4; ++i) { const int tt = 32 * cc_ + 4 * tg + i, ta = tbase + tsgn * tt; const bf16* pr = F.PROJ + (size_t)(row_base + ta) * NMIX; \
        rq[i] = *(const GAS unsigned*)(pr + cq); rx[i] = *(const GAS unsigned*)(pr + cf); rv[i] = *(const GAS unsigned*)(pr + ci); } } while (0)
#define HG_P1(c_) do { { float acc0 = 0.f, acc1 = 0.f; \
        _Pragma("unroll") for (int i = 0; i < 4; ++i) { const h2_t lf = __builtin_bit_cast(h2_t, rx[i]); acc0 += (float)lf[0]; acc1 += (float)lf[1]; } \
        *(LAS f32x2*)(L + HG_GT + ((c_) & 1) * HG_GTB + (tg * 128 + 2 * kp) * 4) = (f32x2){acc0, acc1}; } } while (0)
#define HG_P2(c_) do { { LAS unsigned char* Lb = L + ((c_) & 1) * HG_BUF; const LAS unsigned char* Gt = L + HG_GT + ((c_) & 1) * HG_GTB; f32x2 off = {0.f, 0.f}, be = {0.f, 0.f}; \
        _Pragma("unroll") for (int g2 = 0; g2 < 8; ++g2) { const f32x2 v2 = *(const LAS f32x2*)(Gt + (g2 * 128 + 2 * kp) * 4); if (g2 < tg) off += v2; be += v2; } \
        float kh[2][4]; float b0 = off.x, b1 = off.y; \
        _Pragma("unroll") for (int i = 0; i < 4; ++i) { const int t = 4 * tg + i; const h2_t lf = __builtin_bit_cast(h2_t, rx[i]); const float l0 = (float)lf[0], l1 = (float)lf[1]; b0 += l0; b1 += l1; \
            const float B0 = fmaxf(b0, -80.f), B1 = fmaxf(b1, -80.f); \
            const float qt0 = bflo(rq[i]) * __expf(B0), qt1 = bfhi(rq[i]) * __expf(B1), kt0 = (1.0f - __expf(l0)) * __expf(-B0), kt1 = (1.0f - __expf(l1)) * __expf(-B1); kh[0][i] = kt0; kh[1][i] = kt1; \
            const int a = t * 256 + ((((kp >> 2) ^ (t & 15))) << 4) + (kp & 3) * 4; \
            *(LAS unsigned*)(Lb + HG_QT + a) = pk2(qt0, qt1); *(LAS unsigned*)(Lb + HG_KT + a) = pk2(kt0, kt1); } \
        _Pragma("unroll") for (int e = 0; e < 2; ++e) { const int k = 2 * kp + e; const int a = (((k >> 4) * 4 + (tg >> 1)) * 16 + (k & 15)) * 16 + 8 * (tg & 1); \
            *(LAS v2u*)(Lb + HG_KH + a) = (v2u){pk2(kh[e][0], kh[e][1]), pk2(kh[e][2], kh[e][3])}; \
            v2u vw; if (e == 0) { vw.x = (rv[0] & 0xffffu) | (rv[1] << 16); vw.y = (rv[2] & 0xffffu) | (rv[3] << 16); } else { vw.x = (rv[0] >> 16) | (rv[1] & 0xffff0000u); vw.y = (rv[2] >> 16) | (rv[3] & 0xffff0000u); } \
            *(LAS v2u*)(Lb + HG_VT + a) = vw; } \
        if (tg == 0) *(LAS f32x2*)(Lb + HG_PE + 2 * kp * 4) = (f32x2){__expf(be.x), __expf(be.y)}; } } while (0)
    HG_L(c_begin);
    int c = c_begin;
    for (; c < nch; ++c) {
        if (stopc && tid == 0) *(LAS unsigned*)(L + HG_FLAG) = (__hip_atomic_load(stopc, RLX_AGENT) >= stopneed) ? 1u : 0u;
        HG_P1(c);
        LDS_BARRIER();
        if (stopc && *(const LAS unsigned*)(L + HG_FLAG) != 0u) break;
        HG_P2(c); HG_L(c + 1);
        LDS_BARRIER();
        const LAS unsigned char* Lb = L + (c & 1) * HG_BUF;
        f32x4 d00 = {0.f, 0.f, 0.f, 0.f}, d01 = d00, d11 = d00;
#pragma unroll
        for (int ks = 0; ks < 4; ++ks) { const int co = (((4 * ks + g) ^ r) << 4);
            const bf16x8 kt0 = *(const LAS bf16x8*)(Lb + HG_KT + r * 256 + co), kt1 = *(const LAS bf16x8*)(Lb + HG_KT + (16 + r) * 256 + co);
            const bf16x8 qt0 = *(const LAS bf16x8*)(Lb + HG_QT + r * 256 + co), qt1 = *(const LAS bf16x8*)(Lb + HG_QT + (16 + r) * 256 + co);
            d00 = MFMA16(kt0, qt0, d00); d01 = MFMA16(kt0, qt1, d01); d11 = MFMA16(kt1, qt1, d11); }
        asm volatile("" ::: "memory");
#pragma unroll
        for (int i = 0; i < 4; ++i) if (4 * g + i > r) { d00[i] = 0.f; d11[i] = 0.f; }
        const v4u a0w = {pk2(d00[0], d00[1]), pk2(d00[2], d00[3]), 0u, 0u}, a1w = {pk2(d01[0], d01[1]), pk2(d01[2], d01[3]), pk2(d11[0], d11[1]), pk2(d11[2], d11[3])};
        const v2u vpl = *(const LAS v2u*)(Lb + HG_VT + ((w * 4 + (g >> 1)) * 16 + r) * 16 + 8 * (g & 1)), vph = *(const LAS v2u*)(Lb + HG_VT + ((w * 4 + 2 + (g >> 1)) * 16 + r) * 16 + 8 * (g & 1));
        const bf16x8 vperm = __builtin_bit_cast(bf16x8, (v4u){vpl.x, vpl.y, vph.x, vph.y});
        const bf16x8 vnat = *(const LAS bf16x8*)(Lb + HG_VT + ((w * 4 + g) * 16 + r) * 16);
        f32x4 o0 = MFMA16(__builtin_bit_cast(bf16x8, a0w), vperm, ((f32x4){0.f, 0.f, 0.f, 0.f})), o1 = MFMA16(__builtin_bit_cast(bf16x8, a1w), vperm, ((f32x4){0.f, 0.f, 0.f, 0.f}));
        asm volatile("" ::: "memory");
#pragma unroll
        for (int kk = 0; kk < 4; ++kk) {
            const v4u sw = {pk2(S[2 * kk][0], S[2 * kk][1]), pk2(S[2 * kk][2], S[2 * kk][3]), pk2(S[2 * kk + 1][0], S[2 * kk + 1][1]), pk2(S[2 * kk + 1][2], S[2 * kk + 1][3])};
            const int c_lo = (((4 * kk + (g >> 1)) ^ r) << 4) + 8 * (g & 1), c_hi = (((4 * kk + 2 + (g >> 1)) ^ r) << 4) + 8 * (g & 1);
            const v2u p0l = *(const LAS v2u*)(Lb + HG_QT + r * 256 + c_lo), p0h = *(const LAS v2u*)(Lb + HG_QT + r * 256 + c_hi);
            const v2u p1l = *(const LAS v2u*)(Lb + HG_QT + (16 + r) * 256 + c_lo), p1h = *(const LAS v2u*)(Lb + HG_QT + (16 + r) * 256 + c_hi);
            o0 = MFMA16(__builtin_bit_cast(bf16x8, (v4u){p0l.x, p0l.y, p0h.x, p0h.y}), __builtin_bit_cast(bf16x8, sw), o0);
            o1 = MFMA16(__builtin_bit_cast(bf16x8, (v4u){p1l.x, p1l.y, p1h.x, p1h.y}), __builtin_bit_cast(bf16x8, sw), o1); }
#pragma unroll
        for (int i = 0; i < 4; ++i) { const int t0 = 32 * c + 4 * g + i, t1 = t0 + 16, ta0 = tbase + tsgn * t0, ta1 = tbase + tsgn * t1;
            obuf[(size_t)(row_base + ta0) * 512 + h * 128 + 16 * w + r] = (bf16)(pk2(o0[i], 0.f) & 0xffffu); obuf[(size_t)(row_base + ta1) * 512 + h * 128 + 16 * w + r] = (bf16)(pk2(o1[i], 0.f) & 0xffffu); }
#pragma unroll
        for (int t8 = 0; t8 < 8; ++t8) { const bf16x8 khf = *(const LAS bf16x8*)(Lb + HG_KH + ((t8 * 4 + g) * 16 + r) * 16); const f32x4 pe = *(const LAS f32x4*)(Lb + HG_PE + (16 * t8 + 4 * g) * 4);
            S[t8] = MFMA16(khf, vnat, S[t8]) * pe; }
    }
#undef HG_L
#undef HG_P1
#undef HG_P2
    if (sfin) {
#pragma unroll
        for (int t8 = 0; t8 < 8; ++t8)
#pragma unroll
            for (int i = 0; i < 4; ++i) sfin[(size_t)(16 * t8 + 4 * g + i) * 128 + 16 * w + r] = S[t8][i];
    }
    __syncthreads();
    return c;
}

__device__ __forceinline__ bool early_chains(const Frame& F) { return EARLY_CHAINS && F.xok && F.G == 256; }
__device__ __forceinline__ void p5_chains(Frame& F, unsigned* cw) {
    if (F.xr >= 8) { if (F.tid == 0) (void)__hip_atomic_fetch_add(cw + CW_GDONE + 64 * F.xl, 1u, RLX_AGENT); return; }
    if (F.tid == 0) { unsigned sp = 0; while (__hip_atomic_load(cw + CW_SAMP + 64 * F.xl, RLX_AGENT) < 320u) { __builtin_amdgcn_s_sleep(2); if (++sp > (1u << 22)) break; }
        __builtin_amdgcn_fence(__ATOMIC_ACQUIRE, "agent"); asm volatile("s_waitcnt vmcnt(0)" ::: "memory"); }
    __syncthreads();
    const int b = F.xl - 6, dir = F.xr & 1, h = F.xr >> 1, v = b * 8 + F.xr;
    const int c = hgrn_unit(F, M_P + b * T_S, T_S, h, dir, F.state0 + ((size_t)(b * 2 + dir) * 4 + h) * 16384, F.hsave + (size_t)v * 16384, dir == 0 ? F.OF : F.OB, 0, T_S / 32, cw + CW_GDONE + 64 * F.xl, 24u);
    if (F.tid == 0) F.hidx[v] = c;
}
__device__ __forceinline__ void p6_phase(Frame& F) {
    const bool ec = early_chains(F);
    const bool head = ec ? (F.xl >= 6 && F.xr < 8) : ((int)blockIdx.x < N_HEADWG);
    if (head) { const int v = ec ? (F.xl - 6) * 8 + F.xr : (int)blockIdx.x, dir = v & 1, h = (v >> 1) & 3, b = v >> 3;
        const int c0 = ec ? F.hidx[v] : 0, c1 = c0 + HG_HEAD < T_S / 32 ? c0 + HG_HEAD : T_S / 32;
        if (c0 < c1) hgrn_unit(F, M_P + b * T_S, T_S, h, dir, ec ? F.hsave + (size_t)v * 16384 : F.state0 + ((size_t)(b * 2 + dir) * 4 + h) * 16384, F.hsave + (size_t)v * 16384, dir == 0 ? F.OF : F.OB, c0, c1);
        if (F.tid == 0) F.hidx[v] = c1; }
    else { const int dense = ec ? (F.xl < 6 ? F.xl * 32 + F.xr : 192 + (F.xl - 6) * 24 + (F.xr - 8)) : (int)blockIdx.x - N_HEADWG;
        p6a_prep(F, dense); if (CONV_P6) convert_queue(F, CW_CONVQ + 320, CV_LATE0, CV_LATE_N); }
}

__device__ __forceinline__ int crow(int r, int hi) { return (r & 3) + 8 * (r >> 2) + 4 * hi; }
constexpr int AT_K = 0, AT_V = 16384, AT_STAGE = 16384 + 128 * 136, XCH_SLOT = 64 * 64 * 4;
__device__ __forceinline__ void attn_finish(Frame& F, const f32x16 (&o)[4], const LAS float* slot, float lam, int row0, int h, int lane) {
    const int r32 = lane & 31, hi = lane >> 5;
    f32x16 d[4]; float ss = 0.f;
#pragma unroll
    for (int dv = 0; dv < 4; ++dv)
#pragma unroll
        for (int r = 0; r < 16; ++r) { const float x = o[dv][r] - lam * slot[(dv * 16 + r) * 64 + lane]; d[dv][r] = x; ss += x * x; }
    ss += __shfl_xor(ss, 32);
    const float rstd = (1.0f - LAM_INIT) / sqrtf(ss * (1.0f / 128.0f) + EPS);
    bf16* orow = F.ABUF2 + (size_t)(row0 + r32) * DM + 512 + h * 128;
#pragma unroll
    for (int dv = 0; dv < 4; ++dv)
#pragma unroll
        for (int g = 0; g < 4; ++g) { const int c = 32 * dv + 8 * g + 4 * hi; const f32x4 w4 = *(const GAS f32x4*)(F.attn_subln + c);
            v2u w; w.x = pk2(d[dv][4 * g] * rstd * w4.x, d[dv][4 * g + 1] * rstd * w4.y); w.y = pk2(d[dv][4 * g + 2] * rstd * w4.z, d[dv][4 * g + 3] * rstd * w4.w);
            *(GAS v2u*)(orow + c) = w; }
}
__device__ __forceinline__ float attn_lam(Frame& F) {
    const float a = F.attn_lambda[F.lane] * F.attn_lambda[64 + F.lane], b = F.attn_lambda[128 + F.lane] * F.attn_lambda[192 + F.lane];
    return __expf(wave_sum(a)) - __expf(wave_sum(b)) + LAM_INIT;
}
__device__ __forceinline__ void attn_unit(Frame& F, const bf16* Kb, const bf16* VTb, int TK, int row0, int h) {
    LAS unsigned char* L = F.lds;
    int tid_ = F.tid; asm volatile("" : "+v"(tid_));
    const int tid = tid_, w = F.wave, lane = tid & 63, mp = w >> 2, qb = w & 3, r32 = lane & 31, hi = lane >> 5;
    const float lam = attn_lam(F);
    bf16x8 qf[4];
    { const bf16* Qp = F.QB + (size_t)(row0 + 32 * qb + r32) * 512 + h * 128 + mp * 64 + 8 * hi;
#pragma unroll
      for (int s = 0; s < 4; ++s) qf[s] = *(const GAS bf16x8*)(Qp + 16 * s); }
    f32x16 o[4];
#pragma unroll
    for (int d = 0; d < 4; ++d) o[d] = f32x16{};
    float m_run = -1e30f, l_run = 0.f;
    v4u kreg[2], vreg[2];
    const int krow0 = tid >> 4, kch = tid & 15, vrow0 = tid >> 3, vch = tid & 7;
#define AT_LOAD(kv0_) do { _Pragma("unroll") for (int i = 0; i < 2; ++i) { kreg[i] = *(const GAS v4u*)(Kb + (size_t)((kv0_) + krow0 + 32 * i) * 512 + h * 128 + kch * 8); \
        vreg[i] = *(const GAS v4u*)(VTb + (size_t)(vrow0 + 64 * i) * TK + (kv0_) + vch * 8); } } while (0)
#define AT_WRITE(st_) do { LAS unsigned char* Ls_ = L + (st_) * AT_STAGE; _Pragma("unroll") for (int i = 0; i < 2; ++i) { const int kr = krow0 + 32 * i, vr = vrow0 + 64 * i; \
        *(LAS v4u*)(Ls_ + AT_K + kr * 256 + ((kch ^ (kr & 15)) << 4)) = kreg[i]; \
        *(LAS v2u*)(Ls_ + AT_V + vr * 136 + vch * 16) = (v2u){vreg[i].x, vreg[i].y}; *(LAS v2u*)(Ls_ + AT_V + vr * 136 + vch * 16 + 8) = (v2u){vreg[i].z, vreg[i].w}; } } while (0)
    const int ntiles = TK >> 6;
    AT_LOAD(0); AT_WRITE(0);
    __syncthreads();
    for (int t = 0; t < ntiles; ++t) {
        if (t + 1 < ntiles) AT_LOAD((t + 1) * 64);
        const LAS unsigned char* Ls = L + (t & 1) * AT_STAGE;
#pragma unroll
        for (int j = 0; j < 2; ++j) {
            f32x16 p = f32x16{};
            __builtin_amdgcn_s_setprio(1);
#pragma unroll
            for (int s = 0; s < 4; ++s) { const bf16x8 kf = *(const LAS bf16x8*)(Ls + AT_K + (32 * j + r32) * 256 + (((mp * 8 + 2 * s + hi) ^ (r32 & 15)) << 4));
                p = __builtin_amdgcn_mfma_f32_32x32x16_bf16(kf, qf[s], p, 0, 0, 0); }
            __builtin_amdgcn_s_setprio(0);
            float mx = p[0];
#pragma unroll
            for (int r = 1; r < 16; ++r) mx = fmaxf(mx, p[r]);
            mx = fmaxf(mx, __shfl_xor(mx, 32));
            const float mnew = (mx > m_run + 8.0f) ? mx : m_run, alpha = __builtin_amdgcn_exp2f(m_run - mnew); m_run = mnew;
            float ls = 0.f;
#pragma unroll
            for (int r = 0; r < 16; ++r) { p[r] = __builtin_amdgcn_exp2f(p[r] - mnew); ls += p[r]; }
            l_run = l_run * alpha + ls;
            if (__any(alpha != 1.0f)) {
#pragma unroll
                for (int d = 0; d < 4; ++d)
#pragma unroll
                    for (int r = 0; r < 16; ++r) o[d][r] *= alpha; }
            __builtin_amdgcn_s_setprio(1);
#pragma unroll
            for (int s = 0; s < 2; ++s) { const v4u pw = {pk2(p[8 * s + 0], p[8 * s + 1]), pk2(p[8 * s + 2], p[8 * s + 3]), pk2(p[8 * s + 4], p[8 * s + 5]), pk2(p[8 * s + 6], p[8 * s + 7])};
#pragma unroll
                for (int d = 0; d < 4; ++d) { const LAS unsigned char* vp = Ls + AT_V + (32 * d + r32) * 136 + (32 * j + 16 * s + 4 * hi) * 2;
                    const v2u lo = *(const LAS v2u*)vp, hh = *(const LAS v2u*)(vp + 16);
                    o[d] = __builtin_amdgcn_mfma_f32_32x32x16_bf16(__builtin_bit_cast(bf16x8, (v4u){lo.x, lo.y, hh.x, hh.y}), __builtin_bit_cast(bf16x8, pw), o[d], 0, 0, 0); } }
            __builtin_amdgcn_s_setprio(0);
        }
        if (t + 1 < ntiles) AT_WRITE((t + 1) & 1);
        __syncthreads();
    }
#undef AT_LOAD
#undef AT_WRITE
    const float inv = 1.0f / (l_run + __shfl_xor(l_run, 32));
#pragma unroll
    for (int d = 0; d < 4; ++d)
#pragma unroll
        for (int r = 0; r < 16; ++r) o[d][r] *= inv;
    LAS float* slot = (LAS float*)(L + qb * XCH_SLOT);
    if (mp == 1) {
#pragma unroll
        for (int d = 0; d < 4; ++d)
#pragma unroll
            for (int r = 0; r < 16; ++r) slot[(d * 16 + r) * 64 + lane] = o[d][r];
    }
    __syncthreads();
    if (mp == 0) attn_finish(F, o, slot, lam, row0 + 32 * qb, h, lane);
    __syncthreads();
}

__device__ __forceinline__ void p6b_mixers(Frame& F, int qrun) {
    constexpr int N_HS = NB_S * 4 * 2, N_AS = NB_S * 4 * 8, N_HP = NB_P * 4 * 2, N_AP = NB_P * 4 * 2, N_ALL = N_HS + N_AS + N_HP + N_AP, N_CV = (CONV_LATE_P3 || CONV_P6 || CONV_P5TAIL) ? 0 : (CONV_P9 ? CV_MO / 16 : CV_LATE_N / 16);
    volatile LAS int* qslot = (volatile LAS int*)(F.lds + MISC_OFF + 64);
    for (;;) {
        if (F.tid == 0) *qslot = (int)__hip_atomic_fetch_add(F.ctl + CW_QUEUE + 64 * qrun, 1u, RLX_AGENT);
        __syncthreads();
        int u = *qslot;
        __syncthreads();
        if (u >= N_ALL + N_CV) break;
        if (u >= N_ALL) {
            LAS float* scr = (LAS float*)(F.lds + RING_OFF + F.wave * 16384);
            for (int j = 0; j < 2; ++j) convert_item(F, scr, CV_LATE0 + (u - N_ALL) * 16 + F.wave * 2 + j);
            __syncthreads(); continue; }
#ifdef PROBE_SUB
        if (qrun) { const int cls = u < N_HS ? 0 : u < N_HS + N_AS ? 1 : u < N_HS + N_AS + N_HP ? 2 : 3; if (!((PROBE_SUB >> cls) & 1)) continue; }
#endif
        const bool is_hs = u < N_HS, is_as = !is_hs && u < N_HS + N_AS, is_hp = !is_hs && !is_as && u < N_HS + N_AS + N_HP;
        if (is_hs || is_hp) { const int v = is_hs ? u : u - N_HS - N_AS; const int dir = v & 1, h = (v >> 1) & 3, b = v >> 3;
            hgrn_unit(F, is_hs ? M_P + b * T_S : b * T_P, is_hs ? T_S : T_P, h, dir, is_hs ? F.hsave + (size_t)v * 16384 : nullptr,
                      (is_hs || qrun) ? nullptr : F.out + OUT_S + ((size_t)(b * 2 + dir) * 4 + h) * 16384, dir == 0 ? F.OF : F.OB, is_hs ? F.hidx[v] : 0, is_hs ? T_S / 32 : T_P / 32); continue; }
        { const int v = is_as ? u - N_HS : u - N_HS - N_AS - N_HP;
          const int h = is_as ? (v >> 3) & 3 : (v >> 1) & 3, b = is_as ? v >> 5 : v >> 3, qo = is_as ? (v & 7) * 128 : (v & 1) * 128;
          attn_unit(F, is_as ? F.KS + (size_t)b * TK_S * 512 : F.KB + (size_t)b * T_P * 512, is_as ? F.VTS + (size_t)(b * 4 + h) * 128 * TK_S : F.VTP + (size_t)(b * 4 + h) * 128 * T_P,
                    is_as ? TK_S : T_P, (is_as ? M_P + b * T_S : b * T_P) + qo, h); }
    }
}

__device__ __forceinline__ void p7_combine(Frame& F) {
    const int lane = F.lane, xl = F.xl, wl = F.xr * NWAVES + F.wave, NWL = (F.G / 8) * NWAVES;
    float nw[8];
#pragma unroll
    for (int j = 0; j < 8; ++j) nw[j] = F.hgrn_out_norm[(8 * lane + j) & 127];
    for (int rl = wl; rl < M / 8; rl += NWL) { const int row = pg8::pmap(5 * xl + (rl >> 8)) * 256 + (rl & 255);
        const v4u fa = *(const GAS v4u*)(F.OF + (size_t)row * 512 + 8 * lane), ba = *(const GAS v4u*)(F.OB + (size_t)row * 512 + 8 * lane);
        const float o[8] = {bflo(fa.x) + bflo(ba.x), bfhi(fa.x) + bfhi(ba.x), bflo(fa.y) + bflo(ba.y), bfhi(fa.y) + bfhi(ba.y), bflo(fa.z) + bflo(ba.z), bfhi(fa.z) + bfhi(ba.z), bflo(fa.w) + bflo(ba.w), bfhi(fa.w) + bfhi(ba.w)};
        float ss = 0.f;
#pragma unroll
        for (int j = 0; j < 8; ++j) ss += o[j] * o[j];
        ss += __shfl_xor(ss, 1); ss += __shfl_xor(ss, 2); ss += __shfl_xor(ss, 4); ss += __shfl_xor(ss, 8);
        const float rstd = 1.0f / sqrtf(ss * (1.0f / 128.0f) + EPS);
        const v4u ga = *(const GAS v4u*)(F.PROJ + (size_t)row * NMIX + PC_G + 8 * lane);
        const float g[8] = {bflo(ga.x), bfhi(ga.x), bflo(ga.y), bfhi(ga.y), bflo(ga.z), bfhi(ga.z), bflo(ga.w), bfhi(ga.w)};
        float y[8];
#pragma unroll
        for (int j = 0; j < 8; ++j) y[j] = o[j] * rstd * nw[j] * (g[j] * sigmoid_f(g[j]));
        v4u w; w.x = pk2(y[0], y[1]); w.y = pk2(y[2], y[3]); w.z = pk2(y[4], y[5]); w.w = pk2(y[6], y[7]);
        *(GAS v4u*)(F.ABUF2 + (size_t)row * DM + 8 * lane) = w;
    }
}

struct Args { const float* in[24]; float* out; unsigned char* ws; int ph_lo, ph_hi, use_bar, pad; };
__global__ void __launch_bounds__(NWAVES * 64, 2) hymba_fwd(Args args) {
    extern __shared__ __attribute__((aligned(16))) unsigned char lds[];
    Frame F;
    F.lds = (LAS unsigned char*)lds;
    F.MISC = (volatile LAS unsigned*)(F.lds + MISC_OFF);
    F.tid = threadIdx.x; F.lane = F.tid & 63; F.wave = __builtin_amdgcn_readfirstlane(F.tid >> 6);
    F.G = gridDim.x; { const int bx = blockIdx.x; F.vcu = (F.G % 8 == 0) ? (bx % 8) * (F.G / 8) + bx / 8 : bx; }
    unsigned char* ws = args.ws;
    F.ctl = (gu32*)(ws + WS_CTL);
    F.x_prompt = args.in[0]; F.x_sample = args.in[1]; F.c = args.in[2]; F.cache_k = args.in[3]; F.cache_v = args.in[4]; F.state0 = args.in[5]; F.c_ctx = args.in[6];
    F.w_ada = args.in[7]; F.b_ada = args.in[8]; F.norm_ffn1 = args.in[9]; F.w_ffn1_in = args.in[10]; F.w_ffn1_out = args.in[11]; F.norm_mix = args.in[12]; F.w_mix_in = args.in[13]; F.w_mix_out = args.in[14];
    F.lb_logits = args.in[15]; F.hgrn_out_norm = args.in[16]; F.q_norm = args.in[17]; F.k_norm = args.in[18]; F.attn_lambda = args.in[19]; F.attn_subln = args.in[20]; F.norm_ffn2 = args.in[21];
    F.w_ffn2_in = args.in[22]; F.w_ffn2_out = args.in[23]; F.out = args.out;
    F.mada = (float*)(ws + WS_MADA); F.rope = (float*)(ws + WS_ROPE); F.lbv = (float*)(ws + WS_LB);
    F.W1I = (bf16*)(ws + WS_W1I); F.W1O = (bf16*)(ws + WS_W1O); F.WMI = (bf16*)(ws + WS_WMI); F.WMO = (bf16*)(ws + WS_WMO); F.W2I = (bf16*)(ws + WS_W2I); F.W2O = (bf16*)(ws + WS_W2O);
    F.ABUF = (bf16*)(ws + WS_ABUF); F.ABUF2 = (bf16*)(ws + WS_ABUF2); F.rowss = (float*)(ws + WS_ROWSS); F.bias2m = (float*)(ws + WS_BIAS2); F.bias2f = F.bias2m + 3 * 4096; F.hsave = (float*)(ws + WS_HSAVE); F.hidx = (int*)(ws + WS_ROWSS); F.HID = (bf16*)(ws + WS_BIG); F.PROJ = (bf16*)(ws + WS_BIG); F.QB = (bf16*)(ws + WS_QB); F.KB = (bf16*)(ws + WS_KB); F.KS = (bf16*)(ws + WS_KS);
    F.VTP = (bf16*)(ws + WS_VTP); F.VTS = (bf16*)(ws + WS_VTS); F.OF = (bf16*)(ws + WS_OF); F.OB = (bf16*)(ws + WS_OB);
    for (int u = F.tid; u < (LDS_BYTES - LDSCTL_OFF) / 4; u += NWAVES * 64) ((LAS unsigned*)(F.lds + LDSCTL_OFF))[u] = 0u;
    __syncthreads();
    XcdBarrier bar; bar.bar = (unsigned*)(F.ctl + CW_BAR); bar.x = 0; bar.st = nullptr;
    if (args.use_bar) bar = xcd_barrier_post((unsigned*)(F.ctl + CW_BAR), F.MISC + 8);
    const int lo = args.ph_lo, hi = args.ph_hi;
#ifndef PROBE_DUP
#define PROBE_DUP 0u
#endif
#define IN(k) (lo <= (k) && (k) < hi)
#define SEAM_LOCAL(k) (LOCAL_SEAMS && !FUSE_NORM && !MERGE_FFN && ((k) == 1 || (k) == 3 || (k) == 9 || (k) == 10 || (k) == 11))
#define SEAM(k) do { if (IN(k) && IN((k) + 1) && !(MERGE_FFN && !FUSE_NORM && ((k) == 2 || (k) == 11))) { if (SEAM_LOCAL(k) && F.xok) xcc_barrier(bar, cw + CW_LBAR); else xcd_barrier(bar); } } while (0)
#define PHASE(k, ...) if (IN(k)) { constexpr bool dupk = ((PROBE_DUP) >> (k)) & 1u; \
        if constexpr (dupk) { _Pragma("unroll 1") for (int qrun = 0; qrun < 2; ++qrun) { if (qrun) xcd_barrier(bar); __VA_ARGS__ } } \
        else { constexpr int qrun = 0; (void)qrun; __VA_ARGS__ } } SEAM(k)
#ifdef PROBE_EPI
#define PROBE_EPI_FLAG args.pad
#else
#define PROBE_EPI_FLAG 0
#endif
#ifdef PROBE_BMUL
#define PROBE_GEMM_HOOK if (args.pad) { g.bmul = (PROBE_BMUL) & 1; g.amul = ((PROBE_BMUL) >> 1) & 1; }
#else
#define PROBE_GEMM_HOOK
#endif
#ifndef PROBE_FFN_PART
#define PROBE_FFN_PART 0
#endif
#ifndef PROBE_FORCE_LOCAL
#define PROBE_FORCE_LOCAL 0
#endif
#define COMMA ,
#define GEMM_PHASE(EPI, A_, B_, N_, K_, ...) do { Gemm g{A_, B_, M, N_, K_}; PROBE_GEMM_HOOK; StaticOrder S; S.init(M, N_, F.G, F.xr * 8 + F.xl); typedef pg8::EPI EpiT; EpiT E{__VA_ARGS__}; \
        pg8::gemm_phase<EpiT, StaticOrder, PG8_ALIGN, PG8_SP2>(F.lds + RING_OFF, g, S, E); } while (0)
    using pg8::Gemm; using pg8::StaticOrder;
    constexpr int KFI = FP8_FFN_IN ? DM / 2 : DM;
    float* const outS = F.out + (size_t)M_P * DM;
    F.xl = (int)blockIdx.x % 8; F.xr = (int)blockIdx.x / 8; F.xok = PROBE_FORCE_LOCAL;
#define RELABEL() do { if (args.use_bar && IN(0) && IN(1)) { const unsigned verdict = F.MISC[11], rk = F.MISC[10]; if (verdict == 1u && rk < (unsigned)(F.G / 8)) { F.xok = 1; F.xl = (int)bar.x; F.xr = (int)rk; } } } while (0)
    unsigned* const cw = (unsigned*)F.ctl;
#if FUSE_NORM
    PHASE(0, p0_prologue(F); );
    PHASE(1, norm_mod_phase<false>(F, F.x_prompt, F.x_sample, F.norm_ffn1, 0, 1); bias2_rows(F, F.WMI, NMIX, 3, F.bias2m); bias2_rows(F, F.W2I, NFF, 6, F.bias2f); );
    PHASE(2, GEMM_PHASE(EpiSwiGLU<false>, F.ABUF, F.W1I, NFF, KFI, F.HID, DFF, nullptr, nullptr, PROBE_EPI_FLAG); if (CONV_P2TAIL) convert_queue(F, CW_CONVQ, CV_FI, CV_FO + CV_MI); );
    PHASE(3, GEMM_PHASE(EpiResid<true COMMA true>, F.HID, F.W1O, DM, DFF, F.x_prompt, F.x_sample, F.out, F.mada + 2 * 1024, F.ABUF, F.norm_mix, F.mada + 4 * 1024, F.rowss);
             if (CONV_LATE_P3) convert_queue(F, CW_CONVQ + 64, CV_LATE0, CV_LATE_N); );
    PHASE(4, GEMM_PHASE(EpiProj<true>, F.ABUF, F.WMI, NMIX, DM, F.PROJ, F.out + OUT_V, F.lbv, F.rowss, F.bias2m); );
    PHASE(5, p6_phase(F); );
    PHASE(6, p6b_mixers(F, qrun + args.pad); );
    PHASE(7, p7_combine(F); );
    PHASE(8, GEMM_PHASE(EpiResid<true COMMA false>, F.ABUF2, F.WMO, DM, DM, F.out, outS, F.out, F.mada + 5 * 1024, F.ABUF, F.norm_ffn2, F.mada + 7 * 1024, F.rowss); );
    PHASE(9, GEMM_PHASE(EpiSwiGLU<true>, F.ABUF, F.W2I, NFF, DM, F.HID, DFF, F.rowss, F.bias2f, NFF); );
    PHASE(10, GEMM_PHASE(EpiResid<false COMMA true>, F.HID, F.W2O, DM, DFF, F.out, outS, F.out, F.mada + 8 * 1024, nullptr, nullptr, nullptr, nullptr); );
#else
    PHASE(0, p0_prologue(F); );
    RELABEL();
    PHASE(1, norm_mod_phase<FP8_FFN_IN != 0>(F, F.x_prompt, F.x_sample, F.norm_ffn1, 0, 1); );
#if MERGE_FFN
#define FFN_MERGED(AIN, WIN, WOUT, B0, B1, GATE, PC, UC) do { \
        if (!(args.pad && PROBE_FFN_PART == 2)) { Gemm g{AIN, WIN, M, NFF, DM}; pg8::XccInOrder S{F.xl, F.xr, cw + (PC) + 4096 * args.pad, F.xok}; typedef pg8::EpiSwiGLU<false> EpiT; EpiT E{F.HID, DFF, nullptr, nullptr, 0}; \
          pg8::gemm_phase<EpiT, pg8::XccInOrder, PG8_ALIGN, PG8_SP2>(F.lds + RING_OFF, g, S, E); } \
        if (!(args.pad && PROBE_FFN_PART == 1)) { Gemm g{F.HID, WOUT, M, DM, DFF}; pg8::XccOutOrder S{F.xl, F.xr, cw + (PC) + (PROBE_FFN_PART == 2 ? 0 : 4096 * args.pad)}; typedef pg8::EpiResidSplit<true> EpiT; EpiT E{B0, B1, args.pad ? (float*)(args.ws + WS_OF) : F.out, GATE, (float*)(args.ws + WS_SLAB), cw + (UC) + 4096 * args.pad, F.xl, F.xok};     \
          pg8::gemm_phase<EpiT, pg8::XccOutOrder, PG8_ALIGN, PG8_SP2>(F.lds + RING_OFF, g, S, E); } } while (0)
    PHASE(2, FFN_MERGED(F.ABUF, F.W1I, F.W1O, F.x_prompt, F.x_sample, F.mada + 2 * 1024, CW_PANEL1, CW_UNIT1); );
    PHASE(3, ; );
#else
    PHASE(2, GEMM_PHASE(EpiSwiGLU<false>, F.ABUF, F.W1I, NFF, KFI, F.HID, DFF, nullptr, nullptr, PROBE_EPI_FLAG); if (CONV_P2TAIL) convert_queue(F, CW_CONVQ, CV_FI, CV_FO + CV_MI); );
    PHASE(3, GEMM_PHASE(EpiResid<false COMMA true>, F.HID, F.W1O, DM, DFF, F.x_prompt, F.x_sample, F.out, F.mada + 2 * 1024, nullptr, nullptr, nullptr, nullptr);
             if (CONV_LATE_P3) convert_queue(F, CW_CONVQ + 64, CV_LATE0, CV_LATE_N); );
#endif
    PHASE(4, norm_mod_phase<false>(F, F.out, outS, F.norm_mix, 3, 4); );
    PHASE(5, { Gemm g{F.ABUF, F.WMI, M, NMIX, DM}; StaticOrder S; S.init(M, NMIX, F.G, F.xr * 8 + F.xl); const bool ec = early_chains(F) && !args.pad;
               if (ec) { S.sf = 1; S.sc = cw + CW_SAMP + 64 * F.xl; S.local = 1; }
               typedef pg8::EpiProj<false> EpiT; EpiT E{F.PROJ, F.out + OUT_V, F.lbv, nullptr, nullptr};
               pg8::gemm_phase<EpiT, StaticOrder, PG8_ALIGN, PG8_SP2>(F.lds + RING_OFF, g, S, E);
               if (ec && F.xl >= 6) p5_chains(F, cw);
               if (CONV_P5TAIL && !(ec && F.xl >= 6 && F.xr < 8)) convert_queue(F, CW_CONVQ + 384, CV_LATE0, CV_LATE_N); } );
    PHASE(6, p6_phase(F); );
    PHASE(7, p6b_mixers(F, qrun + args.pad); );
    PHASE(8, p7_combine(F); );
    PHASE(9, GEMM_PHASE(EpiResid<false COMMA false>, F.ABUF2, F.WMO, DM, DM, F.out, outS, F.out, F.mada + 5 * 1024, nullptr, nullptr, nullptr, nullptr);
             if (CONV_P9) convert_queue(F, CW_CONVQ + 192, CV_LATE0 + CV_MO, CV_FI + CV_FO); );
    PHASE(10, norm_mod_phase<FP8_FFN_IN != 0>(F, F.out, outS, F.norm_ffn2, 6, 7); );
#if MERGE_FFN
    PHASE(11, FFN_MERGED(F.ABUF, F.W2I, F.W2O, F.out, outS, F.mada + 8 * 1024, CW_PANEL2, CW_UNIT2); );
    PHASE(12, ; );
#else
    PHASE(11, GEMM_PHASE(EpiSwiGLU<false>, F.ABUF, F.W2I, NFF, KFI, F.HID, DFF, nullptr, nullptr, 0); );
    PHASE(12, GEMM_PHASE(EpiResid<false COMMA true>, F.HID, F.W2O, DM, DFF, F.out, outS, F.out, F.mada + 8 * 1024, nullptr, nullptr, nullptr, nullptr); );
#endif
#endif
#ifdef PROBE_XBAR
#pragma unroll 1
    for (int i = 0; i < PROBE_XBAR; ++i) xcd_barrier(bar);
#endif
#undef IN
#undef SEAM
#undef PHASE
#undef GEMM_PHASE
}

extern "C" void kernel_launch(void* const* d_in, const int* in_sizes, int n_in, void* d_out, int out_size, void* d_ws, size_t ws_size, hipStream_t stream) {
    static int grid = 0;
    if (grid == 0) {
        if (n_in != 24 || in_sizes[0] != M_P * DM || in_sizes[1] != M_S * DM || (size_t)out_size != OUT_END || ws_size < WS_END) {
            fprintf(stderr, "kernel_launch: unexpected shapes (n_in %d, out %d, ws %zu); nothing launched\n", n_in, out_size, ws_size); grid = -1; return; }
        int dev = 0, cus = 0, per_cu = 0;
        if (hipGetDevice(&dev) != hipSuccess || hipDeviceGetAttribute(&cus, hipDeviceAttributeMultiprocessorCount, dev) != hipSuccess) { grid = -1; return; }
        if (hipFuncSetAttribute((const void*)hymba_fwd, hipFuncAttributeMaxDynamicSharedMemorySize, LDS_BYTES) != hipSuccess) { fprintf(stderr, "kernel_launch: hipFuncSetAttribute failed\n"); grid = -1; return; }
        if (hipOccupancyMaxActiveBlocksPerMultiprocessor(&per_cu, (const void*)hymba_fwd, NWAVES * 64, LDS_BYTES) != hipSuccess || per_cu < 1) {
            fprintf(stderr, "kernel_launch: occupancy query reports %d workgroups per CU; nothing launched\n", per_cu); (void)hipGetLastError(); grid = -1; return; }
        grid = cus;
        if (grid % 8 != 0) grid -= grid % 8;
        if (MERGE_FFN && grid != 256) { fprintf(stderr, "kernel_launch: this build needs a 256-CU device (got %d workgroups); nothing launched\n", grid); grid = -1; return; }
    }
    if (grid < 0) return;
    if (hipMemsetAsync((char*)d_ws + WS_CTL, 0, CTL_ZERO_BYTES, stream) != hipSuccess) return;
    Args a{};
    for (int i = 0; i < 24; ++i) a.in[i] = (const float*)d_in[i];
    a.out = (float*)d_out; a.ws = (unsigned char*)d_ws;
#if MK_ONE_LAUNCH
    a.ph_lo = 0; a.ph_hi = N_PHASES; a.use_bar = 1;
    hipLaunchKernelGGL(hymba_fwd, dim3(grid), dim3(NWAVES * 64), LDS_BYTES, stream, a);
#ifdef PROBE_RELAUNCH
    a.ph_lo = PROBE_RELAUNCH; a.ph_hi = PROBE_RELAUNCH + 1; a.use_bar = 0; a.pad = 1;
    hipLaunchKernelGGL(hymba_fwd, dim3(grid), dim3(NWAVES * 64), LDS_BYTES, stream, a);
#endif
#else
    for (int p = 0; p < N_PHASES; ++p) { a.ph_lo = p; a.ph_hi = p + 1; a.use_bar = 0; hipLaunchKernelGGL(hymba_fwd, dim3(grid), dim3(NWAVES * 64), LDS_BYTES, stream, a); }
#endif
}
```

```cpp
#include <hip/hip_runtime.h>
#include <cstdio>
#include <cstdint>
#define MK_ONE_LAUNCH 1
#define PROBE_DUP 0u
#define FP8_FFN1_OUT 1
#define FP8_FFN2_OUT 1
#ifndef FFN_IN_MODE
#define FFN_IN_MODE 2
#endif
#define FP8_FFN_IN (FFN_IN_MODE == 1)
#define I8_FFN_IN (FFN_IN_MODE == 2)
#ifndef FP8_FFN1_OUT
#define FP8_FFN1_OUT 0
#endif
#ifndef FP8_FFN2_OUT
#define FP8_FFN2_OUT 0
#endif
constexpr float F8_SA = 8.0f, F8_SW = 128.0f, F8_ACC = 1.0f / (F8_SA * F8_SW);
__device__ __forceinline__ float f8_clamp(float x) { return __builtin_fminf(__builtin_fmaxf(x, -448.0f), 448.0f); }
__device__ __forceinline__ unsigned pk4_f8(float a, float b, float c, float d) { int w = 0; w = __builtin_amdgcn_cvt_pk_fp8_f32(f8_clamp(a), f8_clamp(b), w, false); w = __builtin_amdgcn_cvt_pk_fp8_f32(f8_clamp(c), f8_clamp(d), w, true); return (unsigned)w; }
__device__ __forceinline__ unsigned pk4_i8(float a, float b, float c, float d) {
    const unsigned ua = __builtin_bit_cast(unsigned, a + 12582912.0f), ub = __builtin_bit_cast(unsigned, b + 12582912.0f), uc = __builtin_bit_cast(unsigned, c + 12582912.0f), ud = __builtin_bit_cast(unsigned, d + 12582912.0f);
    const unsigned lo = __builtin_amdgcn_perm(ub, ua, 0x0c0c0400u), hi = __builtin_amdgcn_perm(ud, uc, 0x0c0c0400u);
    return __builtin_amdgcn_perm(hi, lo, 0x05040100u);
}
namespace pg8 {
#define PG8_LAS __attribute__((address_space(3)))
typedef unsigned short bf16_t;
typedef short bf16x8 __attribute__((ext_vector_type(8)));
typedef float f32x4 __attribute__((ext_vector_type(4)));
typedef unsigned u32x4 __attribute__((ext_vector_type(4)));
constexpr int BM = 256, BK = 64, HALF = 128, HTB = HALF * BK * 2  , STAGE_BYTES = 8 * HTB, NXCD = 8, WGM = 5;

__host__ __device__ __forceinline__ int lds_byte(int r, int c) { const int st = (r >> 4) * 2 + (c >> 5), rr = r & 15, cc = c & 31, ob = rr * 64 + cc * 2; return st * 1024 + (ob ^ (((ob >> 9) & 1) << 5)); }
__host__ __device__ __forceinline__ void stage_rc(int b, int& R, int& C) { const int st = b / 1024, sb = b % 1024, swz = sb ^ (((sb >> 9) & 1) << 5); R = (st >> 1) * 16 + swz / 64; C = (st & 1) * 32 + (swz % 64) / 2; }
__host__ __device__ __forceinline__ int perm32(int rho) { const int n = rho >> 4, i = rho & 15; return 8 * (i >> 2) + 4 * n + (i & 3); }

struct Unit { int pm, pn, k0, nk, kq; };
__host__ __device__ __forceinline__ int pmap(int t) { const unsigned q = (unsigned)(t - 30); return q <= 5u ? t + (int)((0x055554u >> (4u * q)) & 15u) - 4 : t; }
__device__ __forceinline__ void publish_wave(unsigned* cnt, int local);
struct Gemm { const bf16_t* A; const bf16_t* Bt; int M, N, K; int bmul = 1, amul = 1; };

struct StaticOrder {
    int nM, nN, nwg, G, c;
    int sf = 0; unsigned* sc = nullptr; int local = 0;
    __host__ __device__ void init(int M, int N, int G_, int c_) { nM = M / BM; nN = N / BM; nwg = nM * nN; G = G_; c = c_; }
    __host__ __device__ bool next(int i, Unit& u) const {
        int pm, pn, kq = 0; bool ok;
        if (sf && (c & 7) >= 6) {
            const int x = c & 7, r = c >> 3;
            const int j = (r < 8 || i == 0) ? r + 32 * i : 40 + (r - 8) + 24 * (i - 1);
            ok = (r < 8) ? (i < 2) : (i <= 2 && j < 80);
            const int jj = j - 40, j2 = jj - 16;
            const int p = j < 40 ? 1 + (j & 3) : (jj < 16 ? 0 : 1 + (j2 & 3));
            pn = j < 40 ? (j >> 2) : (jj < 16 ? jj : 10 + (j2 >> 2)); pm = pmap(5 * x + p); kq = j < 40 ? 9 : 0;
        } else {
            const long L = (long)i * G + c; ok = L < nwg;
            int wgid = ok ? (int)L : 0; { const int q = nwg / NXCD, r = nwg % NXCD, xcd = wgid % NXCD, off = wgid / NXCD; wgid = (xcd < r ? xcd * (q + 1) : r * (q + 1) + (xcd - r) * q) + off; }
            const int nig = WGM * nN, gid = wgid / nig, fm = gid * WGM, gsz = (nM - fm) < WGM ? (nM - fm) : WGM;
            pm = pmap(fm + ((wgid % nig) % gsz)); pn = (wgid % nig) / gsz;
        }
        u.pm = pm; u.pn = pn; u.k0 = 0; u.nk = 0; u.kq = kq; return ok;
    }
    __device__ __forceinline__ void a_ready(const Unit&) const {}
    __device__ __forceinline__ void done(const Unit& u) const { if (sf && u.kq == 9) publish_wave(sc, local); }
};


__device__ __forceinline__ unsigned cvt_pk_bf16(float lo, float hi) { unsigned r; asm volatile("v_cvt_pk_bf16_f32 %0, %1, %2" : "=v"(r) : "v"(lo), "v"(hi)); return r; }
#ifndef EPI_SC1
#define EPI_SC1 0
#endif
__device__ __forceinline__ void store16(void* p, u32x4 v) {
#if EPI_SC1
    asm volatile("global_store_dwordx4 %0, %1, off sc1\n\ts_nop 1" :: "v"(p), "v"(v) : "memory");
#else
    *(u32x4*)p = v;
#endif
}
__device__ __forceinline__ void store16f(void* p, f32x4 v) { store16(p, __builtin_bit_cast(u32x4, v)); }
__device__ __forceinline__ float silu_f(float g) { return g * __builtin_amdgcn_rcpf(1.0f + __builtin_amdgcn_exp2f(-1.4426950408889634f * g)); }

__device__ __forceinline__ float row_rstd(const float* rowss, int row) {
    const f32x4* p = (const f32x4*)(rowss + (size_t)row * 16); const f32x4 a = p[0], b = p[1], c = p[2], d = p[3];
    const float s = ((a[0] + a[1]) + (a[2] + a[3])) + ((b[0] + b[1]) + (b[2] + b[3])) + ((c[0] + c[1]) + (c[2] + c[3])) + ((d[0] + d[1]) + (d[2] + d[3]));
    return 1.0f / sqrtf(s * (1.0f / 1024.0f) + 1e-6f);
}
template <bool RS, bool H8 = false> struct EpiSwiGLU {
    static constexpr bool PERM = true, AFTER_DRAIN = false, F8 = FP8_FFN_IN && !RS, I8 = I8_FFN_IN && !RS;
    bf16_t* H; int ldh; const float* rowss; const float* bias2; int ldb2;
    __device__ __forceinline__ void operator()(const f32x4 (&acc)[2][2][4][2], const Unit& u, int wr, int wc, int fr, int fq) const {
        const int row0 = u.pm * BM + wr * 64 + fr, col0 = u.pn * HALF + wc * 32 + 8 * fq;
        const int cond = u.pm < 32 ? 0 : 1 + ((u.pm - 32) >> 2);
        f32x4 bz[2][2];
#pragma unroll
        for (int bj = 0; bj < 2; ++bj)
#pragma unroll
            for (int n = 0; n < 2; ++n) { bz[bj][n] = (f32x4){0.f, 0.f, 0.f, 0.f}; if constexpr (RS) bz[bj][n] = *(const f32x4*)(bias2 + (size_t)cond * ldb2 + u.pn * BM + bj * HALF + wc * 32 + 8 * fq + 4 * n);
                if constexpr (I8) bz[bj][n] = *(const f32x4*)(bias2 + u.pn * BM + bj * HALF + wc * 32 + 8 * fq + 4 * n); }
        float rqv[2][4];
#pragma unroll
        for (int ai = 0; ai < 2; ++ai)
#pragma unroll
            for (int m = 0; m < 4; ++m) { rqv[ai][m] = 1.0f; if constexpr (I8) rqv[ai][m] = rowss[row0 + ai * HALF + m * 16]; }
#pragma unroll
        for (int ai = 0; ai < 2; ++ai)
#pragma unroll
            for (int m = 0; m < 4; ++m) { const int row = row0 + ai * HALF + m * 16; bf16_t* rowp = H + (size_t)row * ldh + col0;
                float rs = F8 ? F8_ACC : 1.0f; if constexpr (RS) rs = row_rstd(rowss, row);
                f32x4 g0, g1, u0, u1;
                if constexpr (I8) { typedef int i32x4_t __attribute__((ext_vector_type(4))); const float rq = rqv[ai][m];
                    g0 = __builtin_convertvector(__builtin_bit_cast(i32x4_t, acc[ai][0][m][0]), f32x4) * rq * bz[0][0]; g1 = __builtin_convertvector(__builtin_bit_cast(i32x4_t, acc[ai][0][m][1]), f32x4) * rq * bz[0][1];
                    u0 = __builtin_convertvector(__builtin_bit_cast(i32x4_t, acc[ai][1][m][0]), f32x4) * rq * bz[1][0]; u1 = __builtin_convertvector(__builtin_bit_cast(i32x4_t, acc[ai][1][m][1]), f32x4) * rq * bz[1][1]; }
                else { g0 = acc[ai][0][m][0] * rs + bz[0][0]; g1 = acc[ai][0][m][1] * rs + bz[0][1]; u0 = acc[ai][1][m][0] * rs + bz[1][0]; u1 = acc[ai][1][m][1] * rs + bz[1][1]; }
                u32x4 w;
#ifdef PROBE_EPI
                if (ldb2) { w.x = cvt_pk_bf16(g0[0] * u0[0], g0[1] * u0[1]); w.y = cvt_pk_bf16(g0[2] * u0[2], g0[3] * u0[3]); w.z = cvt_pk_bf16(g1[0] * u1[0], g1[1] * u1[1]); w.w = cvt_pk_bf16(g1[2] * u1[2], g1[3] * u1[3]); store16(rowp, w); continue; }
#endif
                if constexpr (H8) { typedef unsigned u32x2 __attribute__((ext_vector_type(2))); const f32x4 h0 = {silu_f(g0[0]) * u0[0], silu_f(g0[1]) * u0[1], silu_f(g0[2]) * u0[2], silu_f(g0[3]) * u0[3]}, h1 = {silu_f(g1[0]) * u1[0], silu_f(g1[1]) * u1[1], silu_f(g1[2]) * u1[2], silu_f(g1[3]) * u1[3]};
                    *(u32x2*)((unsigned char*)H + (size_t)row * ldh + col0) = (u32x2){pk4_f8(h0[0] * F8_SA, h0[1] * F8_SA, h0[2] * F8_SA, h0[3] * F8_SA), pk4_f8(h1[0] * F8_SA, h1[1] * F8_SA, h1[2] * F8_SA, h1[3] * F8_SA)}; continue; }
                w.x = cvt_pk_bf16(silu_f(g0[0]) * u0[0], silu_f(g0[1]) * u0[1]); w.y = cvt_pk_bf16(silu_f(g0[2]) * u0[2], silu_f(g0[3]) * u0[3]);
                w.z = cvt_pk_bf16(silu_f(g1[0]) * u1[0], silu_f(g1[1]) * u1[1]); w.w = cvt_pk_bf16(silu_f(g1[2]) * u1[2], silu_f(g1[3]) * u1[3]);
                store16(rowp, w); }
    }
};

template <bool NXT, bool HALFG, bool F8_ = false> struct EpiResid {
    static constexpr bool PERM = false, AFTER_DRAIN = false, F8 = F8_, I8 = false;
    static_assert(!(F8_ && NXT), "fp8 operands: plain residual epilogue only");
    const float* base0; const float* base1; float* out; const float* gate;
    bf16_t* nxtA; const float* nw; const float* sc; float* rowss;
    __device__ __forceinline__ void operator()(const f32x4 (&acc)[2][2][4][2], const Unit& u, int wr, int wc, int fr, int fq) const {
        const int row0 = u.pm * BM + wr * 64 + fr, col0 = u.pn * BM + wc * 32 + 4 * fq;
        const int cond = u.pm < 32 ? 0 : 1 + ((u.pm - 32) >> 2);
        const float* bp = u.pm < 32 ? base0 : base1 - (size_t)8192 * 1024;
        if constexpr (!NXT) {
            constexpr float gsl = (HALFG ? 0.5f : 1.0f) * (F8_ ? F8_ACC : 1.0f);
            f32x4 gv[2][2];
#pragma unroll
            for (int bj = 0; bj < 2; ++bj)
#pragma unroll
                for (int n = 0; n < 2; ++n) gv[bj][n] = *(const f32x4*)(gate + cond * 9216 + col0 + bj * HALF + n * 16) * gsl;
#pragma unroll
            for (int ai = 0; ai < 2; ++ai)
#pragma unroll
                for (int m = 0; m < 4; ++m) { const size_t off = (size_t)(row0 + ai * HALF + m * 16) * 1024 + col0;
#pragma unroll
                    for (int bj = 0; bj < 2; ++bj)
#pragma unroll
                        for (int n = 0; n < 2; ++n) { const f32x4 b = *(const f32x4*)(bp + off + bj * HALF + n * 16); store16f(out + off + bj * HALF + n * 16, b + gv[bj][n] * acc[ai][bj][m][n]); } }
            return;
        }
        float ss[2][4];
#pragma unroll
        for (int ai = 0; ai < 2; ++ai)
#pragma unroll
            for (int m = 0; m < 4; ++m) ss[ai][m] = 0.f;
#pragma unroll
        for (int bj = 0; bj < 2; ++bj)
#pragma unroll
            for (int n = 0; n < 2; ++n) { const int c = col0 + bj * HALF + n * 16; constexpr float gsl = HALFG ? 0.5f : 1.0f; const f32x4 gv = *(const f32x4*)(gate + cond * 9216 + c) * gsl;
                f32x4 av = {0.f, 0.f, 0.f, 0.f}; if constexpr (NXT) av = *(const f32x4*)(nw + c) * (*(const f32x4*)(sc + cond * 9216 + c) + 1.0f);
#pragma unroll
                for (int ai = 0; ai < 2; ++ai)
#pragma unroll
                    for (int m = 0; m < 4; ++m) { const size_t off = (size_t)(row0 + ai * HALF + m * 16) * 1024 + c; const f32x4 b = *(const f32x4*)(bp + off); const f32x4 o = b + gv * acc[ai][bj][m][n];
                        *(f32x4*)(out + off) = o;
                        if constexpr (NXT) { ss[ai][m] += (o[0] * o[0] + o[1] * o[1]) + (o[2] * o[2] + o[3] * o[3]); const f32x4 a = o * av;
                            typedef unsigned u32x2 __attribute__((ext_vector_type(2))); *(u32x2*)(nxtA + off) = (u32x2){cvt_pk_bf16(a[0], a[1]), cvt_pk_bf16(a[2], a[3])}; } } }
        if constexpr (NXT) {
#pragma unroll
            for (int ai = 0; ai < 2; ++ai)
#pragma unroll
                for (int m = 0; m < 4; ++m) { float s = ss[ai][m]; s += __shfl_xor(s, 16); s += __shfl_xor(s, 32); if (fq == 0) rowss[(size_t)(row0 + ai * HALF + m * 16) * 16 + u.pn * 4 + wc] = s; } }
    }
};

typedef _Float16 h2_t __attribute__((ext_vector_type(2)));
__device__ __forceinline__ unsigned pkh2(float lo, float hi) { const h2_t h = {(_Float16)lo, (_Float16)hi}; return __builtin_bit_cast(unsigned, h); }
__device__ __forceinline__ float logf_gate(float x, float lb) { const float sg = __builtin_amdgcn_rcpf(1.0f + __builtin_amdgcn_exp2f(-1.4426950408889634f * x)); return 0.6931471805599453f * __builtin_amdgcn_logf(lb + (1.0f - lb) * sg); }
template <bool RS> struct EpiProj {
    static constexpr bool PERM = true, AFTER_DRAIN = false, F8 = false, I8 = false;
    bf16_t* P; float* outv; const float* lbv; const float* rowss; const float* bias2;
    __device__ __forceinline__ void operator()(const f32x4 (&acc)[2][2][4][2], const Unit& u, int wr, int wc, int fr, int fq) const {
        const int row0 = u.pm * BM + wr * 64 + fr, col0 = u.pn * BM + wc * 32 + 8 * fq;
        const bool wv = (u.pn >= 14) && (u.pm < 32), gate = (u.pn >= 4) && (u.pn < 8);
        const int cond = u.pm < 32 ? 0 : 1 + ((u.pm - 32) >> 2);
        f32x4 lb[2][2], bz[2][2];
#pragma unroll
        for (int bj = 0; bj < 2; ++bj)
#pragma unroll
            for (int n = 0; n < 2; ++n) { lb[bj][n] = gate ? *(const f32x4*)(lbv + ((col0 + bj * HALF + 4 * n) & 511)) : (f32x4){0.f, 0.f, 0.f, 0.f}; bz[bj][n] = (f32x4){0.f, 0.f, 0.f, 0.f}; if constexpr (RS) bz[bj][n] = *(const f32x4*)(bias2 + cond * 4096 + col0 + bj * HALF + 4 * n); }
#pragma unroll
        for (int ai = 0; ai < 2; ++ai)
#pragma unroll
            for (int m = 0; m < 4; ++m) { const int row = row0 + ai * HALF + m * 16; bf16_t* rowp = P + (size_t)row * 4096 + col0; float rs = 1.0f; if constexpr (RS) rs = row_rstd(rowss, row);
#pragma unroll
                for (int bj = 0; bj < 2; ++bj) { const f32x4 v0 = acc[ai][bj][m][0] * rs + bz[bj][0], v1 = acc[ai][bj][m][1] * rs + bz[bj][1]; u32x4 w;
                    if (gate) { const f32x4 l0 = lb[bj][0], l1 = lb[bj][1];
                        w.x = pkh2(logf_gate(v0[0], l0[0]), logf_gate(v0[1], l0[1])); w.y = pkh2(logf_gate(v0[2], l0[2]), logf_gate(v0[3], l0[3]));
                        w.z = pkh2(logf_gate(v1[0], l1[0]), logf_gate(v1[1], l1[1])); w.w = pkh2(logf_gate(v1[2], l1[2]), logf_gate(v1[3], l1[3])); }
                    else { w.x = cvt_pk_bf16(v0[0], v0[1]); w.y = cvt_pk_bf16(v0[2], v0[3]); w.z = cvt_pk_bf16(v1[0], v1[1]); w.w = cvt_pk_bf16(v1[2], v1[3]); }
                    store16(rowp + bj * HALF, w);
                    if (wv) { float* ov = outv + (size_t)row * 512 + (col0 + bj * HALF - 3584); *(f32x4*)ov = v0; *(f32x4*)(ov + 4) = v1; } } }
    }
};

__device__ __forceinline__ void publish_wave(unsigned* cnt, int local) {
    asm volatile("s_waitcnt vmcnt(0)" ::: "memory");
    if (!local) { __builtin_amdgcn_fence(__ATOMIC_RELEASE, "agent"); asm volatile("s_waitcnt vmcnt(0)" ::: "memory"); }
    if ((threadIdx.x & 63) == 0) (void)__hip_atomic_fetch_add(cnt, 1u, __ATOMIC_RELAXED, __HIP_MEMORY_SCOPE_AGENT);
}
__device__ __forceinline__ void wait_counter_wave(unsigned* cnt, unsigned need) {
    unsigned sp = 0;
    while ((unsigned)__builtin_amdgcn_readfirstlane(__hip_atomic_load(cnt, __ATOMIC_RELAXED, __HIP_MEMORY_SCOPE_AGENT)) < need) { __builtin_amdgcn_s_sleep(2); if (++sp > (1u << 22)) break; }
    __builtin_amdgcn_fence(__ATOMIC_ACQUIRE, "agent"); asm volatile("s_waitcnt vmcnt(0)" ::: "memory");
}
__device__ __forceinline__ void wait_counter_wg(unsigned* cnt, unsigned need) {
    if (threadIdx.x < 64) wait_counter_wave(cnt, need);
    asm volatile("" ::: "memory"); __builtin_amdgcn_s_barrier(); asm volatile("" ::: "memory");
}
struct XccInOrder {
    int x, r; unsigned* pc; int local;
    __device__ __forceinline__ bool next(int i, Unit& u) const { const int j = i * 32 + r; if (j >= 110) return false; u.k0 = 0; u.nk = 0; u.kq = 0;
        if (j < 88) { u.pm = 5 * x + (j & 3); u.pn = j >> 2; } else { u.pm = 5 * x + 4; u.pn = j - 88; } return true; }
    __device__ __forceinline__ void a_ready(const Unit&) const {}
    __device__ __forceinline__ void done(const Unit& u) const {
        const int j = (u.pm == 5 * x + 4) ? 88 + u.pn : 4 * u.pn + (u.pm - 5 * x), i = (j - r) >> 5;
        if (i == 0) return;
        Unit p; next(i - 1, p);
        const bool lane0 = (threadIdx.x & 63) == 0;
        if (i == 1) { if (local) { if (lane0) (void)__hip_atomic_fetch_add(pc + 16 * p.pm, 1u, __ATOMIC_RELAXED, __HIP_MEMORY_SCOPE_AGENT); } else publish_wave(pc + 16 * p.pm, 0); return; }
        publish_wave(pc + 16 * u.pm, local);
        if (i == 2 && lane0) (void)__hip_atomic_fetch_add(pc + 16 * p.pm, 1u, __ATOMIC_RELAXED, __HIP_MEMORY_SCOPE_AGENT);
    }
};
struct XccOutOrder {
    int x, r; unsigned* pc;
    __device__ __forceinline__ bool next(int i, Unit& u) const { if (i > 0) return false;
        if (r >= 14 && r < 30) { const int q = r - 14; u.pm = 5 * x + (q >> 2); u.pn = q & 3; u.k0 = 0; u.nk = 0; u.kq = 0; }
        else { const int s = r < 14 ? r : r - 16, kq = s & 3; u.pm = 5 * x + 4; u.pn = s >> 2; u.kq = 1 + kq;
               const int it0 = kq == 0 ? 0 : kq == 1 ? 6 : kq == 2 ? 12 : 17, nit = kq < 2 ? 6 : 5; u.k0 = 2 * it0; u.nk = 2 * nit; }
        return true; }
    __device__ __forceinline__ void a_ready(const Unit& u) const { wait_counter_wg(pc + 16 * u.pm, 22u * 8u); }
    __device__ __forceinline__ void done(const Unit&) const {}
};
template <bool HALFG> struct EpiResidSplit {
    static constexpr bool PERM = false, AFTER_DRAIN = false, F8 = false, I8 = false;
    const float* base0; const float* base1; float* out; const float* gate; float* slab; unsigned* uc; int x; int local;
    __device__ __forceinline__ void operator()(f32x4 (&acc)[2][2][4][2], const Unit& u, int wr, int wc, int fr, int fq) const {
        const int tid = threadIdx.x;
        if (u.kq >= 1 && u.kq <= 3) {
            f32x4* s = (f32x4*)(slab + (size_t)((x * 4 + u.pn) * 3 + (u.kq - 1)) * (32 * 512 * 4)) + tid;
#pragma unroll
            for (int ai = 0; ai < 2; ++ai)
#pragma unroll
                for (int bj = 0; bj < 2; ++bj) {
#pragma unroll
                    for (int m = 0; m < 4; ++m)
#pragma unroll
                        for (int n = 0; n < 2; ++n) s[(m * 2 + n) * 512] = acc[ai][bj][m][n];
                    s += 8 * 512; asm volatile("" : "+v"(s) :: "memory"); }
            publish_wave(uc + 16 * (x * 4 + u.pn), local);
            return;
        }
        const bool owner = u.kq == 4;
        const f32x4* sp = (const f32x4*)(slab + (size_t)((x * 4 + u.pn) * 3) * (32 * 512 * 4)) + tid;
        if (owner) wait_counter_wave(uc + 16 * (x * 4 + u.pn), 24u);
        const int row0 = u.pm * BM + wr * 64 + fr, col0 = u.pn * BM + wc * 32 + 4 * fq;
        const int cond = u.pm < 32 ? 0 : 1 + ((u.pm - 32) >> 2);
        const float* bp = u.pm < 32 ? base0 : base1 - (size_t)8192 * 1024;
        constexpr float gsl = HALFG ? 0.5f : 1.0f;
        f32x4 gv[2][2];
#pragma unroll
        for (int bj = 0; bj < 2; ++bj)
#pragma unroll
            for (int n = 0; n < 2; ++n) gv[bj][n] = *(const f32x4*)(gate + cond * 9216 + col0 + bj * HALF + n * 16) * gsl;
#pragma unroll
        for (int ai = 0; ai < 2; ++ai)
#pragma unroll
            for (int m = 0; m < 4; ++m) { const size_t off = (size_t)(row0 + ai * HALF + m * 16) * 1024 + col0;
#pragma unroll
                for (int bj = 0; bj < 2; ++bj)
#pragma unroll
                    for (int n = 0; n < 2; ++n) { f32x4 a = acc[ai][bj][m][n];
                        if (owner) { const f32x4* s = sp + (((ai * 2 + bj) * 4 + m) * 2 + n) * 512; a += (s[0] + s[32 * 512]) + s[2 * 32 * 512]; }
                        const f32x4 b = *(const f32x4*)(bp + off + bj * HALF + n * 16); *(f32x4*)(out + off + bj * HALF + n * 16) = b + gv[bj][n] * a; }
                asm volatile("" ::: "memory"); }
    }
};
typedef int i32x8 __attribute__((ext_vector_type(8)));
typedef int i32x4 __attribute__((ext_vector_type(4)));
__device__ __forceinline__ i32x8 pg8_ld8(const PG8_LAS unsigned char* p) { const i32x4 lo = *(const PG8_LAS i32x4*)p, hi = *(const PG8_LAS i32x4*)(p + 1024); return __builtin_shufflevector(lo, hi, 0, 1, 2, 3, 4, 5, 6, 7); }
__device__ __forceinline__ void pg8_mfma_f8(f32x4& c, const i32x8& a, const i32x8& b) { asm("v_mfma_f32_16x16x128_f8f6f4 %0, %1, %2, %0" : "+v"(c) : "v"(a), "v"(b)); }
template <class Epi, class Sched, bool ALIGN_EPI = false, bool SP2 = false>
__device__ __forceinline__ void gemm_phase(PG8_LAS unsigned char* lds, const Gemm g, const Sched& S, const Epi& E) {
    const int tid = threadIdx.x, wid = __builtin_amdgcn_readfirstlane(tid >> 6), lane = tid & 63, wr = wid >> 2, wc = wid & 3, fr = lane & 15, fq = lane >> 4;
    const int K = g.K, nt = K / BK;
    unsigned voffA[2], voffB[2];
#pragma unroll
    for (int i = 0; i < 2; ++i) { int R, C; stage_rc(tid * 16 + i * 8192, R, C); const int Rb = Epi::PERM ? ((R & ~31) + perm32(R & 31)) : R;
        voffA[i] = (unsigned)(R * K + C) * 2u; voffB[i] = (unsigned)(Rb * K + C) * 2u; }
    const size_t kstep = (size_t)(BK * 2);
    const size_t hstep = (size_t)HALF * K * 2;
    const size_t tstep = 2 * hstep;
    const unsigned ldsw = (unsigned)wid * 1024u;
    const int aoff = lds_byte(wr * 64 + fr, fq * 8), boff = lds_byte(wc * 32 + fr, fq * 8);
#define PG8_SA(b, h) (((b) * 2 + (h)) * HTB)
#define PG8_SB(b, h) ((4 + (b) * 2 + (h)) * HTB)
#define PG8_STAGE(bufoff, gbase, voff) do { _Pragma("unroll") for (int _i = 0; _i < 2; ++_i) \
        __builtin_amdgcn_global_load_lds((const unsigned*)((const char*)(gbase) + (voff)[_i]), (PG8_LAS unsigned*)(lds + (bufoff) + ldsw + _i * 8192), 16, 0, 0); } while (0)
#define PG8_LDA(dst, b, h) do { if constexpr (Epi::F8) { _Pragma("unroll") for (int m = 0; m < 4; ++m) dst##8[m] = pg8_ld8(lds + PG8_SA(b, h) + aoff + m * 2048); } else { \
        _Pragma("unroll") for (int m = 0; m < 4; ++m) _Pragma("unroll") for (int k = 0; k < 2; ++k) dst[m][k] = *(const PG8_LAS bf16x8*)(lds + PG8_SA(b, h) + aoff + m * 2048 + k * 1024); } } while (0)
#define PG8_LDB(dst, b, h) do { if constexpr (Epi::F8) { _Pragma("unroll") for (int n = 0; n < 2; ++n) dst##8[n] = pg8_ld8(lds + PG8_SB(b, h) + boff + n * 2048); } else { \
        _Pragma("unroll") for (int n = 0; n < 2; ++n) _Pragma("unroll") for (int k = 0; k < 2; ++k) dst[n][k] = *(const PG8_LAS bf16x8*)(lds + PG8_SB(b, h) + boff + n * 2048 + k * 1024); } } while (0)
#define PG8_MMA(ai, bj, At, Bt) do { __builtin_amdgcn_s_setprio(1); _Pragma("unroll") for (int m = 0; m < 4; ++m) _Pragma("unroll") for (int n = 0; n < 2; ++n) { \
        if constexpr (Epi::F8) { pg8_mfma_f8(acc[ai][bj][m][n], Bt##8[n], At##8[m]); } \
        else if constexpr (Epi::I8) { _Pragma("unroll") for (int k = 0; k < 2; ++k) acc[ai][bj][m][n] = __builtin_bit_cast(f32x4, __builtin_amdgcn_mfma_i32_16x16x64_i8(__builtin_bit_cast(i32x4, Bt[n][k]), __builtin_bit_cast(i32x4, At[m][k]), __builtin_bit_cast(i32x4, acc[ai][bj][m][n]), 0, 0, 0)); } \
        else { _Pragma("unroll") for (int k = 0; k < 2; ++k) acc[ai][bj][m][n] = __builtin_amdgcn_mfma_f32_16x16x32_bf16(Bt[n][k], At[m][k], acc[ai][bj][m][n], 0, 0, 0); } } __builtin_amdgcn_s_setprio(0); } while (0)
#define PG8_WAIT_V(n) asm volatile("s_waitcnt vmcnt(" #n ")" ::: "memory")
#define PG8_WAIT_L(n) asm volatile("s_waitcnt lgkmcnt(" #n ")" ::: "memory")
#define PG8_BAR __builtin_amdgcn_s_barrier()
#define PG8_SCHED __builtin_amdgcn_sched_barrier(0)
    Unit cur, nxt; int ui = 0;
    if (!S.next(0, cur)) return;
    f32x4 acc[2][2][4][2];
#pragma unroll
    for (int a = 0; a < 2; ++a)
#pragma unroll
        for (int b = 0; b < 2; ++b)
#pragma unroll
            for (int m = 0; m < 4; ++m)
#pragma unroll
                for (int n = 0; n < 2; ++n) acc[a][b][m][n] = (f32x4){0.f, 0.f, 0.f, 0.f};
    bf16x8 At[4][2], B0[2][2], B1[2][2];
    i32x8 At8[4], B08[2], B18[2];
    const char* cA = (const char*)g.A + (size_t)(cur.pm * g.amul) * tstep + (size_t)cur.k0 * kstep; const char* cB = (const char*)g.Bt + (size_t)(cur.pn * g.bmul) * tstep + (size_t)cur.k0 * kstep;
    S.a_ready(cur);
    if constexpr (SP2) {
        PG8_STAGE(PG8_SB(0, 0), cB, voffB); PG8_STAGE(PG8_SB(0, 1), cB + hstep, voffB); PG8_STAGE(PG8_SA(0, 0), cA, voffA); PG8_STAGE(PG8_SA(0, 1), cA + hstep, voffA);
        if (wr == 1) PG8_BAR;
        PG8_WAIT_V(2); PG8_BAR;
        PG8_STAGE(PG8_SB(1, 0), cB + kstep, voffB); PG8_STAGE(PG8_SA(1, 0), cA + kstep, voffA); PG8_STAGE(PG8_SB(1, 1), cB + hstep + kstep, voffB);
        PG8_WAIT_V(6); PG8_BAR;
    } else {
        PG8_STAGE(PG8_SB(0, 0), cB, voffB); PG8_STAGE(PG8_SA(0, 0), cA, voffA); PG8_STAGE(PG8_SB(0, 1), cB + hstep, voffB); PG8_STAGE(PG8_SA(0, 1), cA + hstep, voffA);
        if (wr == 1) PG8_BAR;
        PG8_WAIT_V(4); PG8_BAR;
        PG8_STAGE(PG8_SB(1, 0), cB + kstep, voffB); PG8_STAGE(PG8_SA(1, 0), cA + kstep, voffA); PG8_STAGE(PG8_SB(1, 1), cB + hstep + kstep, voffB);
        PG8_WAIT_V(6); PG8_BAR;
    }
    for (;;) {
        const bool has_next = S.next(ui + 1, nxt);
        const char* nA = has_next ? (const char*)g.A + (size_t)(nxt.pm * g.amul) * tstep + (size_t)nxt.k0 * kstep : cA; const char* nB = has_next ? (const char*)g.Bt + (size_t)(nxt.pn * g.bmul) * tstep + (size_t)nxt.k0 * kstep : cB;
        const int unt = cur.nk ? cur.nk : nt;
#pragma unroll 1
        for (int t = 0; t < unt; t += 2) {
            const bool last = (t == unt - 2);
            const char* a1 = cA + (size_t)(t + 1) * kstep;
            const char* a2 = last ? nA : cA + (size_t)(t + 2) * kstep; const char* b2 = last ? nB : cB + (size_t)(t + 2) * kstep;
            const char* a3 = a2 + kstep; const char* b3 = b2 + kstep;
            if (last && has_next) S.a_ready(nxt);
            if constexpr (SP2) {
            PG8_LDB(B0, 0, 0); PG8_LDB(B1, 0, 1); PG8_SCHED; PG8_LDA(At, 0, 0); PG8_STAGE(PG8_SA(1, 1), a1 + hstep, voffA);
            PG8_WAIT_V(8); PG8_WAIT_L(0); PG8_BAR; PG8_MMA(0, 0, At, B0); PG8_MMA(0, 1, At, B1); PG8_BAR; PG8_SCHED;
            PG8_LDA(At, 0, 1); PG8_STAGE(PG8_SB(0, 0), b2, voffB); PG8_STAGE(PG8_SB(0, 1), b2 + hstep, voffB); PG8_STAGE(PG8_SA(0, 0), a2, voffA);
            PG8_WAIT_V(8); PG8_WAIT_L(0); PG8_BAR; PG8_MMA(1, 0, At, B0); PG8_MMA(1, 1, At, B1); PG8_BAR; PG8_SCHED;
            PG8_LDB(B0, 1, 0); PG8_LDB(B1, 1, 1); PG8_SCHED; PG8_LDA(At, 1, 0); PG8_STAGE(PG8_SA(0, 1), a2 + hstep, voffA);
            PG8_WAIT_V(8); PG8_WAIT_L(0); PG8_BAR; PG8_MMA(0, 0, At, B0); PG8_MMA(0, 1, At, B1); PG8_BAR; PG8_SCHED;
            PG8_LDA(At, 1, 1); PG8_STAGE(PG8_SB(1, 0), b3, voffB); PG8_STAGE(PG8_SB(1, 1), b3 + hstep, voffB); PG8_STAGE(PG8_SA(1, 0), a3, voffA);
            PG8_WAIT_V(8); PG8_WAIT_L(0); PG8_BAR; PG8_MMA(1, 0, At, B0); PG8_MMA(1, 1, At, B1); PG8_BAR; PG8_SCHED;
            } else {
            PG8_LDB(B0, 0, 0); PG8_SCHED; PG8_LDA(At, 0, 0); PG8_STAGE(PG8_SA(1, 1), a1 + hstep, voffA);
            PG8_WAIT_L(8); PG8_BAR; PG8_WAIT_L(0); PG8_MMA(0, 0, At, B0); PG8_BAR; PG8_SCHED;
            PG8_LDB(B1, 0, 1); PG8_STAGE(PG8_SB(0, 0), b2, voffB);
            PG8_BAR; PG8_WAIT_L(0); PG8_MMA(0, 1, At, B1); PG8_BAR;
            PG8_LDA(At, 0, 1); PG8_STAGE(PG8_SA(0, 0), a2, voffA);
            PG8_BAR; PG8_WAIT_L(0); PG8_MMA(1, 0, At, B0); PG8_BAR; PG8_SCHED;
            PG8_STAGE(PG8_SB(0, 1), b2 + hstep, voffB);
            PG8_WAIT_V(6); PG8_BAR; PG8_MMA(1, 1, At, B1); PG8_BAR;
            PG8_LDB(B0, 1, 0); PG8_SCHED; PG8_LDA(At, 1, 0); PG8_STAGE(PG8_SA(0, 1), a2 + hstep, voffA);
            PG8_WAIT_L(8); PG8_BAR; PG8_WAIT_L(0); PG8_MMA(0, 0, At, B0); PG8_BAR; PG8_SCHED;
            PG8_LDB(B1, 1, 1); PG8_STAGE(PG8_SB(1, 0), b3, voffB);
            PG8_BAR; PG8_WAIT_L(0); PG8_MMA(0, 1, At, B1); PG8_BAR;
            PG8_LDA(At, 1, 1); PG8_STAGE(PG8_SA(1, 0), a3, voffA);
            PG8_BAR; PG8_WAIT_L(0); PG8_MMA(1, 0, At, B0); PG8_BAR; PG8_SCHED;
            PG8_STAGE(PG8_SB(1, 1), b3 + hstep, voffB);
            PG8_WAIT_V(6); PG8_BAR; PG8_MMA(1, 1, At, B1); PG8_BAR;
            }
        }
        if constexpr (Epi::F8) { asm volatile("s_nop 15\n\ts_nop 15" ::: "memory"); PG8_SCHED; }
        if constexpr (ALIGN_EPI) { if (wr == 0) PG8_BAR; }
        if constexpr (!Epi::AFTER_DRAIN) { E(acc, cur, wr, wc, fr, fq); S.done(cur); }
        if (!has_next) break;
#pragma unroll
        for (int a = 0; a < 2; ++a)
#pragma unroll
            for (int b = 0; b < 2; ++b)
#pragma unroll
                for (int m = 0; m < 4; ++m)
#pragma unroll
                    for (int n = 0; n < 2; ++n) acc[a][b][m][n] = (f32x4){0.f, 0.f, 0.f, 0.f};
        cur = nxt; cA = nA; cB = nB; ++ui;
        if constexpr (ALIGN_EPI) { if (wr == 1) PG8_BAR; }
    }
    PG8_WAIT_V(0);
    if constexpr (!ALIGN_EPI) { if (wr == 0) PG8_BAR; }
    PG8_BAR;
    if constexpr (Epi::AFTER_DRAIN) { E.fused(acc, cur, wr, wc, fr, fq, lds, wid, lane); S.done(cur); }
#undef PG8_SA
#undef PG8_SB
#undef PG8_STAGE
#undef PG8_LDA
#undef PG8_LDB
#undef PG8_MMA
#undef PG8_WAIT_V
#undef PG8_WAIT_L
#undef PG8_BAR
#undef PG8_SCHED
}
}

#ifndef PG8_SP2
#define PG8_SP2 true
#endif
#ifndef PG8_ALIGN
#define PG8_ALIGN true
#endif
constexpr int NWAVES = 8;
#ifndef MK_ONE_LAUNCH
#define MK_ONE_LAUNCH 1
#endif
#ifndef MERGE_FFN
#define MERGE_FFN 0
#endif
#ifndef MERGE_P01
#define MERGE_P01 0
#endif
#ifndef FUSE_NORM
#define FUSE_NORM 0
#endif
constexpr int N_PHASES = FUSE_NORM ? 11 : 13;
static_assert(!((FFN_IN_MODE || FP8_FFN1_OUT || FP8_FFN2_OUT) && (FUSE_NORM || MERGE_FFN)), "the fp8 ffn-in path is wired into the plain 13-phase program only");
#ifndef CONV_MODE
#define CONV_MODE 0
#endif

constexpr int DM = 1024, M_P = 8192, M_S = 2048, M = M_P + M_S, DFF = 2816, NFF = 2 * DFF, NMIX = 4096;
constexpr int T_P = 256, T_S = 1024, PAST = 512, TK_S = PAST + T_S, NB_P = 32, NB_S = 2;
constexpr float EPS = 1e-6f;
constexpr float QSCALE = 0.125f * 1.4426950408889634f;
constexpr float LAM_INIT = 0.2f;
constexpr size_t OUT_Y = 0, OUT_K = (size_t)M * DM, OUT_V = OUT_K + (size_t)M_P * 512, OUT_S = OUT_V + (size_t)M_P * 512, OUT_END = OUT_S + (size_t)NB_P * 2 * 4 * 128 * 128;
constexpr int PC_Q = 0, PC_I = 512, PC_FF = 1024, PC_FB = 1536, PC_G = 2048, PC_AQ = 2560, PC_AK = 3072, PC_AV = 3584;

constexpr size_t MiB = 1u << 20;
constexpr size_t WS_CTL = 0, CTL_ZERO_BYTES = 192 * 1024;
constexpr size_t WS_MADA = 64 * 1024;
constexpr size_t WS_LB = 1 * MiB + 128 * 1024;
constexpr size_t WS_ROPE = 1 * MiB + 256 * 1024;
constexpr size_t WS_W1I = 2 * MiB, WS_W1O = 13 * MiB, WS_WMI = 19 * MiB, WS_WMO = 27 * MiB, WS_W2I = 29 * MiB, WS_W2O = 40 * MiB;
constexpr size_t WS_ABUF = 46 * MiB;
constexpr size_t WS_BIG = 66 * MiB;
constexpr size_t WS_SLAB = 122 * MiB;
constexpr size_t WS_QB = 146 * MiB;
constexpr size_t WS_KB = 156 * MiB;
constexpr size_t WS_KS = 164 * MiB;
constexpr size_t WS_VTP = 167 * MiB;
constexpr size_t WS_VTS = 175 * MiB;
constexpr size_t WS_OF = 178 * MiB, WS_OB = 198 * MiB;
constexpr size_t WS_ABUF2 = 218 * MiB;
constexpr size_t WS_ROWSS = 238 * MiB;
constexpr size_t WS_BIAS2 = 239 * MiB;
constexpr size_t WS_HSAVE = 240 * MiB;
constexpr size_t WS_END = 241 * MiB;
constexpr int CW_BAR = 4096;
constexpr int CW_QUEUE = 64;
constexpr int CW_MADA = 768;
constexpr int CW_CONVQ = 512;
constexpr int CW_SAMP = 11520, CW_GDONE = 11776;
constexpr int CW_LBAR = 10496;
#ifndef EARLY_CHAINS
#define EARLY_CHAINS 1
#endif
#ifndef LOCAL_SEAMS
#define LOCAL_SEAMS 1
#endif
constexpr int CW_PANEL1 = 8192, CW_PANEL2 = 8832, CW_UNIT1 = 9472, CW_UNIT2 = 9984;

constexpr int RING_OFF = 0, RING_BYTES = 131072;
constexpr int LDSCTL_OFF = RING_BYTES, MISC_OFF = LDSCTL_OFF + 320;
constexpr int LDS_BYTES = 147456;

#define GAS __attribute__((address_space(1)))
#define LAS __attribute__((address_space(3)))
typedef unsigned short bf16;
typedef unsigned v4u __attribute__((ext_vector_type(4)));
typedef unsigned v2u __attribute__((ext_vector_type(2)));
typedef float f32x4 __attribute__((ext_vector_type(4)));
typedef float f32x2 __attribute__((ext_vector_type(2)));
typedef float f32x16 __attribute__((ext_vector_type(16)));
typedef short bf16x8 __attribute__((ext_vector_type(8)));
typedef short s16x4 __attribute__((ext_vector_type(4)));
typedef GAS unsigned gu32;
#define RLX_AGENT __ATOMIC_RELAXED, __HIP_MEMORY_SCOPE_AGENT
#define LDS_WAIT() asm volatile("s_waitcnt lgkmcnt(0)" ::: "memory")
#define VM_WAIT() asm volatile("s_waitcnt vmcnt(0)" ::: "memory")
#define LDS_BARRIER() do { asm volatile("s_waitcnt lgkmcnt(0)" ::: "memory"); __builtin_amdgcn_s_barrier(); asm volatile("" ::: "memory"); } while (0)
__device__ __forceinline__ unsigned f2bf(float f) { unsigned u = __builtin_bit_cast(unsigned, f); return (u + 0x7fffu + ((u >> 16) & 1u)) >> 16; }
typedef __bf16 bf16x2_t __attribute__((ext_vector_type(2)));
typedef _Float16 h2_t __attribute__((ext_vector_type(2)));
__device__ __forceinline__ unsigned pkh2(float lo, float hi) { const h2_t h = {(_Float16)lo, (_Float16)hi}; return __builtin_bit_cast(unsigned, h); }
__device__ __forceinline__ unsigned pk2(float lo, float hi) { const f32x2 v = {lo, hi}; const bf16x2_t b = __builtin_convertvector(v, bf16x2_t); return __builtin_bit_cast(unsigned, b); }
__device__ __forceinline__ float bflo(unsigned w) { return __builtin_bit_cast(float, w << 16); }
__device__ __forceinline__ float bfhi(unsigned w) { return __builtin_bit_cast(float, w & 0xffff0000u); }
__device__ __forceinline__ float wave_sum(float v) {
#pragma unroll
    for (int o = 1; o < 64; o <<= 1) v += __shfl_xor(v, o);
    return v;
}
__device__ __forceinline__ float sigmoid_f(float x) { return __builtin_amdgcn_rcpf(1.0f + __builtin_amdgcn_exp2f(-1.4426950408889634f * x)); }
#define XB_TMO      128
#define XB_XCNT(j)  (256  + 64 * (j))
#define XB_XSUB(j)  (1280 + 64 * (j))
#define XB_XGEN(j)  (2304 + 64 * (j))
#define XB_TOP      3328
#define XB_TOPGEN   3392
#define XCD_BAR_WORDS 3456
#define XB_SPIN_CAP (1u << 18)

__device__ __forceinline__ unsigned xb_ld(unsigned* p)              { return __hip_atomic_load(p, __ATOMIC_RELAXED, __HIP_MEMORY_SCOPE_AGENT); }
__device__ __forceinline__ unsigned xb_add(unsigned* p, unsigned v) { return __hip_atomic_fetch_add(p, v, __ATOMIC_RELAXED, __HIP_MEMORY_SCOPE_AGENT); }
__device__ __forceinline__ unsigned xb_xcc_id() { return (unsigned)__builtin_amdgcn_s_getreg((3 << 11) | 20) & 0xFu; }
#define XB_SPIN(cond, bar) do { unsigned _sp = 0; while (cond) { __builtin_amdgcn_s_sleep(1); \
    if ((++_sp & 255u) == 0u) { if (xb_ld(&(bar)[XB_TMO])) break; if (_sp > XB_SPIN_CAP) { atomicAdd(&(bar)[XB_TMO], 1u); break; } } } } while (0)

struct XcdBarrier {
    unsigned* bar; unsigned x;
    volatile LAS unsigned* st;
};

__device__ __forceinline__ XcdBarrier xcd_barrier_post(unsigned* bar, volatile LAS unsigned* st) {
    XcdBarrier b; b.bar = bar; b.x = xb_xcc_id(); b.st = st;
    if (threadIdx.x == 0) st[2] = xb_add(&bar[XB_XCNT(b.x)], 1u);
    return b;
}
__device__ __forceinline__ void xcd_barrier_complete(unsigned* bar, unsigned x, unsigned& nloc, unsigned& nx) {
    const unsigned G = gridDim.x * gridDim.y * gridDim.z;
    unsigned sum, cnt, mine, sp = 0u;
    for (;;) {
        sum = 0u; cnt = 0u; mine = 0u;
#pragma unroll
        for (unsigned j = 0; j < 16; ++j) { const unsigned c = xb_ld(&bar[XB_XCNT(j)]); sum += c; cnt += (c > 0u) ? 1u : 0u; mine = (j == x) ? c : mine; }
        if (sum == G) break;
        __builtin_amdgcn_s_sleep(1);
        if ((++sp & 255u) == 0u) { if (xb_ld(&bar[XB_TMO])) break; if (sp > XB_SPIN_CAP) { atomicAdd(&bar[XB_TMO], 1u); break; } }
    }
    nloc = mine > 0u ? mine : 1u; nx = cnt > 0u ? cnt : 1u;
}
__device__ __forceinline__ unsigned xcd_census_even(unsigned* bar) {
    const unsigned G = gridDim.x * gridDim.y * gridDim.z; bool ok = (G % 8u) == 0u;
#pragma unroll
    for (unsigned j = 0; j < 16; ++j) { const unsigned c = xb_ld(&bar[XB_XCNT(j)]); ok = ok && (c == (j < 8u ? G / 8u : 0u)); }
    return ok ? 1u : 2u;
}

__device__ __forceinline__ void xcd_barrier(const XcdBarrier& b) {
    asm volatile("s_waitcnt vmcnt(0)" ::: "memory");
    __syncthreads();
    if (threadIdx.x == 0) {
        unsigned* bar = b.bar;
        __builtin_amdgcn_s_waitcnt(0);
        unsigned nloc = b.st[0], nx = b.st[1];
        if (nloc == 0u) { xcd_barrier_complete(bar, b.x, nloc, nx); b.st[0] = nloc; b.st[1] = nx; b.st[3] = xcd_census_even(bar); }
        const unsigned old = xb_add(&bar[XB_XSUB(b.x)], 1u);
        const unsigned gen = old / nloc;
        if (old + 1u == (gen + 1u) * nloc) {
            __builtin_amdgcn_fence(__ATOMIC_RELEASE, "agent");
            asm volatile("s_waitcnt vmcnt(0)" ::: "memory");
            const unsigned og = xb_add(&bar[XB_TOP], 1u);
            const unsigned tg = og / nx;
            if (og + 1u == (tg + 1u) * nx) xb_add(&bar[XB_TOPGEN], 1u);
            else XB_SPIN(xb_ld(&bar[XB_TOPGEN]) == tg, bar);
            __builtin_amdgcn_fence(__ATOMIC_ACQUIRE, "agent");
            xb_add(&bar[XB_XGEN(b.x)], 1u);
            asm volatile("s_waitcnt vmcnt(0)" ::: "memory");
        } else {
            XB_SPIN(xb_ld(&bar[XB_XGEN(b.x)]) == gen, bar);
            __builtin_amdgcn_fence(__ATOMIC_ACQUIRE, "agent");
            asm volatile("s_waitcnt vmcnt(0)" ::: "memory");
        }
    }
    __syncthreads();
}

__device__ __forceinline__ void xcc_barrier(const XcdBarrier& b, unsigned* lsub) {
    asm volatile("s_waitcnt vmcnt(0)" ::: "memory");
    __syncthreads();
    if (threadIdx.x == 0) {
        const unsigned nloc = b.st[0];
        unsigned* c = lsub + 64 * b.x;
        const unsigned old = xb_add(c, 1u), target = (old / nloc + 1u) * nloc;
        XB_SPIN(xb_ld(c) < target, b.bar);
        __builtin_amdgcn_fence(__ATOMIC_ACQUIRE, "agent");
        asm volatile("s_waitcnt vmcnt(0)" ::: "memory");
    }
    __syncthreads();
}

struct Frame {
    LAS unsigned char* lds;
    volatile LAS unsigned* MISC;
    gu32* ctl;
    int tid, lane, wave;
    int vcu, G;
    int xl, xr, xok;
    const float *x_prompt, *x_sample, *c, *cache_k, *cache_v, *state0, *c_ctx, *w_ada, *b_ada, *norm_ffn1, *w_ffn1_in, *w_ffn1_out, *norm_mix, *w_mix_in, *w_mix_out,
                *lb_logits, *hgrn_out_norm, *q_norm, *k_norm, *attn_lambda, *attn_subln, *norm_ffn2, *w_ffn2_in, *w_ffn2_out;
    float* out;
    float *mada, *rope, *lbv, *bias2m, *bias2f, *rowss, *hsave, *rowq, *cq1, *cq2; int* hidx; bf16 *W1I, *W1O, *WMI, *WMO, *W2I, *W2O, *ABUF, *ABUF2, *HID, *PROJ, *QB, *KB, *KS, *VTP, *VTS, *OF, *OB;
};

constexpr int CV_FI = I8_FFN_IN ? (NFF / 32) * 8 : (DM / 64) * (NFF / 32),
               CV_FO = (DFF / 64) * (DM / 32), CV_MI = (DM / 64) * (NMIX / 32), CV_MO = (DM / 64) * (DM / 32);
#ifndef CONV_P5TAIL
#define CONV_P5TAIL 0
#endif
#ifndef CONV_P6
#define CONV_P6 0
#endif
#ifndef CONV_P9
#define CONV_P9 0
#endif
#ifndef CONV_LATE_P3
#define CONV_LATE_P3 0
#endif
#ifndef CONV_P2TAIL
#define CONV_P2TAIL 1
#endif
constexpr int CV_P0_N = CONV_P2TAIL ? CV_FI : CV_FI + CV_FO + CV_MI;
constexpr int CV_LATE0 = CV_FI + CV_FO + CV_MI, CV_LATE_N = CV_MO + CV_FI + CV_FO;
template <int MODE, bool F8 = false>
__device__ __forceinline__ void p0_transpose_item(const float* W, int K, int N, bf16* WT, LAS float* scr, int item, int lane) {
    const int nblk = N / 32, kb = item / nblk, nb = item % nblk, k0 = 64 * kb, n0 = 32 * nb;
    int drow0 = n0;
    if (MODE == 1) { const int half = n0 / DFF, r = n0 % DFF; drow0 = (r / 128) * 256 + half * 128 + (r % 128); }
    float tv[32];
    const float* wp = W + (size_t)(k0 + (lane >> 5)) * N + n0 + (lane & 31);
#pragma unroll
    for (int i = 0; i < 32; ++i) tv[i] = __builtin_nontemporal_load(wp + (size_t)(2 * i) * N);
#pragma unroll
    for (int i = 0; i < 32; ++i) scr[(2 * i + (lane >> 5)) * 33 + (lane & 31)] = tv[i];
    LDS_WAIT(); asm volatile("" ::: "memory");
    const int c = lane & 7;
#pragma unroll
    for (int j = 0; j < 4; ++j) { const int n = (lane >> 3) + 8 * j; const LAS float* s = scr + (8 * c) * 33 + n;
        if constexpr (F8) { v2u o; o.x = pk4_f8(s[0 * 33] * F8_SW, s[1 * 33] * F8_SW, s[2 * 33] * F8_SW, s[3 * 33] * F8_SW); o.y = pk4_f8(s[4 * 33] * F8_SW, s[5 * 33] * F8_SW, s[6 * 33] * F8_SW, s[7 * 33] * F8_SW);
            *(GAS v2u*)((unsigned char*)WT + (size_t)(drow0 + n) * K + k0 + 8 * c) = o; }
        else { v4u o; o.x = pk2(s[0 * 33], s[1 * 33]); o.y = pk2(s[2 * 33], s[3 * 33]); o.z = pk2(s[4 * 33], s[5 * 33]); o.w = pk2(s[6 * 33], s[7 * 33]);
            *(GAS v4u*)(WT + (size_t)(drow0 + n) * K + k0 + 8 * c) = o; } }
    LDS_WAIT(); asm volatile("" ::: "memory");
}

__device__ __forceinline__ void convert_panel_i8(Frame& F, const float* W, bf16* WTb, float* cq, int panel) {
    constexpr int K = DM, N = NFF;
    unsigned char* WT = (unsigned char*)WTb;
    LAS float* scr = (LAS float*)(F.lds + RING_OFF + F.wave * 16384);
    const int lane = F.lane, n0 = 32 * panel, half = n0 / DFF, r = n0 % DFF, drow0 = (r / 128) * 256 + half * 128 + (r % 128);
    float tv[2][32];
#pragma unroll
    for (int sb = 0; sb < 2; ++sb) { const float* wp = W + (size_t)(128 * F.wave + 64 * sb + (lane >> 5)) * N + n0 + (lane & 31);
#pragma unroll
        for (int i = 0; i < 32; ++i) tv[sb][i] = __builtin_nontemporal_load(wp + (size_t)(2 * i) * N); }
    float m = 0.f;
#pragma unroll
    for (int sb = 0; sb < 2; ++sb)
#pragma unroll
        for (int i = 0; i < 32; ++i) m = __builtin_fmaxf(m, __builtin_fabsf(tv[sb][i]));
    m = __builtin_fmaxf(m, __shfl_xor(m, 32));
    if (lane < 32) scr[3072 + lane] = m;
    __syncthreads();
    float cm = 0.f;
#pragma unroll
    for (int w = 0; w < NWAVES; ++w) cm = __builtin_fmaxf(cm, ((LAS float*)(F.lds + RING_OFF + w * 16384))[3072 + (lane & 31)]);
    const float inv = cm > 0.f ? 127.0f / cm : 0.f;
    if (F.wave == 0 && lane < 32) cq[drow0 + lane] = cm * (1.0f / 127.0f);
    const int c = lane & 7;
#pragma unroll
    for (int sb = 0; sb < 2; ++sb) { const int k0 = 128 * F.wave + 64 * sb;
#pragma unroll
        for (int i = 0; i < 32; ++i) scr[(2 * i + (lane >> 5)) * 33 + (lane & 31)] = tv[sb][i] * inv;
        LDS_WAIT(); asm volatile("" ::: "memory");
#pragma unroll
        for (int j = 0; j < 4; ++j) { const int n = (lane >> 3) + 8 * j; const LAS float* s = scr + (8 * c) * 33 + n;
            v2u o; o.x = pk4_i8(s[0 * 33], s[1 * 33], s[2 * 33], s[3 * 33]); o.y = pk4_i8(s[4 * 33], s[5 * 33], s[6 * 33], s[7 * 33]);
            *(GAS v2u*)(WT + (size_t)(drow0 + n) * K + k0 + 8 * c) = o; }
        LDS_WAIT(); asm volatile("" ::: "memory"); }
    __syncthreads();
}
__device__ __forceinline__ void convert_item(Frame& F, LAS float* scr, int it) {
    int r = it;
    if (r < CV_FI) { if constexpr (I8_FFN_IN) convert_panel_i8(F, F.w_ffn1_in, F.W1I, F.cq1, r >> 3); else p0_transpose_item<1, FP8_FFN_IN != 0>(F.w_ffn1_in, DM, NFF, F.W1I, scr, r, F.lane); return; } r -= CV_FI;
    if (r < CV_FO) { p0_transpose_item<0, FP8_FFN1_OUT != 0>(F.w_ffn1_out, DFF, DM, F.W1O, scr, r, F.lane); return; } r -= CV_FO;
    if (r < CV_MI) { p0_transpose_item<0>(F.w_mix_in, DM, NMIX, F.WMI, scr, r, F.lane); return; } r -= CV_MI;
    if (r < CV_MO) { p0_transpose_item<0>(F.w_mix_out, DM, DM, F.WMO, scr, r, F.lane); return; } r -= CV_MO;
    if (r < CV_FI) { if constexpr (I8_FFN_IN) convert_panel_i8(F, F.w_ffn2_in, F.W2I, F.cq2, r >> 3); else p0_transpose_item<1, FP8_FFN_IN != 0>(F.w_ffn2_in, DM, NFF, F.W2I, scr, r, F.lane); return; } r -= CV_FI;
    p0_transpose_item<0, FP8_FFN2_OUT != 0>(F.w_ffn2_out, DFF, DM, F.W2O, scr, r, F.lane);
}
__device__ __forceinline__ void convert_queue(Frame& F, int qword, int first, int n) {
    LAS float* scr = (LAS float*)(F.lds + RING_OFF + F.wave * 16384);
    volatile LAS int* qslot = (volatile LAS int*)(F.lds + MISC_OFF + 64);
    for (;;) {
        if (F.tid == 0) *qslot = (int)__hip_atomic_fetch_add(F.ctl + qword, 1u, RLX_AGENT);
        __syncthreads();
        const int bt = *qslot;
        __syncthreads();
        if (bt * 8 >= n) break;
        { const int it = bt * 8 + F.wave; if (it < n) convert_item(F, scr, first + it); }
    }
}
__device__ __forceinline__ void p0_prologue(Frame& F) {
    if (F.vcu < 144) {
        LAS float* sS = (LAS float*)(F.lds);
        LAS float* red = (LAS float*)(F.lds + 12288);
        for (int i = F.tid; i < 3072; i += NWAVES * 64) { const int cond = i >> 10, k = i & 1023; const float cv = cond == 0 ? F.c_ctx[k] : F.c[(cond - 1) * 1024 + k]; sS[i] = cv * sigmoid_f(cv); }
        __syncthreads();
        const int cb = F.vcu % 36, kq = F.vcu / 36, col = cb * 256 + 4 * F.lane, k0 = kq * 256 + F.wave * 32;
        f32x4 a0 = {0.f, 0.f, 0.f, 0.f}, a1 = a0, a2 = a0;
#pragma unroll
        for (int hb = 0; hb < 2; ++hb) { f32x4 wv[16];
#pragma unroll
            for (int kk = 0; kk < 16; ++kk) wv[kk] = __builtin_nontemporal_load((const f32x4*)(F.w_ada + (size_t)(k0 + hb * 16 + kk) * 9216 + col));
#pragma unroll
            for (int kk = 0; kk < 16; ++kk) { const int k = k0 + hb * 16 + kk; a0 += wv[kk] * sS[k]; a1 += wv[kk] * sS[1024 + k]; a2 += wv[kk] * sS[2048 + k]; } }
        *(LAS f32x4*)(red + (F.wave * 3 + 0) * 256 + 4 * F.lane) = a0; *(LAS f32x4*)(red + (F.wave * 3 + 1) * 256 + 4 * F.lane) = a1; *(LAS f32x4*)(red + (F.wave * 3 + 2) * 256 + 4 * F.lane) = a2;
        __syncthreads();
        for (int o = F.tid; o < 768; o += NWAVES * 64) { const int cond = o >> 8, cc = o & 255; float s = kq == 0 ? F.b_ada[cb * 256 + cc] : 0.f;
#pragma unroll
            for (int w = 0; w < 8; ++w) s += red[(w * 3 + cond) * 256 + cc];
            atomicAdd(F.mada + cond * 9216 + cb * 256 + cc, s); }
        asm volatile("s_waitcnt vmcnt(0)" ::: "memory");
        __syncthreads();
        if (cb < 8 && F.tid == 0) { __builtin_amdgcn_fence(__ATOMIC_RELEASE, "agent"); asm volatile("s_waitcnt vmcnt(0)" ::: "memory"); (void)__hip_atomic_fetch_add(F.ctl + CW_MADA, 1u, RLX_AGENT); }
    }
    if (F.vcu == F.G - 1) { const int k = F.tid; F.lbv[k] = 1.0f / (1.0f + __expf(F.lb_logits[512 + k] - F.lb_logits[k])); }
    { const int gid = (F.vcu * NWAVES + F.wave) * 64 + F.lane;
      if (gid < 1024 * 32) { const int t = gid >> 5, j = gid & 31, i = j & 15; const float pos = (j < 16) ? (float)(t >> 6) : (float)(t & 63);
          const float inv = exp2f(-(float)i * (13.287712379549449f / 16.0f));
          float sn, cs; sincosf(pos * inv, &sn, &cs); F.rope[gid] = cs; F.rope[32768 + gid] = sn; } }
    LAS float* scr = (LAS float*)(F.lds + RING_OFF + F.wave * 16384);
    const int gw = F.vcu * NWAVES + F.wave, NGW = F.G * NWAVES;
#if CONV_MODE == 0
    (void)gw; (void)NGW; (void)scr; convert_queue(F, CW_CONVQ + 128, 0, CV_P0_N);
#else
    for (int it = gw; it < CV_FI; it += NGW) p0_transpose_item<1>(F.w_ffn1_in, DM, NFF, F.W1I, scr, it, F.lane);
#endif
}
__device__ __forceinline__ void wait_mada01(Frame& F) {
    if (F.tid == 0) { unsigned sp = 0;
        while (__hip_atomic_load(F.ctl + CW_MADA, RLX_AGENT) < 32u) { __builtin_amdgcn_s_sleep(2); if (++sp > (1u << 22)) break; }
        __builtin_amdgcn_fence(__ATOMIC_ACQUIRE, "agent"); asm volatile("s_waitcnt vmcnt(0)" ::: "memory"); }
    __syncthreads();
}
template <int QM>
__device__ __forceinline__ void norm_mod_phase(Frame& F, const float* src0, const float* src1, const float* nw, int sh_chunk, int sc_chunk) {
    const int xl = F.xl, wl = F.xr * NWAVES + F.wave, NWL = (F.G / 8) * NWAVES;
    f32x4 a4[4], h4[4]; int cur = -1;
    for (int rl = wl; rl < M / 8; rl += NWL) { const int row = pg8::pmap(5 * xl + (rl >> 8)) * 256 + (rl & 255);
        const float* xr = row < M_P ? src0 + (size_t)row * DM : src1 + (size_t)(row - M_P) * DM;
        const int cond = row < M_P ? 0 : 1 + ((row - M_P) >> 10);
        f32x4 v[4]; float ss = 0.f;
#pragma unroll
        for (int j = 0; j < 4; ++j) { v[j] = ((const GAS f32x4*)xr)[F.lane + 64 * j]; ss += (v[j].x * v[j].x + v[j].y * v[j].y) + (v[j].z * v[j].z + v[j].w * v[j].w); }
        if (cond != cur) { cur = cond; const float* sh = F.mada + cond * 9216 + sh_chunk * 1024; const float* sc = F.mada + cond * 9216 + sc_chunk * 1024;
#pragma unroll
            for (int j = 0; j < 4; ++j) { const int q = F.lane + 64 * j; a4[j] = ((const GAS f32x4*)nw)[q] * (((const GAS f32x4*)sc)[q] + 1.0f); h4[j] = ((const GAS f32x4*)sh)[q]; } }
        const float rstd = 1.0f / sqrtf(wave_sum(ss) * (1.0f / DM) + EPS);
        if constexpr (QM == 2) { GAS unsigned* o4 = (GAS unsigned*)((GAS unsigned char*)F.ABUF + (size_t)row * DM);
            f32x4 o[4]; float am = 0.f;
#pragma unroll
            for (int j = 0; j < 4; ++j) { o[j] = v[j] * rstd * a4[j] + h4[j]; am = __builtin_fmaxf(am, __builtin_fmaxf(__builtin_fmaxf(__builtin_fabsf(o[j].x), __builtin_fabsf(o[j].y)), __builtin_fmaxf(__builtin_fabsf(o[j].z), __builtin_fabsf(o[j].w)))); }
#pragma unroll
            for (int sh = 1; sh < 64; sh <<= 1) am = __builtin_fmaxf(am, __shfl_xor(am, sh));
            const float inv = am > 0.f ? 127.0f / am : 0.f;
            if (F.lane == 0) F.rowq[row] = am * (1.0f / 127.0f);
#pragma unroll
            for (int j = 0; j < 4; ++j) { const f32x4 q = o[j] * inv; o4[F.lane + 64 * j] = pk4_i8(q.x, q.y, q.z, q.w); } }
        else if constexpr (QM == 1) { GAS unsigned* o4 = (GAS unsigned*)((GAS unsigned char*)F.ABUF + (size_t)row * DM);
#pragma unroll
            for (int j = 0; j < 4; ++j) { const int q = F.lane + 64 * j; const f32x4 o = (v[j] * rstd * a4[j] + h4[j]) * F8_SA; o4[q] = pk4_f8(o.x, o.y, o.z, o.w); } }
        else { GAS v2u* o8 = (GAS v2u*)(F.ABUF + (size_t)row * DM);
#pragma unroll
            for (int j = 0; j < 4; ++j) { const int q = F.lane + 64 * j; const f32x4 o = v[j] * rstd * a4[j] + h4[j]; v2u w; w.x = pk2(o.x, o.y); w.y = pk2(o.z, o.w); o8[q] = w; } }
    }
}

__device__ __forceinline__ void bias2_rows(Frame& F, const bf16* Wt, int N, int sh_chunk, float* dst) {
    const int gw = F.vcu * NWAVES + F.wave, NGW = F.G * NWAVES, lane = F.lane;
    float sh[3][16];
#pragma unroll
    for (int c = 0; c < 3; ++c)
#pragma unroll
        for (int j = 0; j < 16; ++j) sh[c][j] = F.mada[c * 9216 + sh_chunk * 1024 + (j < 8 ? 8 * lane + j : 512 + 8 * lane + (j - 8))];
    for (int n = gw; n < N; n += NGW) {
        const v4u w0 = *(const GAS v4u*)(Wt + (size_t)n * DM + 8 * lane), w1 = *(const GAS v4u*)(Wt + (size_t)n * DM + 512 + 8 * lane);
        const float wv[16] = {bflo(w0.x), bfhi(w0.x), bflo(w0.y), bfhi(w0.y), bflo(w0.z), bfhi(w0.z), bflo(w0.w), bfhi(w0.w), bflo(w1.x), bfhi(w1.x), bflo(w1.y), bfhi(w1.y), bflo(w1.z), bfhi(w1.z), bflo(w1.w), bfhi(w1.w)};
        float a0 = 0.f, a1 = 0.f, a2 = 0.f;
#pragma unroll
        for (int j = 0; j < 16; ++j) { a0 += wv[j] * sh[0][j]; a1 += wv[j] * sh[1][j]; a2 += wv[j] * sh[2][j]; }
        a0 = wave_sum(a0); a1 = wave_sum(a1); a2 = wave_sum(a2);
        if (lane == 0) { dst[n] = a0; dst[N + n] = a1; dst[2 * N + n] = a2; }
    }
}

constexpr int N_HEADWG = NB_S * 4 * 2, HG_HEAD = 6;
template <bool SRC_F32>
__device__ __forceinline__ void vt_item(const void* src, size_t src_pitch  , bf16* dst, size_t dst_pitch, LAS unsigned short* scr, int lane) {
#pragma unroll
    for (int i = 0; i < 8; ++i) { const int id = i * 64 + lane, r = id >> 3, ch = id & 7; v4u w;
        if (SRC_F32) { const float* p = (const float*)src + (size_t)r * src_pitch + ch * 8; const f32x4 a = *(const GAS f32x4*)p, b = *(const GAS f32x4*)(p + 4);
            w.x = pk2(a.x, a.y); w.y = pk2(a.z, a.w); w.z = pk2(b.x, b.y); w.w = pk2(b.z, b.w); }
        else w = *(const GAS v4u*)((const bf16*)src + (size_t)r * src_pitch + ch * 8);
        *(LAS v4u*)(scr + r * 72 + ch * 8) = w; }
    LDS_WAIT(); asm volatile("" ::: "memory");
#pragma unroll
    for (int i = 0; i < 8; ++i) { const int id = i * 64 + lane, c = id >> 3, rc = id & 7; const LAS unsigned short* s = scr + (rc * 8) * 72 + c; v4u w;
        w.x = (unsigned)s[0] | ((unsigned)s[72] << 16); w.y = (unsigned)s[2 * 72] | ((unsigned)s[3 * 72] << 16); w.z = (unsigned)s[4 * 72] | ((unsigned)s[5 * 72] << 16); w.w = (unsigned)s[6 * 72] | ((unsigned)s[7 * 72] << 16);
        *(GAS v4u*)(dst + (size_t)c * dst_pitch + rc * 8) = w; }
    LDS_WAIT(); asm volatile("" ::: "memory");
}

__device__ __forceinline__ void p6a_prep(Frame& F, int dense) {
    const int gw = dense * NWAVES + F.wave, NGW = (F.G - N_HEADWG) * NWAVES, lane = F.lane;
    const int d0 = 8 * (lane & 7);
    float qw[8], kw[8];
#pragma unroll
    for (int j = 0; j < 8; ++j) { qw[j] = F.q_norm[d0 + j]; kw[j] = F.k_norm[d0 + j]; }
    for (int row = gw; row < M; row += NGW) {
        const bf16* pr = F.PROJ + (size_t)row * NMIX;
        const v4u qa = *(const GAS v4u*)(pr + PC_AQ + 8 * lane), ka = *(const GAS v4u*)(pr + PC_AK + 8 * lane);
        float q[8] = {bflo(qa.x), bfhi(qa.x), bflo(qa.y), bfhi(qa.y), bflo(qa.z), bfhi(qa.z), bflo(qa.w), bfhi(qa.w)};
        float k[8] = {bflo(ka.x), bfhi(ka.x), bflo(ka.y), bfhi(ka.y), bflo(ka.z), bfhi(ka.z), bflo(ka.w), bfhi(ka.w)};
        float sq = 0.f, sk = 0.f;
#pragma unroll
        for (int j = 0; j < 8; ++j) { sq += q[j] * q[j]; sk += k[j] * k[j]; }
        sq += __shfl_xor(sq, 1); sq += __shfl_xor(sq, 2); sq += __shfl_xor(sq, 4);
        sk += __shfl_xor(sk, 1); sk += __shfl_xor(sk, 2); sk += __shfl_xor(sk, 4);
        const float rq = 1.0f / sqrtf(sq * (1.0f / 64.0f) + EPS), rk = 1.0f / sqrtf(sk * (1.0f / 64.0f) + EPS);
#pragma unroll
        for (int j = 0; j < 8; ++j) { q[j] = q[j] * rq * qw[j]; k[j] = k[j] * rk * kw[j]; }
        if (row < M_P) {
            float* ok = F.out + OUT_K + (size_t)row * 512 + 8 * lane;
            *(GAS f32x4*)ok = (f32x4){k[0], k[1], k[2], k[3]}; *(GAS f32x4*)(ok + 4) = (f32x4){k[4], k[5], k[6], k[7]};
            v4u w; w.x = pk2(k[0], k[1]); w.y = pk2(k[2], k[3]); w.z = pk2(k[4], k[5]); w.w = pk2(k[6], k[7]);
            *(GAS v4u*)(F.KB + (size_t)row * 512 + 8 * lane) = w;
        } else {
            const int rs = row - M_P, b = rs >> 10, t = rs & 1023, g8 = lane & 7;
            const bool first = (g8 & 2) == 0; const int tc = ((g8 >= 4) ? 16 : 0) + 8 * (g8 & 1);
            const float* cs = F.rope + t * 32 + tc; const float* sn = F.rope + 32768 + t * 32 + tc;
#pragma unroll
            for (int j = 0; j < 8; ++j) { const float c = cs[j], s = sn[j]; const float pq = __shfl_xor(q[j], 2), pk = __shfl_xor(k[j], 2);
                q[j] = first ? q[j] * c - pq * s : q[j] * c + pq * s; k[j] = first ? k[j] * c - pk * s : k[j] * c + pk * s; }
            v4u w; w.x = pk2(k[0], k[1]); w.y = pk2(k[2], k[3]); w.z = pk2(k[4], k[5]); w.w = pk2(k[6], k[7]);
            *(GAS v4u*)(F.KS + ((size_t)b * TK_S + PAST + t) * 512 + 8 * lane) = w;
        }
        v4u w; w.x = pk2(q[0] * QSCALE, q[1] * QSCALE); w.y = pk2(q[2] * QSCALE, q[3] * QSCALE); w.z = pk2(q[4] * QSCALE, q[5] * QSCALE); w.w = pk2(q[6] * QSCALE, q[7] * QSCALE);
        *(GAS v4u*)(F.QB + (size_t)row * 512 + 8 * lane) = w;
    }
    for (int r = gw; r < NB_S * PAST; r += NGW) { const int b = r >> 9, j = r & 511; const float* p = F.cache_k + (size_t)r * 512 + 8 * lane;
        const f32x4 a = *(const GAS f32x4*)p, bb = *(const GAS f32x4*)(p + 4); v4u w; w.x = pk2(a.x, a.y); w.y = pk2(a.z, a.w); w.z = pk2(bb.x, bb.y); w.w = pk2(bb.z, bb.w);
        *(GAS v4u*)(F.KS + ((size_t)b * TK_S + j) * 512 + 8 * lane) = w; }
    LAS unsigned short* scr = (LAS unsigned short*)(F.lds + RING_OFF + F.wave * 16384);
    constexpr int IT_P = NB_P * 4 * 4 * 2, IT_SL = NB_S * 4 * 16 * 2, IT_SC = NB_S * 4 * 8 * 2;
    for (int it = gw; it < IT_P + IT_SL + IT_SC; it += NGW) {
        if (it < IT_P) { const int bh = it >> 3, tb = (it >> 1) & 3, db = it & 1, b = bh >> 2, h = bh & 3;
            vt_item<false>(F.PROJ + ((size_t)b * T_P + tb * 64) * NMIX + PC_AV + h * 128 + db * 64, NMIX, F.VTP + ((size_t)bh * 128 + db * 64) * T_P + tb * 64, T_P, scr, lane); }
        else if (it < IT_P + IT_SL) { const int r = it - IT_P, bh = r >> 5, tb = (r >> 1) & 15, db = r & 1, b = bh >> 2, h = bh & 3;
            vt_item<false>(F.PROJ + ((size_t)M_P + b * T_S + tb * 64) * NMIX + PC_AV + h * 128 + db * 64, NMIX, F.VTS + ((size_t)bh * 128 + db * 64) * TK_S + PAST + tb * 64, TK_S, scr, lane); }
        else { const int r = it - IT_P - IT_SL, bh = r >> 4, tb = (r >> 1) & 7, db = r & 1, b = bh >> 2, h = bh & 3;
            vt_item<true>(F.cache_v + ((size_t)b * PAST + tb * 64) * 512 + h * 128 + db * 64, 512, F.VTS + ((size_t)bh * 128 + db * 64) * TK_S + tb * 64, TK_S, scr, lane); }
    }
}

constexpr int HG_QT = 0, HG_KT = 8192, HG_KH = 16384, HG_VT = 24576, HG_PE = 32768, HG_BUF = 33792, HG_GT = 2 * HG_BUF, HG_GTB = 4096, HG_FLAG = HG_GT + 2 * HG_GTB;
#define MFMA16(a, b, c) __builtin_amdgcn_mfma_f32_16x16x32_bf16(a, b, c, 0, 0, 0)
__device__ __forceinline__ int hgrn_unit(Frame& F, int row_base, int T, int h, int dir, const float* s0, float* sfin, bf16* obuf, int c_begin, int c_end, const unsigned* stopc = nullptr, unsigned stopneed = 0u) {
    LAS unsigned char* L = F.lds;
    int tid_ = F.tid; asm volatile("" : "+v"(tid_));
    const int tid = tid_, lane = tid & 63, w = F.wave, r = lane & 15, g = lane >> 4, kp = tid & 63, tg = w;
    f32x4 S[8];
#pragma unroll
    for (int t8 = 0; t8 < 8; ++t8)
#pragma unroll
        for (int i = 0; i < 4; ++i) S[t8][i] = s0 ? s0[(size_t)(16 * t8 + 4 * g + i) * 128 + 16 * w + r] : 0.f;
    const int cq = PC_Q + h * 128 + 2 * kp, cf = (dir == 0 ? PC_FF : PC_FB) + h * 128 + 2 * kp, ci = PC_I + h * 128 + 2 * kp;
    unsigned rq[4], rx[4], rv[4];
    const int tsgn = dir == 0 ? 1 : -1, tbase = dir == 0 ? 0 : T - 1;
    const int nch = c_end;
#define HG_L(c_) do { const int cc_ = (c_) < nch ? (c_) : nch - 1;     \
        _Pragma("unroll") for (int i = 0; i < 4; ++i) { const int tt = 32 * cc_ + 4 * tg + i, ta = tbase + tsgn * tt; const bf16* pr = F.PROJ + (size_t)(row_base + ta) * NMIX; \
        rq[i] = *(const GAS unsigned*)(pr + cq); rx[i] = *(const GAS unsigned*)(pr + cf); rv[i] = *(const GAS unsigned*)(pr + ci); } } while (0)
#define HG_P1(c_) do { { float acc0 = 0.f, acc1 = 0.f; \
        _Pragma("unroll") for (int i = 0; i < 4; ++i) { const h2_t lf = __builtin_bit_cast(h2_t, rx[i]); acc0 += (float)lf[0]; acc1 += (float)lf[1]; } \
        *(LAS f32x2*)(L + HG_GT + ((c_) & 1) * HG_GTB + (tg * 128 + 2 * kp) * 4) = (f32x2){acc0, acc1}; } } while (0)
#define HG_P2(c_) do { { LAS unsigned char* Lb = L + ((c_) & 1) * HG_BUF; const LAS unsigned char* Gt = L + HG_GT + ((c_) & 1) * HG_GTB; f32x2 off = {0.f, 0.f}, be = {0.f, 0.f}; \
        _Pragma("unroll") for (int g2 = 0; g2 < 8; ++g2) { const f32x2 v2 = *(const LAS f32x2*)(Gt + (g2 * 128 + 2 * kp) * 4); if (g2 < tg) off += v2; be += v2; } \
        float kh[2][4]; float b0 = off.x, b1 = off.y; \
        _Pragma("unroll") for (int i = 0; i < 4; ++i) { const int t = 4 * tg + i; const h2_t lf = __builtin_bit_cast(h2_t, rx[i]); const float l0 = (float)lf[0], l1 = (float)lf[1]; b0 += l0; b1 += l1; \
            const float B0 = fmaxf(b0, -80.f), B1 = fmaxf(b1, -80.f); \
            const float qt0 = bflo(rq[i]) * __expf(B0), qt1 = bfhi(rq[i]) * __expf(B1), kt0 = (1.0f - __expf(l0)) * __expf(-B0), kt1 = (1.0f - __expf(l1)) * __expf(-B1); kh[0][i] = kt0; kh[1][i] = kt1; \
            const int a = t * 256 + ((((kp >> 2) ^ (t & 15))) << 4) + (kp & 3) * 4; \
            *(LAS unsigned*)(Lb + HG_QT + a) = pk2(qt0, qt1); *(LAS unsigned*)(Lb + HG_KT + a) = pk2(kt0, kt1); } \
        _Pragma("unroll") for (int e = 0; e < 2; ++e) { const int k = 2 * kp + e; const int a = (((k >> 4) * 4 + (tg >> 1)) * 16 + (k & 15)) * 16 + 8 * (tg & 1); \
            *(LAS v2u*)(Lb + HG_KH + a) = (v2u){pk2(kh[e][0], kh[e][1]), pk2(kh[e][2], kh[e][3])}; \
            v2u vw; if (e == 0) { vw.x = (rv[0] & 0xffffu) | (rv[1] << 16); vw.y = (rv[2] & 0xffffu) | (rv[3] << 16); } else { vw.x = (rv[0] >> 16) | (rv[1] & 0xffff0000u); vw.y = (rv[2] >> 16) | (rv[3] & 0xffff0000u); } \
            *(LAS v2u*)(Lb + HG_VT + a) = vw; } \
        if (tg == 0) *(LAS f32x2*)(Lb + HG_PE + 2 * kp * 4) = (f32x2){__expf(be.x), __expf(be.y)}; } } while (0)
    HG_L(c_begin);
    int c = c_begin;
    for (; c < nch; ++c) {
        if (stopc && tid == 0) *(LAS unsigned*)(L + HG_FLAG) = (__hip_atomic_load(stopc, RLX_AGENT) >= stopneed) ? 1u : 0u;
        HG_P1(c);
        LDS_BARRIER();
        if (stopc && *(const LAS unsigned*)(L + HG_FLAG) != 0u) break;
        HG_P2(c); HG_L(c + 1);
        LDS_BARRIER();
        const LAS unsigned char* Lb = L + (c & 1) * HG_BUF;
        f32x4 d00 = {0.f, 0.f, 0.f, 0.f}, d01 = d00, d11 = d00;
#pragma unroll
        for (int ks = 0; ks < 4; ++ks) { const int co = (((4 * ks + g) ^ r) << 4);
            const bf16x8 kt0 = *(const LAS bf16x8*)(Lb + HG_KT + r * 256 + co), kt1 = *(const LAS bf16x8*)(Lb + HG_KT + (16 + r) * 256 + co);
            const bf16x8 qt0 = *(const LAS bf16x8*)(Lb + HG_QT + r * 256 + co), qt1 = *(const LAS bf16x8*)(Lb + HG_QT + (16 + r) * 256 + co);
            d00 = MFMA16(kt0, qt0, d00); d01 = MFMA16(kt0, qt1, d01); d11 = MFMA16(kt1, qt1, d11); }
        asm volatile("" ::: "memory");
#pragma unroll
        for (int i = 0; i < 4; ++i) if (4 * g + i > r) { d00[i] = 0.f; d11[i] = 0.f; }
        const v4u a0w = {pk2(d00[0], d00[1]), pk2(d00[2], d00[3]), 0u, 0u}, a1w = {pk2(d01[0], d01[1]), pk2(d01[2], d01[3]), pk2(d11[0], d11[1]), pk2(d11[2], d11[3])};
        const v2u vpl = *(const LAS v2u*)(Lb + HG_VT + ((w * 4 + (g >> 1)) * 16 + r) * 16 + 8 * (g & 1)), vph = *(const LAS v2u*)(Lb + HG_VT + ((w * 4 + 2 + (g >> 1)) * 16 + r) * 16 + 8 * (g & 1));
        const bf16x8 vperm = __builtin_bit_cast(bf16x8, (v4u){vpl.x, vpl.y, vph.x, vph.y});
        const bf16x8 vnat = *(const LAS bf16x8*)(Lb + HG_VT + ((w * 4 + g) * 16 + r) * 16);
        f32x4 o0 = MFMA16(__builtin_bit_cast(bf16x8, a0w), vperm, ((f32x4){0.f, 0.f, 0.f, 0.f})), o1 = MFMA16(__builtin_bit_cast(bf16x8, a1w), vperm, ((f32x4){0.f, 0.f, 0.f, 0.f}));
        asm volatile("" ::: "memory");
#pragma unroll
        for (int kk = 0; kk < 4; ++kk) {
            const v4u sw = {pk2(S[2 * kk][0], S[2 * kk][1]), pk2(S[2 * kk][2], S[2 * kk][3]), pk2(S[2 * kk + 1][0], S[2 * kk + 1][1]), pk2(S[2 * kk + 1][2], S[2 * kk + 1][3])};
            const int c_lo = (((4 * kk + (g >> 1)) ^ r) << 4) + 8 * (g & 1), c_hi = (((4 * kk + 2 + (g >> 1)) ^ r) << 4) + 8 * (g & 1);
            const v2u p0l = *(const LAS v2u*)(Lb + HG_QT + r * 256 + c_lo), p0h = *(const LAS v2u*)(Lb + HG_QT + r * 256 + c_hi);
            const v2u p1l = *(const LAS v2u*)(Lb + HG_QT + (16 + r) * 256 + c_lo), p1h = *(const LAS v2u*)(Lb + HG_QT + (16 + r) * 256 + c_hi);
            o0 = MFMA16(__builtin_bit_cast(bf16x8, (v4u){p0l.x, p0l.y, p0h.x, p0h.y}), __builtin_bit_cast(bf16x8, sw), o0);
            o1 = MFMA16(__builtin_bit_cast(bf16x8, (v4u){p1l.x, p1l.y, p1h.x, p1h.y}), __builtin_bit_cast(bf16x8, sw), o1); }
#pragma unroll
        for (int i = 0; i < 4; ++i) { const int t0 = 32 * c + 4 * g + i, t1 = t0 + 16, ta0 = tbase + tsgn * t0, ta1 = tbase + tsgn * t1;
            obuf[(size_t)(row_base + ta0) * 512 + h * 128 + 16 * w + r] = (bf16)(pk2(o0[i], 0.f) & 0xffffu); obuf[(size_t)(row_base + ta1) * 512 + h * 128 + 16 * w + r] = (bf16)(pk2(o1[i], 0.f) & 0xffffu); }
#pragma unroll
        for (int t8 = 0; t8 < 8; ++t8) { const bf16x8 khf = *(const LAS bf16x8*)(Lb + HG_KH + ((t8 * 4 + g) * 16 + r) * 16); const f32x4 pe = *(const LAS f32x4*)(Lb + HG_PE + (16 * t8 + 4 * g) * 4);
            S[t8] = MFMA16(khf, vnat, S[t8]) * pe; }
    }
#undef HG_L
#undef HG_P1
#undef HG_P2
    if (sfin) {
#pragma unroll
        for (int t8 = 0; t8 < 8; ++t8)
#pragma unroll
            for (int i = 0; i < 4; ++i) sfin[(size_t)(16 * t8 + 4 * g + i) * 128 + 16 * w + r] = S[t8][i];
    }
    __syncthreads();
    return c;
}

__device__ __forceinline__ bool early_chains(const Frame& F) { return EARLY_CHAINS && F.xok && F.G == 256; }
__device__ __forceinline__ void p5_chains(Frame& F, unsigned* cw) {
    if (F.xr >= 8) { if (F.tid == 0) (void)__hip_atomic_fetch_add(cw + CW_GDONE + 64 * F.xl, 1u, RLX_AGENT); return; }
    if (F.tid == 0) { unsigned sp = 0; while (__hip_atomic_load(cw + CW_SAMP + 64 * F.xl, RLX_AGENT) < 320u) { __builtin_amdgcn_s_sleep(2); if (++sp > (1u << 22)) break; }
        __builtin_amdgcn_fence(__ATOMIC_ACQUIRE, "agent"); asm volatile("s_waitcnt vmcnt(0)" ::: "memory"); }
    __syncthreads();
    const int b = F.xl - 6, dir = F.xr & 1, h = F.xr >> 1, v = b * 8 + F.xr;
    const int c = hgrn_unit(F, M_P + b * T_S, T_S, h, dir, F.state0 + ((size_t)(b * 2 + dir) * 4 + h) * 16384, F.hsave + (size_t)v * 16384, dir == 0 ? F.OF : F.OB, 0, T_S / 32, cw + CW_GDONE + 64 * F.xl, 24u);
    if (F.tid == 0) F.hidx[v] = c;
}
__device__ __forceinline__ void p6_phase(Frame& F) {
    const bool ec = early_chains(F);
    const bool head = ec ? (F.xl >= 6 && F.xr < 8) : ((int)blockIdx.x < N_HEADWG);
    if (head) { const int v = ec ? (F.xl - 6) * 8 + F.xr : (int)blockIdx.x, dir = v & 1, h = (v >> 1) & 3, b = v >> 3;
        const int c0 = ec ? F.hidx[v] : 0, c1 = c0 + HG_HEAD < T_S / 32 ? c0 + HG_HEAD : T_S / 32;
        if (c0 < c1) hgrn_unit(F, M_P + b * T_S, T_S, h, dir, ec ? F.hsave + (size_t)v * 16384 : F.state0 + ((size_t)(b * 2 + dir) * 4 + h) * 16384, F.hsave + (size_t)v * 16384, dir == 0 ? F.OF : F.OB, c0, c1);
        if (F.tid == 0) F.hidx[v] = c1; }
    else { const int dense = ec ? (F.xl < 6 ? F.xl * 32 + F.xr : 192 + (F.xl - 6) * 24 + (F.xr - 8)) : (int)blockIdx.x - N_HEADWG;
        p6a_prep(F, dense); if (CONV_P6) convert_queue(F, CW_CONVQ + 320, CV_LATE0, CV_LATE_N); }
}

__device__ __forceinline__ int crow(int r, int hi) { return (r & 3) + 8 * (r >> 2) + 4 * hi; }
constexpr int AT_K = 0, AT_V = 16384, AT_STAGE = 16384 + 128 * 136, XCH_SLOT = 64 * 64 * 4;
__device__ __forceinline__ void attn_finish(Frame& F, const f32x16 (&o)[4], const LAS float* slot, float lam, int row0, int h, int lane) {
    const int r32 = lane & 31, hi = lane >> 5;
    f32x16 d[4]; float ss = 0.f;
#pragma unroll
    for (int dv = 0; dv < 4; ++dv)
#pragma unroll
        for (int r = 0; r < 16; ++r) { const float x = o[dv][r] - lam * slot[(dv * 16 + r) * 64 + lane]; d[dv][r] = x; ss += x * x; }
    ss += __shfl_xor(ss, 32);
    const float rstd = (1.0f - LAM_INIT) / sqrtf(ss * (1.0f / 128.0f) + EPS);
    bf16* orow = F.ABUF2 + (size_t)(row0 + r32) * DM + 512 + h * 128;
#pragma unroll
    for (int dv = 0; dv < 4; ++dv)
#pragma unroll
        for (int g = 0; g < 4; ++g) { const int c = 32 * dv + 8 * g + 4 * hi; const f32x4 w4 = *(const GAS f32x4*)(F.attn_subln + c);
            v2u w; w.x = pk2(d[dv][4 * g] * rstd * w4.x, d[dv][4 * g + 1] * rstd * w4.y); w.y = pk2(d[dv][4 * g + 2] * rstd * w4.z, d[dv][4 * g + 3] * rstd * w4.w);
            *(GAS v2u*)(orow + c) = w; }
}
__device__ __forceinline__ float attn_lam(Frame& F) {
    const float a = F.attn_lambda[F.lane] * F.attn_lambda[64 + F.lane], b = F.attn_lambda[128 + F.lane] * F.attn_lambda[192 + F.lane];
    return __expf(wave_sum(a)) - __expf(wave_sum(b)) + LAM_INIT;
}
__device__ __forceinline__ void attn_unit(Frame& F, const bf16* Kb, const bf16* VTb, int TK, int row0, int h) {
    LAS unsigned char* L = F.lds;
    int tid_ = F.tid; asm volatile("" : "+v"(tid_));
    const int tid = tid_, w = F.wave, lane = tid & 63, mp = w >> 2, qb = w & 3, r32 = lane & 31, hi = lane >> 5;
    const float lam = attn_lam(F);
    bf16x8 qf[4];
    { const bf16* Qp = F.QB + (size_t)(row0 + 32 * qb + r32) * 512 + h * 128 + mp * 64 + 8 * hi;
#pragma unroll
      for (int s = 0; s < 4; ++s) qf[s] = *(const GAS bf16x8*)(Qp + 16 * s); }
    f32x16 o[4];
#pragma unroll
    for (int d = 0; d < 4; ++d) o[d] = f32x16{};
    float m_run = -1e30f, l_run = 0.f;
    v4u kreg[2], vreg[2];
    const int krow0 = tid >> 4, kch = tid & 15, vrow0 = tid >> 3, vch = tid & 7;
#define AT_LOAD(kv0_) do { _Pragma("unroll") for (int i = 0; i < 2; ++i) { kreg[i] = *(const GAS v4u*)(Kb + (size_t)((kv0_) + krow0 + 32 * i) * 512 + h * 128 + kch * 8); \
        vreg[i] = *(const GAS v4u*)(VTb + (size_t)(vrow0 + 64 * i) * TK + (kv0_) + vch * 8); } } while (0)
#define AT_WRITE(st_) do { LAS unsigned char* Ls_ = L + (st_) * AT_STAGE; _Pragma("unroll") for (int i = 0; i < 2; ++i) { const int kr = krow0 + 32 * i, vr = vrow0 + 64 * i; \
        *(LAS v4u*)(Ls_ + AT_K + kr * 256 + ((kch ^ (kr & 15)) << 4)) = kreg[i]; \
        *(LAS v2u*)(Ls_ + AT_V + vr * 136 + vch * 16) = (v2u){vreg[i].x, vreg[i].y}; *(LAS v2u*)(Ls_ + AT_V + vr * 136 + vch * 16 + 8) = (v2u){vreg[i].z, vreg[i].w}; } } while (0)
    const int ntiles = TK >> 6;
    AT_LOAD(0); AT_WRITE(0);
    __syncthreads();
    for (int t = 0; t < ntiles; ++t) {
        if (t + 1 < ntiles) AT_LOAD((t + 1) * 64);
        const LAS unsigned char* Ls = L + (t & 1) * AT_STAGE;
#pragma unroll
        for (int j = 0; j < 2; ++j) {
            f32x16 p = f32x16{};
            __builtin_amdgcn_s_setprio(1);
#pragma unroll
            for (int s = 0; s < 4; ++s) { const bf16x8 kf = *(const LAS bf16x8*)(Ls + AT_K + (32 * j + r32) * 256 + (((mp * 8 + 2 * s + hi) ^ (r32 & 15)) << 4));
                p = __builtin_amdgcn_mfma_f32_32x32x16_bf16(kf, qf[s], p, 0, 0, 0); }
            __builtin_amdgcn_s_setprio(0);
            float mx = p[0];
#pragma unroll
            for (int r = 1; r < 16; ++r) mx = fmaxf(mx, p[r]);
            mx = fmaxf(mx, __shfl_xor(mx, 32));
            const float mnew = (mx > m_run + 8.0f) ? mx : m_run, alpha = __builtin_amdgcn_exp2f(m_run - mnew); m_run = mnew;
            float ls = 0.f;
#pragma unroll
            for (int r = 0; r < 16; ++r) { p[r] = __builtin_amdgcn_exp2f(p[r] - mnew); ls += p[r]; }
            l_run = l_run * alpha + ls;
            if (__any(alpha != 1.0f)) {
#pragma unroll
                for (int d = 0; d < 4; ++d)
#pragma unroll
                    for (int r = 0; r < 16; ++r) o[d][r] *= alpha; }
            __builtin_amdgcn_s_setprio(1);
#pragma unroll
            for (int s = 0; s < 2; ++s) { const v4u pw = {pk2(p[8 * s + 0], p[8 * s + 1]), pk2(p[8 * s + 2], p[8 * s + 3]), pk2(p[8 * s + 4], p[8 * s + 5]), pk2(p[8 * s + 6], p[8 * s + 7])};
#pragma unroll
                for (int d = 0; d < 4; ++d) { const LAS unsigned char* vp = Ls + AT_V + (32 * d + r32) * 136 + (32 * j + 16 * s + 4 * hi) * 2;
                    const v2u lo = *(const LAS v2u*)vp, hh = *(const LAS v2u*)(vp + 16);
                    o[d] = __builtin_amdgcn_mfma_f32_32x32x16_bf16(__builtin_bit_cast(bf16x8, (v4u){lo.x, lo.y, hh.x, hh.y}), __builtin_bit_cast(bf16x8, pw), o[d], 0, 0, 0); } }
            __builtin_amdgcn_s_setprio(0);
        }
        if (t + 1 < ntiles) AT_WRITE((t + 1) & 1);
        __syncthreads();
    }
#undef AT_LOAD
#undef AT_WRITE
    const float inv = 1.0f / (l_run + __shfl_xor(l_run, 32));
#pragma unroll
    for (int d = 0; d < 4; ++d)
#pragma unroll
        for (int r = 0; r < 16; ++r) o[d][r] *= inv;
    LAS float* slot = (LAS float*)(L + qb * XCH_SLOT);
    if (mp == 1) {
#pragma unroll
        for (int d = 0; d < 4; ++d)
#pragma unroll
            for (int r = 0; r < 16; ++r) slot[(d * 16 + r) * 64 + lane] = o[d][r];
    }
    __syncthreads();
    if (mp == 0) attn_finish(F, o, slot, lam, row0 + 32 * qb, h, lane);
    __syncthreads();
}

__device__ __forceinline__ void p6b_mixers(Frame& F, int qrun) {
    constexpr int N_HS = NB_S * 4 * 2, N_AS = NB_S * 4 * 8, N_HP = NB_P * 4 * 2, N_AP = NB_P * 4 * 2, N_ALL = N_HS + N_AS + N_HP + N_AP, N_CV = (CONV_LATE_P3 || CONV_P6 || CONV_P5TAIL) ? 0 : (CONV_P9 ? CV_MO / 16 : CV_LATE_N / 16);
    volatile LAS int* qslot = (volatile LAS int*)(F.lds + MISC_OFF + 64);
    for (;;) {
        if (F.tid == 0) *qslot = (int)__hip_atomic_fetch_add(F.ctl + CW_QUEUE + 64 * qrun, 1u, RLX_AGENT);
        __syncthreads();
        int u = *qslot;
        __syncthreads();
        if (u >= N_ALL + N_CV) break;
        if (u >= N_ALL) {
            LAS float* scr = (LAS float*)(F.lds + RING_OFF + F.wave * 16384);
            for (int j = 0; j < 2; ++j) convert_item(F, scr, CV_LATE0 + (u - N_ALL) * 16 + j * 8 + F.wave);
            __syncthreads(); continue; }
#ifdef PROBE_SUB
        if (qrun) { const int cls = u < N_HS ? 0 : u < N_HS + N_AS ? 1 : u < N_HS + N_AS + N_HP ? 2 : 3; if (!((PROBE_SUB >> cls) & 1)) continue; }
#endif
        const bool is_hs = u < N_HS, is_as = !is_hs && u < N_HS + N_AS, is_hp = !is_hs && !is_as && u < N_HS + N_AS + N_HP;
        if (is_hs || is_hp) { const int v = is_hs ? u : u - N_HS - N_AS; const int dir = v & 1, h = (v >> 1) & 3, b = v >> 3;
            hgrn_unit(F, is_hs ? M_P + b * T_S : b * T_P, is_hs ? T_S : T_P, h, dir, is_hs ? F.hsave + (size_t)v * 16384 : nullptr,
                      (is_hs || qrun) ? nullptr : F.out + OUT_S + ((size_t)(b * 2 + dir) * 4 + h) * 16384, dir == 0 ? F.OF : F.OB, is_hs ? F.hidx[v] : 0, is_hs ? T_S / 32 : T_P / 32); continue; }
        { const int v = is_as ? u - N_HS : u - N_HS - N_AS - N_HP;
          const int h = is_as ? (v >> 3) & 3 : (v >> 1) & 3, b = is_as ? v >> 5 : v >> 3, qo = is_as ? (v & 7) * 128 : (v & 1) * 128;
          attn_unit(F, is_as ? F.KS + (size_t)b * TK_S * 512 : F.KB + (size_t)b * T_P * 512, is_as ? F.VTS + (size_t)(b * 4 + h) * 128 * TK_S : F.VTP + (size_t)(b * 4 + h) * 128 * T_P,
                    is_as ? TK_S : T_P, (is_as ? M_P + b * T_S : b * T_P) + qo, h); }
    }
}

__device__ __forceinline__ void p7_combine(Frame& F) {
    const int lane = F.lane, xl = F.xl, wl = F.xr * NWAVES + F.wave, NWL = (F.G / 8) * NWAVES;
    float nw[8];
#pragma unroll
    for (int j = 0; j < 8; ++j) nw[j] = F.hgrn_out_norm[(8 * lane + j) & 127];
    for (int rl = wl; rl < M / 8; rl += NWL) { const int row = pg8::pmap(5 * xl + (rl >> 8)) * 256 + (rl & 255);
        const v4u fa = *(const GAS v4u*)(F.OF + (size_t)row * 512 + 8 * lane), ba = *(const GAS v4u*)(F.OB + (size_t)row * 512 + 8 * lane);
        const float o[8] = {bflo(fa.x) + bflo(ba.x), bfhi(fa.x) + bfhi(ba.x), bflo(fa.y) + bflo(ba.y), bfhi(fa.y) + bfhi(ba.y), bflo(fa.z) + bflo(ba.z), bfhi(fa.z) + bfhi(ba.z), bflo(fa.w) + bflo(ba.w), bfhi(fa.w) + bfhi(ba.w)};
        float ss = 0.f;
#pragma unroll
        for (int j = 0; j < 8; ++j) ss += o[j] * o[j];
        ss += __shfl_xor(ss, 1); ss += __shfl_xor(ss, 2); ss += __shfl_xor(ss, 4); ss += __shfl_xor(ss, 8);
        const float rstd = 1.0f / sqrtf(ss * (1.0f / 128.0f) + EPS);
        const v4u ga = *(const GAS v4u*)(F.PROJ + (size_t)row * NMIX + PC_G + 8 * lane);
        const float g[8] = {bflo(ga.x), bfhi(ga.x), bflo(ga.y), bfhi(ga.y), bflo(ga.z), bfhi(ga.z), bflo(ga.w), bfhi(ga.w)};
        float y[8];
#pragma unroll
        for (int j = 0; j < 8; ++j) y[j] = o[j] * rstd * nw[j] * (g[j] * sigmoid_f(g[j]));
        v4u w; w.x = pk2(y[0], y[1]); w.y = pk2(y[2], y[3]); w.z = pk2(y[4], y[5]); w.w = pk2(y[6], y[7]);
        *(GAS v4u*)(F.ABUF2 + (size_t)row * DM + 8 * lane) = w;
    }
}

struct Args { const float* in[24]; float* out; unsigned char* ws; int ph_lo, ph_hi, use_bar, pad; };
__global__ void __launch_bounds__(NWAVES * 64, 2) hymba_fwd(Args args) {
    extern __shared__ __attribute__((aligned(16))) unsigned char lds[];
    Frame F;
    F.lds = (LAS unsigned char*)lds;
    F.MISC = (volatile LAS unsigned*)(F.lds + MISC_OFF);
    F.tid = threadIdx.x; F.lane = F.tid & 63; F.wave = __builtin_amdgcn_readfirstlane(F.tid >> 6);
    F.G = gridDim.x; { const int bx = blockIdx.x; F.vcu = (F.G % 8 == 0) ? (bx % 8) * (F.G / 8) + bx / 8 : bx; }
    unsigned char* ws = args.ws;
    F.ctl = (gu32*)(ws + WS_CTL);
    F.x_prompt = args.in[0]; F.x_sample = args.in[1]; F.c = args.in[2]; F.cache_k = args.in[3]; F.cache_v = args.in[4]; F.state0 = args.in[5]; F.c_ctx = args.in[6];
    F.w_ada = args.in[7]; F.b_ada = args.in[8]; F.norm_ffn1 = args.in[9]; F.w_ffn1_in = args.in[10]; F.w_ffn1_out = args.in[11]; F.norm_mix = args.in[12]; F.w_mix_in = args.in[13]; F.w_mix_out = args.in[14];
    F.lb_logits = args.in[15]; F.hgrn_out_norm = args.in[16]; F.q_norm = args.in[17]; F.k_norm = args.in[18]; F.attn_lambda = args.in[19]; F.attn_subln = args.in[20]; F.norm_ffn2 = args.in[21];
    F.w_ffn2_in = args.in[22]; F.w_ffn2_out = args.in[23]; F.out = args.out;
    F.mada = (float*)(ws + WS_MADA); F.rope = (float*)(ws + WS_ROPE); F.lbv = (float*)(ws + WS_LB);
    F.W1I = (bf16*)(ws + WS_W1I); F.W1O = (bf16*)(ws + WS_W1O); F.WMI = (bf16*)(ws + WS_WMI); F.WMO = (bf16*)(ws + WS_WMO); F.W2I = (bf16*)(ws + WS_W2I); F.W2O = (bf16*)(ws + WS_W2O);
    F.ABUF = (bf16*)(ws + WS_ABUF); F.ABUF2 = (bf16*)(ws + WS_ABUF2); F.rowss = (float*)(ws + WS_ROWSS); F.bias2m = (float*)(ws + WS_BIAS2); F.bias2f = F.bias2m + 3 * 4096; F.hsave = (float*)(ws + WS_HSAVE); F.hidx = (int*)(ws + WS_ROWSS); F.cq1 = (float*)(ws + WS_BIAS2); F.cq2 = F.cq1 + NFF; F.rowq = F.cq2 + NFF; F.HID = (bf16*)(ws + WS_BIG); F.PROJ = (bf16*)(ws + WS_BIG); F.QB = (bf16*)(ws + WS_QB); F.KB = (bf16*)(ws + WS_KB); F.KS = (bf16*)(ws + WS_KS);
    F.VTP = (bf16*)(ws + WS_VTP); F.VTS = (bf16*)(ws + WS_VTS); F.OF = (bf16*)(ws + WS_OF); F.OB = (bf16*)(ws + WS_OB);
    for (int u = F.tid; u < (LDS_BYTES - LDSCTL_OFF) / 4; u += NWAVES * 64) ((LAS unsigned*)(F.lds + LDSCTL_OFF))[u] = 0u;
    __syncthreads();
    XcdBarrier bar; bar.bar = (unsigned*)(F.ctl + CW_BAR); bar.x = 0; bar.st = nullptr;
    if (args.use_bar) bar = xcd_barrier_post((unsigned*)(F.ctl + CW_BAR), F.MISC + 8);
    const int lo = args.ph_lo, hi = args.ph_hi;
#ifndef PROBE_DUP
#define PROBE_DUP 0u
#endif
#define IN(k) (lo <= (k) && (k) < hi)
#define SEAM_LOCAL(k) (LOCAL_SEAMS && !FUSE_NORM && !MERGE_FFN && ((k) == 1 || (k) == 3 || (k) == 9 || (k) == 10 || (k) == 11))
#define SEAM(k) do { if (IN(k) && IN((k) + 1) && !(MERGE_FFN && !FUSE_NORM && ((k) == 2 || (k) == 11))) { if (SEAM_LOCAL(k) && F.xok) xcc_barrier(bar, cw + CW_LBAR); else xcd_barrier(bar); } } while (0)
#define PHASE(k, ...) if (IN(k)) { constexpr bool dupk = ((PROBE_DUP) >> (k)) & 1u; \
        if constexpr (dupk) { _Pragma("unroll 1") for (int qrun = 0; qrun < 2; ++qrun) { if (qrun) xcd_barrier(bar); __VA_ARGS__ } } \
        else { constexpr int qrun = 0; (void)qrun; __VA_ARGS__ } } SEAM(k)
#ifdef PROBE_EPI
#define PROBE_EPI_FLAG args.pad
#else
#define PROBE_EPI_FLAG 0
#endif
#ifdef PROBE_BMUL
#define PROBE_GEMM_HOOK if (args.pad) { g.bmul = (PROBE_BMUL) & 1; g.amul = ((PROBE_BMUL) >> 1) & 1; }
#else
#define PROBE_GEMM_HOOK
#endif
#ifndef PROBE_FFN_PART
#define PROBE_FFN_PART 0
#endif
#ifndef PROBE_FORCE_LOCAL
#define PROBE_FORCE_LOCAL 0
#endif
#define COMMA ,
#define GEMM_PHASE(EPI, A_, B_, N_, K_, ...) do { Gemm g{A_, B_, M, N_, K_}; PROBE_GEMM_HOOK; StaticOrder S; S.init(M, N_, F.G, F.xr * 8 + F.xl); typedef pg8::EPI EpiT; EpiT E{__VA_ARGS__}; \
        pg8::gemm_phase<EpiT, StaticOrder, PG8_ALIGN, PG8_SP2>(F.lds + RING_OFF, g, S, E); } while (0)
    using pg8::Gemm; using pg8::StaticOrder;
    constexpr int KFI = FFN_IN_MODE ? DM / 2 : DM;
    float* const outS = F.out + (size_t)M_P * DM;
    F.xl = (int)blockIdx.x % 8; F.xr = (int)blockIdx.x / 8; F.xok = PROBE_FORCE_LOCAL;
#define RELABEL() do { if (args.use_bar && IN(0) && IN(1)) { const unsigned verdict = F.MISC[11], rk = F.MISC[10]; if (verdict == 1u && rk < (unsigned)(F.G / 8)) { F.xok = 1; F.xl = (int)bar.x; F.xr = (int)rk; } } } while (0)
    unsigned* const cw = (unsigned*)F.ctl;
#if FUSE_NORM
    PHASE(0, p0_prologue(F); );
    PHASE(1, norm_mod_phase<0>(F, F.x_prompt, F.x_sample, F.norm_ffn1, 0, 1); bias2_rows(F, F.WMI, NMIX, 3, F.bias2m); bias2_rows(F, F.W2I, NFF, 6, F.bias2f); );
    PHASE(2, GEMM_PHASE(EpiSwiGLU<false>, F.ABUF, F.W1I, NFF, KFI, F.HID, DFF, nullptr, nullptr, PROBE_EPI_FLAG); if (CONV_P2TAIL) convert_queue(F, CW_CONVQ, CV_FI, CV_FO + CV_MI); );
    PHASE(3, GEMM_PHASE(EpiResid<true COMMA true>, F.HID, F.W1O, DM, DFF, F.x_prompt, F.x_sample, F.out, F.mada + 2 * 1024, F.ABUF, F.norm_mix, F.mada + 4 * 1024, F.rowss);
             if (CONV_LATE_P3) convert_queue(F, CW_CONVQ + 64, CV_LATE0, CV_LATE_N); );
    PHASE(4, GEMM_PHASE(EpiProj<true>, F.ABUF, F.WMI, NMIX, DM, F.PROJ, F.out + OUT_V, F.lbv, F.rowss, F.bias2m); );
    PHASE(5, p6_phase(F); );
    PHASE(6, p6b_mixers(F, qrun + args.pad); );
    PHASE(7, p7_combine(F); );
    PHASE(8, GEMM_PHASE(EpiResid<true COMMA false>, F.ABUF2, F.WMO, DM, DM, F.out, outS, F.out, F.mada + 5 * 1024, F.ABUF, F.norm_ffn2, F.mada + 7 * 1024, F.rowss); );
    PHASE(9, GEMM_PHASE(EpiSwiGLU<true>, F.ABUF, F.W2I, NFF, DM, F.HID, DFF, F.rowss, F.bias2f, NFF); );
    PHASE(10, GEMM_PHASE(EpiResid<false COMMA true>, F.HID, F.W2O, DM, DFF, F.out, outS, F.out, F.mada + 8 * 1024, nullptr, nullptr, nullptr, nullptr); );
#else
    PHASE(0, p0_prologue(F); );
    RELABEL();
    PHASE(1, norm_mod_phase<FFN_IN_MODE>(F, F.x_prompt, F.x_sample, F.norm_ffn1, 0, 1); );
#if MERGE_FFN
#define FFN_MERGED(AIN, WIN, WOUT, B0, B1, GATE, PC, UC) do { \
        if (!(args.pad && PROBE_FFN_PART == 2)) { Gemm g{AIN, WIN, M, NFF, DM}; pg8::XccInOrder S{F.xl, F.xr, cw + (PC) + 4096 * args.pad, F.xok}; typedef pg8::EpiSwiGLU<false> EpiT; EpiT E{F.HID, DFF, nullptr, nullptr, 0}; \
          pg8::gemm_phase<EpiT, pg8::XccInOrder, PG8_ALIGN, PG8_SP2>(F.lds + RING_OFF, g, S, E); } \
        if (!(args.pad && PROBE_FFN_PART == 1)) { Gemm g{F.HID, WOUT, M, DM, DFF}; pg8::XccOutOrder S{F.xl, F.xr, cw + (PC) + (PROBE_FFN_PART == 2 ? 0 : 4096 * args.pad)}; typedef pg8::EpiResidSplit<true> EpiT; EpiT E{B0, B1, args.pad ? (float*)(args.ws + WS_OF) : F.out, GATE, (float*)(args.ws + WS_SLAB), cw + (UC) + 4096 * args.pad, F.xl, F.xok};     \
          pg8::gemm_phase<EpiT, pg8::XccOutOrder, PG8_ALIGN, PG8_SP2>(F.lds + RING_OFF, g, S, E); } } while (0)
    PHASE(2, FFN_MERGED(F.ABUF, F.W1I, F.W1O, F.x_prompt, F.x_sample, F.mada + 2 * 1024, CW_PANEL1, CW_UNIT1); );
    PHASE(3, ; );
#else
    PHASE(2, GEMM_PHASE(EpiSwiGLU<false COMMA FP8_FFN1_OUT != 0>, F.ABUF, F.W1I, NFF, KFI, F.HID, DFF, F.rowq, F.cq1, PROBE_EPI_FLAG); if (CONV_P2TAIL) convert_queue(F, CW_CONVQ, CV_FI, CV_FO + CV_MI); );
    PHASE(3, GEMM_PHASE(EpiResid<false COMMA true COMMA FP8_FFN1_OUT != 0>, F.HID, F.W1O, DM, FP8_FFN1_OUT ? DFF / 2 : DFF, F.x_prompt, F.x_sample, F.out, F.mada + 2 * 1024, nullptr, nullptr, nullptr, nullptr);
             if (CONV_LATE_P3) convert_queue(F, CW_CONVQ + 64, CV_LATE0, CV_LATE_N); );
#endif
    PHASE(4, norm_mod_phase<0>(F, F.out, outS, F.norm_mix, 3, 4); );
    PHASE(5, { Gemm g{F.ABUF, F.WMI, M, NMIX, DM}; StaticOrder S; S.init(M, NMIX, F.G, F.xr * 8 + F.xl); const bool ec = early_chains(F) && !args.pad;
               if (ec) { S.sf = 1; S.sc = cw + CW_SAMP + 64 * F.xl; S.local = 1; }
               typedef pg8::EpiProj<false> EpiT; EpiT E{F.PROJ, F.out + OUT_V, F.lbv, nullptr, nullptr};
               pg8::gemm_phase<EpiT, StaticOrder, PG8_ALIGN, PG8_SP2>(F.lds + RING_OFF, g, S, E);
               if (ec && F.xl >= 6) p5_chains(F, cw);
               if (CONV_P5TAIL && !(ec && F.xl >= 6 && F.xr < 8)) convert_queue(F, CW_CONVQ + 384, CV_LATE0, CV_LATE_N); } );
    PHASE(6, p6_phase(F); );
    PHASE(7, p6b_mixers(F, qrun + args.pad); );
    PHASE(8, p7_combine(F); );
    PHASE(9, GEMM_PHASE(EpiResid<false COMMA false>, F.ABUF2, F.WMO, DM, DM, F.out, outS, F.out, F.mada + 5 * 1024, nullptr, nullptr, nullptr, nullptr);
             if (CONV_P9) convert_queue(F, CW_CONVQ + 192, CV_LATE0 + CV_MO, CV_FI + CV_FO); );
    PHASE(10, norm_mod_phase<FFN_IN_MODE>(F, F.out, outS, F.norm_ffn2, 6, 7); );
#if MERGE_FFN
    PHASE(11, FFN_MERGED(F.ABUF, F.W2I, F.W2O, F.out, outS, F.mada + 8 * 1024, CW_PANEL2, CW_UNIT2); );
    PHASE(12, ; );
#else
    PHASE(11, GEMM_PHASE(EpiSwiGLU<false COMMA FP8_FFN2_OUT != 0>, F.ABUF, F.W2I, NFF, KFI, F.HID, DFF, F.rowq, F.cq2, 0); );
    PHASE(12, GEMM_PHASE(EpiResid<false COMMA true COMMA FP8_FFN2_OUT != 0>, F.HID, F.W2O, DM, FP8_FFN2_OUT ? DFF / 2 : DFF, F.out, outS, F.out, F.mada + 8 * 1024, nullptr, nullptr, nullptr, nullptr); );
#endif
#endif
#ifdef PROBE_XBAR
#pragma unroll 1
    for (int i = 0; i < PROBE_XBAR; ++i) xcd_barrier(bar);
#endif
#undef IN
#undef SEAM
#undef PHASE
#undef GEMM_PHASE
}

extern "C" void kernel_launch(void* const* d_in, const int* in_sizes, int n_in, void* d_out, int out_size, void* d_ws, size_t ws_size, hipStream_t stream) {
    static int grid = 0;
    if (grid == 0) {
        if (n_in != 24 || in_sizes[0] != M_P * DM || in_sizes[1] != M_S * DM || (size_t)out_size != OUT_END || ws_size < WS_END) {
            fprintf(stderr, "kernel_launch: unexpected shapes (n_in %d, out %d, ws %zu); nothing launched\n", n_in, out_size, ws_size); grid = -1; return; }
        int dev = 0, cus = 0, per_cu = 0;
        if (hipGetDevice(&dev) != hipSuccess || hipDeviceGetAttribute(&cus, hipDeviceAttributeMultiprocessorCount, dev) != hipSuccess) { grid = -1; return; }
        if (hipFuncSetAttribute((const void*)hymba_fwd, hipFuncAttributeMaxDynamicSharedMemorySize, LDS_BYTES) != hipSuccess) { fprintf(stderr, "kernel_launch: hipFuncSetAttribute failed\n"); grid = -1; return; }
        if (hipOccupancyMaxActiveBlocksPerMultiprocessor(&per_cu, (const void*)hymba_fwd, NWAVES * 64, LDS_BYTES) != hipSuccess || per_cu < 1) {
            fprintf(stderr, "kernel_launch: occupancy query reports %d workgroups per CU; nothing launched\n", per_cu); (void)hipGetLastError(); grid = -1; return; }
        grid = cus;
        if (grid % 8 != 0) grid -= grid % 8;
        if (MERGE_FFN && grid != 256) { fprintf(stderr, "kernel_launch: this build needs a 256-CU device (got %d workgroups); nothing launched\n", grid); grid = -1; return; }
    }
    if (grid < 0) return;
    if (hipMemsetAsync((char*)d_ws + WS_CTL, 0, CTL_ZERO_BYTES, stream) != hipSuccess) return;
    Args a{};
    for (int i = 0; i < 24; ++i) a.in[i] = (const float*)d_in[i];
    a.out = (float*)d_out; a.ws = (unsigned char*)d_ws;
#if MK_ONE_LAUNCH
    a.ph_lo = 0; a.ph_hi = N_PHASES; a.use_bar = 1;
    hipLaunchKernelGGL(hymba_fwd, dim3(grid), dim3(NWAVES * 64), LDS_BYTES, stream, a);
#ifdef PROBE_RELAUNCH
    a.ph_lo = PROBE_RELAUNCH; a.ph_hi = PROBE_RELAUNCH + 1; a.use_bar = 0; a.pad = 1;
    hipLaunchKernelGGL(hymba_fwd, dim3(grid), dim3(NWAVES * 64), LDS_BYTES, stream, a);
#endif
#else
    for (int p = 0; p < N_PHASES; ++p) { a.ph_lo = p; a.ph_hi = p + 1; a.use_bar = 0; hipLaunchKernelGGL(hymba_fwd, dim3(grid), dim3(NWAVES * 64), LDS_BYTES, stream, a); }
#endif
}
```

```cpp
#include <hip/hip_runtime.h>
#include <cstdio>
#include <cstdint>
#define MK_ONE_LAUNCH 1
#define PROBE_DUP 0u
#define FP8_FFN1_OUT 1
#define FP8_FFN2_OUT 1
#define TALL_FI 0
#ifndef FFN_IN_MODE
#define FFN_IN_MODE 2
#endif
#ifndef TALL_TILES
#define TALL_TILES 1
#endif
#ifndef TALL_FI
#define TALL_FI TALL_TILES
#endif
#ifndef TALL_FO
#define TALL_FO TALL_TILES
#endif
#ifndef TALL_MI
#define TALL_MI TALL_TILES
#endif
#ifndef TALL_MO
#define TALL_MO TALL_TILES
#endif
#define FP8_FFN_IN (FFN_IN_MODE == 1)
#define I8_FFN_IN (FFN_IN_MODE == 2)
#ifndef FP8_FFN1_OUT
#define FP8_FFN1_OUT 0
#endif
#ifndef FP8_FFN2_OUT
#define FP8_FFN2_OUT 0
#endif
constexpr float F8_SA = 8.0f, F8_SW = 128.0f, F8_ACC = 1.0f / (F8_SA * F8_SW);
__device__ __forceinline__ float f8_clamp(float x) { return __builtin_fminf(__builtin_fmaxf(x, -448.0f), 448.0f); }
__device__ __forceinline__ unsigned pk4_f8(float a, float b, float c, float d) { int w = 0; w = __builtin_amdgcn_cvt_pk_fp8_f32(f8_clamp(a), f8_clamp(b), w, false); w = __builtin_amdgcn_cvt_pk_fp8_f32(f8_clamp(c), f8_clamp(d), w, true); return (unsigned)w; }
__device__ __forceinline__ unsigned pk4_i8(float a, float b, float c, float d) {
    const unsigned ua = __builtin_bit_cast(unsigned, a + 12582912.0f), ub = __builtin_bit_cast(unsigned, b + 12582912.0f), uc = __builtin_bit_cast(unsigned, c + 12582912.0f), ud = __builtin_bit_cast(unsigned, d + 12582912.0f);
    const unsigned lo = __builtin_amdgcn_perm(ub, ua, 0x0c0c0400u), hi = __builtin_amdgcn_perm(ud, uc, 0x0c0c0400u);
    return __builtin_amdgcn_perm(hi, lo, 0x05040100u);
}
namespace pg8 {
#define PG8_LAS __attribute__((address_space(3)))
typedef unsigned short bf16_t;
typedef short bf16x8 __attribute__((ext_vector_type(8)));
typedef float f32x4 __attribute__((ext_vector_type(4)));
typedef unsigned u32x4 __attribute__((ext_vector_type(4)));
constexpr int BM = 256, BK = 64, HALF = 128, HTB = HALF * BK * 2  , STAGE_BYTES = 8 * HTB, NXCD = 8, WGM = 5;

__host__ __device__ __forceinline__ int lds_byte(int r, int c) { const int st = (r >> 4) * 2 + (c >> 5), rr = r & 15, cc = c & 31, ob = rr * 64 + cc * 2; return st * 1024 + (ob ^ (((ob >> 9) & 1) << 5)); }
__host__ __device__ __forceinline__ void stage_rc(int b, int& R, int& C) { const int st = b / 1024, sb = b % 1024, swz = sb ^ (((sb >> 9) & 1) << 5); R = (st >> 1) * 16 + swz / 64; C = (st & 1) * 32 + (swz % 64) / 2; }
__host__ __device__ __forceinline__ int perm32(int rho) { const int n = rho >> 4, i = rho & 15; return 8 * (i >> 2) + 4 * n + (i & 3); }

struct Unit { int pm, pn, k0, nk, kq; };
__host__ __device__ __forceinline__ int pmap(int t) { if (TALL_TILES) return t; const unsigned q = (unsigned)(t - 30); return q <= 5u ? t + (int)((0x055554u >> (4u * q)) & 15u) - 4 : t; }
__device__ __forceinline__ void publish_wave(unsigned* cnt, int local);
constexpr int TROWS = 160;
template <bool TALL> __device__ __forceinline__ int tile_row(int pm, int wr, int fr, int ai, int m) { return TALL ? pm * TROWS + (ai ? HALF + 16 * wr : 64 * wr + 16 * m) + fr : pm * BM + ai * HALF + wr * 64 + m * 16 + fr; }
#define PG8_ROWSKIP(TALL, ai, m) ((TALL) && (ai) == 1 && (m) > 0)
__device__ __forceinline__ int row_cond(int row) { return row < 8192 ? 0 : 1 + ((row - 8192) >> 10); }
struct Gemm { const bf16_t* A; const bf16_t* Bt; int M, N, K; int bmul = 1, amul = 1; };

struct StaticOrder {
    int nM, nN, nwg, G, c;
    int sf = 0; unsigned* sc = nullptr; int local = 0;
    __host__ __device__ void init(int M, int N, int G_, int c_) { nM = M / BM; nN = N / BM; nwg = nM * nN; G = G_; c = c_; }
    __host__ __device__ bool next(int i, Unit& u) const {
        int pm, pn, kq = 0; bool ok;
        if (sf && (c & 7) >= 6) {
            const int x = c & 7, r = c >> 3;
            const int j = (r < 8 || i == 0) ? r + 32 * i : 40 + (r - 8) + 24 * (i - 1);
            ok = (r < 8) ? (i < 2) : (i <= 2 && j < 80);
            const int jj = j - 40, j2 = jj - 16;
            const int p = j < 40 ? 1 + (j & 3) : (jj < 16 ? 0 : 1 + (j2 & 3));
            pn = j < 40 ? (j >> 2) : (jj < 16 ? jj : 10 + (j2 >> 2)); pm = pmap(5 * x + p); kq = j < 40 ? 9 : 0;
        } else {
            const long L = (long)i * G + c; ok = L < nwg;
            int wgid = ok ? (int)L : 0; { const int q = nwg / NXCD, r = nwg % NXCD, xcd = wgid % NXCD, off = wgid / NXCD; wgid = (xcd < r ? xcd * (q + 1) : r * (q + 1) + (xcd - r) * q) + off; }
            const int nig = WGM * nN, gid = wgid / nig, fm = gid * WGM, gsz = (nM - fm) < WGM ? (nM - fm) : WGM;
            pm = pmap(fm + ((wgid % nig) % gsz)); pn = (wgid % nig) / gsz;
        }
        u.pm = pm; u.pn = pn; u.k0 = 0; u.nk = 0; u.kq = kq; return ok;
    }
    __device__ __forceinline__ void a_ready(const Unit&) const {}
    __device__ __forceinline__ void done(const Unit& u) const { if (sf && u.kq == 9) publish_wave(sc, local); }
};
struct TallOrder {
    int nN, nwg, G, c;
    __host__ __device__ void init(int M, int N, int G_, int c_) { nN = N / BM; nwg = (M / TROWS) * nN; G = G_; c = c_; }
    __host__ __device__ bool next(int i, Unit& u) const { const long L = (long)i * G + c; const bool ok = L < nwg; const int l = ok ? (int)L : 0, x = l % NXCD, r = l / NXCD;
        u.pm = 8 * x + (r & 7); u.pn = r >> 3; u.k0 = 0; u.nk = 0; u.kq = 0; return ok; }
    __device__ __forceinline__ void a_ready(const Unit&) const {}
    __device__ __forceinline__ void done(const Unit&) const {}
};
template <bool TALL> struct OrderSel { typedef StaticOrder type; };
template <> struct OrderSel<true> { typedef TallOrder type; };


__device__ __forceinline__ unsigned cvt_pk_bf16(float lo, float hi) { unsigned r; asm volatile("v_cvt_pk_bf16_f32 %0, %1, %2" : "=v"(r) : "v"(lo), "v"(hi)); return r; }
#ifndef EPI_SC1
#define EPI_SC1 0
#endif
__device__ __forceinline__ void store16(void* p, u32x4 v) {
#if EPI_SC1
    asm volatile("global_store_dwordx4 %0, %1, off sc1\n\ts_nop 1" :: "v"(p), "v"(v) : "memory");
#else
    *(u32x4*)p = v;
#endif
}
__device__ __forceinline__ void store16f(void* p, f32x4 v) { store16(p, __builtin_bit_cast(u32x4, v)); }
__device__ __forceinline__ float silu_f(float g) { return g * __builtin_amdgcn_rcpf(1.0f + __builtin_amdgcn_exp2f(-1.4426950408889634f * g)); }

__device__ __forceinline__ float row_rstd(const float* rowss, int row) {
    const f32x4* p = (const f32x4*)(rowss + (size_t)row * 16); const f32x4 a = p[0], b = p[1], c = p[2], d = p[3];
    const float s = ((a[0] + a[1]) + (a[2] + a[3])) + ((b[0] + b[1]) + (b[2] + b[3])) + ((c[0] + c[1]) + (c[2] + c[3])) + ((d[0] + d[1]) + (d[2] + d[3]));
    return 1.0f / sqrtf(s * (1.0f / 1024.0f) + 1e-6f);
}
template <bool RS, bool H8 = false, bool TALL_ = false> struct EpiSwiGLU {
    static_assert(!(RS && TALL_), "160-row units: no per-unit condition");
    static constexpr bool PERM = true, AFTER_DRAIN = false, TALL = TALL_, F8 = FP8_FFN_IN && !RS, I8 = I8_FFN_IN && !RS;
    bf16_t* H; int ldh; const float* rowss; const float* bias2; int ldb2;
    __device__ __forceinline__ void operator()(const f32x4 (&acc)[2][2][4][2], const Unit& u, int wr, int wc, int fr, int fq) const {
        const int row0 = u.pm * BM + wr * 64 + fr, col0 = u.pn * HALF + wc * 32 + 8 * fq;
        const int cond = u.pm < 32 ? 0 : 1 + ((u.pm - 32) >> 2);
        f32x4 bz[2][2];
#pragma unroll
        for (int bj = 0; bj < 2; ++bj)
#pragma unroll
            for (int n = 0; n < 2; ++n) { bz[bj][n] = (f32x4){0.f, 0.f, 0.f, 0.f}; if constexpr (RS) bz[bj][n] = *(const f32x4*)(bias2 + (size_t)cond * ldb2 + u.pn * BM + bj * HALF + wc * 32 + 8 * fq + 4 * n);
                if constexpr (I8) bz[bj][n] = *(const f32x4*)(bias2 + u.pn * BM + bj * HALF + wc * 32 + 8 * fq + 4 * n); }
        float rqv[2][4];
#pragma unroll
        for (int ai = 0; ai < 2; ++ai)
#pragma unroll
            for (int m = 0; m < 4; ++m) { rqv[ai][m] = 1.0f; if constexpr (I8) { if (!PG8_ROWSKIP(TALL, ai, m)) rqv[ai][m] = rowss[tile_row<TALL>(u.pm, wr, fr, ai, m)]; } }
#pragma unroll
        for (int ai = 0; ai < 2; ++ai)
#pragma unroll
            for (int m = 0; m < 4; ++m) { if (PG8_ROWSKIP(TALL, ai, m)) continue; const int row = tile_row<TALL>(u.pm, wr, fr, ai, m); bf16_t* rowp = H + (size_t)row * ldh + col0;
                float rs = F8 ? F8_ACC : 1.0f; if constexpr (RS) rs = row_rstd(rowss, row);
                f32x4 g0, g1, u0, u1;
                if constexpr (I8) { typedef int i32x4_t __attribute__((ext_vector_type(4))); const float rq = rqv[ai][m];
                    g0 = __builtin_convertvector(__builtin_bit_cast(i32x4_t, acc[ai][0][m][0]), f32x4) * rq * bz[0][0]; g1 = __builtin_convertvector(__builtin_bit_cast(i32x4_t, acc[ai][0][m][1]), f32x4) * rq * bz[0][1];
                    u0 = __builtin_convertvector(__builtin_bit_cast(i32x4_t, acc[ai][1][m][0]), f32x4) * rq * bz[1][0]; u1 = __builtin_convertvector(__builtin_bit_cast(i32x4_t, acc[ai][1][m][1]), f32x4) * rq * bz[1][1]; }
                else { g0 = acc[ai][0][m][0] * rs + bz[0][0]; g1 = acc[ai][0][m][1] * rs + bz[0][1]; u0 = acc[ai][1][m][0] * rs + bz[1][0]; u1 = acc[ai][1][m][1] * rs + bz[1][1]; }
                u32x4 w;
#ifdef PROBE_EPI
                if (ldb2) { w.x = cvt_pk_bf16(g0[0] * u0[0], g0[1] * u0[1]); w.y = cvt_pk_bf16(g0[2] * u0[2], g0[3] * u0[3]); w.z = cvt_pk_bf16(g1[0] * u1[0], g1[1] * u1[1]); w.w = cvt_pk_bf16(g1[2] * u1[2], g1[3] * u1[3]); store16(rowp, w); continue; }
#endif
                if constexpr (H8) { typedef unsigned u32x2 __attribute__((ext_vector_type(2))); const f32x4 h0 = {silu_f(g0[0]) * u0[0], silu_f(g0[1]) * u0[1], silu_f(g0[2]) * u0[2], silu_f(g0[3]) * u0[3]}, h1 = {silu_f(g1[0]) * u1[0], silu_f(g1[1]) * u1[1], silu_f(g1[2]) * u1[2], silu_f(g1[3]) * u1[3]};
                    *(u32x2*)((unsigned char*)H + (size_t)row * ldh + col0) = (u32x2){pk4_f8(h0[0] * F8_SA, h0[1] * F8_SA, h0[2] * F8_SA, h0[3] * F8_SA), pk4_f8(h1[0] * F8_SA, h1[1] * F8_SA, h1[2] * F8_SA, h1[3] * F8_SA)}; continue; }
                w.x = cvt_pk_bf16(silu_f(g0[0]) * u0[0], silu_f(g0[1]) * u0[1]); w.y = cvt_pk_bf16(silu_f(g0[2]) * u0[2], silu_f(g0[3]) * u0[3]);
                w.z = cvt_pk_bf16(silu_f(g1[0]) * u1[0], silu_f(g1[1]) * u1[1]); w.w = cvt_pk_bf16(silu_f(g1[2]) * u1[2], silu_f(g1[3]) * u1[3]);
                store16(rowp, w); }
    }
};

template <bool NXT, bool HALFG, bool F8_ = false, bool TALL_ = false> struct EpiResid {
    static constexpr bool PERM = false, AFTER_DRAIN = false, F8 = F8_, I8 = false, TALL = TALL_;
    static_assert(!(TALL_ && NXT), "160-row units: plain residual epilogue only");
    static_assert(!(F8_ && NXT), "fp8 operands: plain residual epilogue only");
    const float* base0; const float* base1; float* out; const float* gate;
    bf16_t* nxtA; const float* nw; const float* sc; float* rowss;
    __device__ __forceinline__ void operator()(const f32x4 (&acc)[2][2][4][2], const Unit& u, int wr, int wc, int fr, int fq) const {
        const int row0 = u.pm * BM + wr * 64 + fr, col0 = u.pn * BM + wc * 32 + 4 * fq;
        const int cond = u.pm < 32 ? 0 : 1 + ((u.pm - 32) >> 2);
        const float* bp = u.pm < 32 ? base0 : base1 - (size_t)8192 * 1024;
        if constexpr (!NXT && TALL_) {
            constexpr float gsl = (HALFG ? 0.5f : 1.0f) * (F8_ ? F8_ACC : 1.0f);
            const int c_lo = row_cond(u.pm * TROWS), c_hi = row_cond(u.pm * TROWS + TROWS - 1);
            if (c_lo == c_hi) {
                const float* bpt = c_lo == 0 ? base0 : base1 - (size_t)8192 * 1024;
                f32x4 gv[2][2];
#pragma unroll
                for (int bj = 0; bj < 2; ++bj)
#pragma unroll
                    for (int n = 0; n < 2; ++n) gv[bj][n] = *(const f32x4*)(gate + c_lo * 9216 + col0 + bj * HALF + n * 16) * gsl;
#pragma unroll
                for (int ai = 0; ai < 2; ++ai)
#pragma unroll
                    for (int m = 0; m < 4; ++m) { if (PG8_ROWSKIP(true, ai, m)) continue; const size_t off = (size_t)tile_row<true>(u.pm, wr, fr, ai, m) * 1024 + col0;
#pragma unroll
                        for (int bj = 0; bj < 2; ++bj)
#pragma unroll
                            for (int n = 0; n < 2; ++n) { const f32x4 b = *(const f32x4*)(bpt + off + bj * HALF + n * 16); store16f(out + off + bj * HALF + n * 16, b + gv[bj][n] * acc[ai][bj][m][n]); } }
            } else {
#pragma unroll
                for (int ai = 0; ai < 2; ++ai)
#pragma unroll
                    for (int m = 0; m < 4; ++m) { if (PG8_ROWSKIP(true, ai, m)) continue; const int row = tile_row<true>(u.pm, wr, fr, ai, m), cr = row_cond(row); const size_t off = (size_t)row * 1024 + col0;
                        const float* bpt = cr == 0 ? base0 : base1 - (size_t)8192 * 1024;
#pragma unroll
                        for (int bj = 0; bj < 2; ++bj)
#pragma unroll
                            for (int n = 0; n < 2; ++n) { const f32x4 gvr = *(const f32x4*)(gate + cr * 9216 + col0 + bj * HALF + n * 16) * gsl; const f32x4 b = *(const f32x4*)(bpt + off + bj * HALF + n * 16);
                                store16f(out + off + bj * HALF + n * 16, b + gvr * acc[ai][bj][m][n]); } }
            }
            return;
        }
        if constexpr (!NXT) {
            constexpr float gsl = (HALFG ? 0.5f : 1.0f) * (F8_ ? F8_ACC : 1.0f);
            f32x4 gv[2][2];
#pragma unroll
            for (int bj = 0; bj < 2; ++bj)
#pragma unroll
                for (int n = 0; n < 2; ++n) gv[bj][n] = *(const f32x4*)(gate + cond * 9216 + col0 + bj * HALF + n * 16) * gsl;
#pragma unroll
            for (int ai = 0; ai < 2; ++ai)
#pragma unroll
                for (int m = 0; m < 4; ++m) { const size_t off = (size_t)(row0 + ai * HALF + m * 16) * 1024 + col0;
#pragma unroll
                    for (int bj = 0; bj < 2; ++bj)
#pragma unroll
                        for (int n = 0; n < 2; ++n) { const f32x4 b = *(const f32x4*)(bp + off + bj * HALF + n * 16); store16f(out + off + bj * HALF + n * 16, b + gv[bj][n] * acc[ai][bj][m][n]); } }
            return;
        }
        float ss[2][4];
#pragma unroll
        for (int ai = 0; ai < 2; ++ai)
#pragma unroll
            for (int m = 0; m < 4; ++m) ss[ai][m] = 0.f;
#pragma unroll
        for (int bj = 0; bj < 2; ++bj)
#pragma unroll
            for (int n = 0; n < 2; ++n) { const int c = col0 + bj * HALF + n * 16; constexpr float gsl = HALFG ? 0.5f : 1.0f; const f32x4 gv = *(const f32x4*)(gate + cond * 9216 + c) * gsl;
                f32x4 av = {0.f, 0.f, 0.f, 0.f}; if constexpr (NXT) av = *(const f32x4*)(nw + c) * (*(const f32x4*)(sc + cond * 9216 + c) + 1.0f);
#pragma unroll
                for (int ai = 0; ai < 2; ++ai)
#pragma unroll
                    for (int m = 0; m < 4; ++m) { const size_t off = (size_t)(row0 + ai * HALF + m * 16) * 1024 + c; const f32x4 b = *(const f32x4*)(bp + off); const f32x4 o = b + gv * acc[ai][bj][m][n];
                        *(f32x4*)(out + off) = o;
                        if constexpr (NXT) { ss[ai][m] += (o[0] * o[0] + o[1] * o[1]) + (o[2] * o[2] + o[3] * o[3]); const f32x4 a = o * av;
                            typedef unsigned u32x2 __attribute__((ext_vector_type(2))); *(u32x2*)(nxtA + off) = (u32x2){cvt_pk_bf16(a[0], a[1]), cvt_pk_bf16(a[2], a[3])}; } } }
        if constexpr (NXT) {
#pragma unroll
            for (int ai = 0; ai < 2; ++ai)
#pragma unroll
                for (int m = 0; m < 4; ++m) { float s = ss[ai][m]; s += __shfl_xor(s, 16); s += __shfl_xor(s, 32); if (fq == 0) rowss[(size_t)(row0 + ai * HALF + m * 16) * 16 + u.pn * 4 + wc] = s; } }
    }
};

typedef _Float16 h2_t __attribute__((ext_vector_type(2)));
__device__ __forceinline__ unsigned pkh2(float lo, float hi) { const h2_t h = {(_Float16)lo, (_Float16)hi}; return __builtin_bit_cast(unsigned, h); }
__device__ __forceinline__ float logf_gate(float x, float lb) { const float sg = __builtin_amdgcn_rcpf(1.0f + __builtin_amdgcn_exp2f(-1.4426950408889634f * x)); return 0.6931471805599453f * __builtin_amdgcn_logf(lb + (1.0f - lb) * sg); }
template <bool RS, bool TALL_ = false> struct EpiProj {
    static_assert(!(RS && TALL_), "160-row units: no per-unit condition");
    static constexpr bool PERM = true, AFTER_DRAIN = false, F8 = false, I8 = false, TALL = TALL_;
    bf16_t* P; float* outv; const float* lbv; const float* rowss; const float* bias2;
    __device__ __forceinline__ void operator()(const f32x4 (&acc)[2][2][4][2], const Unit& u, int wr, int wc, int fr, int fq) const {
        const int row0 = u.pm * BM + wr * 64 + fr, col0 = u.pn * BM + wc * 32 + 8 * fq;
        const bool wv = (u.pn >= 14) && (TALL ? u.pm * TROWS < 8192 : u.pm < 32), gate = (u.pn >= 4) && (u.pn < 8);
        const int cond = u.pm < 32 ? 0 : 1 + ((u.pm - 32) >> 2);
        f32x4 lb[2][2], bz[2][2];
#pragma unroll
        for (int bj = 0; bj < 2; ++bj)
#pragma unroll
            for (int n = 0; n < 2; ++n) { lb[bj][n] = gate ? *(const f32x4*)(lbv + ((col0 + bj * HALF + 4 * n) & 511)) : (f32x4){0.f, 0.f, 0.f, 0.f}; bz[bj][n] = (f32x4){0.f, 0.f, 0.f, 0.f}; if constexpr (RS) bz[bj][n] = *(const f32x4*)(bias2 + cond * 4096 + col0 + bj * HALF + 4 * n); }
#pragma unroll
        for (int ai = 0; ai < 2; ++ai)
#pragma unroll
            for (int m = 0; m < 4; ++m) { if (PG8_ROWSKIP(TALL, ai, m)) continue; const int row = tile_row<TALL>(u.pm, wr, fr, ai, m); bf16_t* rowp = P + (size_t)row * 4096 + col0; float rs = 1.0f; if constexpr (RS) rs = row_rstd(rowss, row);
#pragma unroll
                for (int bj = 0; bj < 2; ++bj) { const f32x4 v0 = acc[ai][bj][m][0] * rs + bz[bj][0], v1 = acc[ai][bj][m][1] * rs + bz[bj][1]; u32x4 w;
                    if (gate) { const f32x4 l0 = lb[bj][0], l1 = lb[bj][1];
                        w.x = pkh2(logf_gate(v0[0], l0[0]), logf_gate(v0[1], l0[1])); w.y = pkh2(logf_gate(v0[2], l0[2]), logf_gate(v0[3], l0[3]));
                        w.z = pkh2(logf_gate(v1[0], l1[0]), logf_gate(v1[1], l1[1])); w.w = pkh2(logf_gate(v1[2], l1[2]), logf_gate(v1[3], l1[3])); }
                    else { w.x = cvt_pk_bf16(v0[0], v0[1]); w.y = cvt_pk_bf16(v0[2], v0[3]); w.z = cvt_pk_bf16(v1[0], v1[1]); w.w = cvt_pk_bf16(v1[2], v1[3]); }
                    store16(rowp + bj * HALF, w);
                    if (wv && (!TALL || row < 8192)) { float* ov = outv + (size_t)row * 512 + (col0 + bj * HALF - 3584); *(f32x4*)ov = v0; *(f32x4*)(ov + 4) = v1; } } }
    }
};

__device__ __forceinline__ void publish_wave(unsigned* cnt, int local) {
    asm volatile("s_waitcnt vmcnt(0)" ::: "memory");
    if (!local) { __builtin_amdgcn_fence(__ATOMIC_RELEASE, "agent"); asm volatile("s_waitcnt vmcnt(0)" ::: "memory"); }
    if ((threadIdx.x & 63) == 0) (void)__hip_atomic_fetch_add(cnt, 1u, __ATOMIC_RELAXED, __HIP_MEMORY_SCOPE_AGENT);
}
__device__ __forceinline__ void wait_counter_wave(unsigned* cnt, unsigned need) {
    unsigned sp = 0;
    while ((unsigned)__builtin_amdgcn_readfirstlane(__hip_atomic_load(cnt, __ATOMIC_RELAXED, __HIP_MEMORY_SCOPE_AGENT)) < need) { __builtin_amdgcn_s_sleep(2); if (++sp > (1u << 22)) break; }
    __builtin_amdgcn_fence(__ATOMIC_ACQUIRE, "agent"); asm volatile("s_waitcnt vmcnt(0)" ::: "memory");
}
__device__ __forceinline__ void wait_counter_wg(unsigned* cnt, unsigned need) {
    if (threadIdx.x < 64) wait_counter_wave(cnt, need);
    asm volatile("" ::: "memory"); __builtin_amdgcn_s_barrier(); asm volatile("" ::: "memory");
}
struct XccInOrder {
    int x, r; unsigned* pc; int local;
    __device__ __forceinline__ bool next(int i, Unit& u) const { const int j = i * 32 + r; if (j >= 110) return false; u.k0 = 0; u.nk = 0; u.kq = 0;
        if (j < 88) { u.pm = 5 * x + (j & 3); u.pn = j >> 2; } else { u.pm = 5 * x + 4; u.pn = j - 88; } return true; }
    __device__ __forceinline__ void a_ready(const Unit&) const {}
    __device__ __forceinline__ void done(const Unit& u) const {
        const int j = (u.pm == 5 * x + 4) ? 88 + u.pn : 4 * u.pn + (u.pm - 5 * x), i = (j - r) >> 5;
        if (i == 0) return;
        Unit p; next(i - 1, p);
        const bool lane0 = (threadIdx.x & 63) == 0;
        if (i == 1) { if (local) { if (lane0) (void)__hip_atomic_fetch_add(pc + 16 * p.pm, 1u, __ATOMIC_RELAXED, __HIP_MEMORY_SCOPE_AGENT); } else publish_wave(pc + 16 * p.pm, 0); return; }
        publish_wave(pc + 16 * u.pm, local);
        if (i == 2 && lane0) (void)__hip_atomic_fetch_add(pc + 16 * p.pm, 1u, __ATOMIC_RELAXED, __HIP_MEMORY_SCOPE_AGENT);
    }
};
struct XccOutOrder {
    int x, r; unsigned* pc;
    __device__ __forceinline__ bool next(int i, Unit& u) const { if (i > 0) return false;
        if (r >= 14 && r < 30) { const int q = r - 14; u.pm = 5 * x + (q >> 2); u.pn = q & 3; u.k0 = 0; u.nk = 0; u.kq = 0; }
        else { const int s = r < 14 ? r : r - 16, kq = s & 3; u.pm = 5 * x + 4; u.pn = s >> 2; u.kq = 1 + kq;
               const int it0 = kq == 0 ? 0 : kq == 1 ? 6 : kq == 2 ? 12 : 17, nit = kq < 2 ? 6 : 5; u.k0 = 2 * it0; u.nk = 2 * nit; }
        return true; }
    __device__ __forceinline__ void a_ready(const Unit& u) const { wait_counter_wg(pc + 16 * u.pm, 22u * 8u); }
    __device__ __forceinline__ void done(const Unit&) const {}
};
template <bool HALFG> struct EpiResidSplit {
    static constexpr bool PERM = false, AFTER_DRAIN = false, F8 = false, I8 = false;
    const float* base0; const float* base1; float* out; const float* gate; float* slab; unsigned* uc; int x; int local;
    __device__ __forceinline__ void operator()(f32x4 (&acc)[2][2][4][2], const Unit& u, int wr, int wc, int fr, int fq) const {
        const int tid = threadIdx.x;
        if (u.kq >= 1 && u.kq <= 3) {
            f32x4* s = (f32x4*)(slab + (size_t)((x * 4 + u.pn) * 3 + (u.kq - 1)) * (32 * 512 * 4)) + tid;
#pragma unroll
            for (int ai = 0; ai < 2; ++ai)
#pragma unroll
                for (int bj = 0; bj < 2; ++bj) {
#pragma unroll
                    for (int m = 0; m < 4; ++m)
#pragma unroll
                        for (int n = 0; n < 2; ++n) s[(m * 2 + n) * 512] = acc[ai][bj][m][n];
                    s += 8 * 512; asm volatile("" : "+v"(s) :: "memory"); }
            publish_wave(uc + 16 * (x * 4 + u.pn), local);
            return;
        }
        const bool owner = u.kq == 4;
        const f32x4* sp = (const f32x4*)(slab + (size_t)((x * 4 + u.pn) * 3) * (32 * 512 * 4)) + tid;
        if (owner) wait_counter_wave(uc + 16 * (x * 4 + u.pn), 24u);
        const int row0 = u.pm * BM + wr * 64 + fr, col0 = u.pn * BM + wc * 32 + 4 * fq;
        const int cond = u.pm < 32 ? 0 : 1 + ((u.pm - 32) >> 2);
        const float* bp = u.pm < 32 ? base0 : base1 - (size_t)8192 * 1024;
        constexpr float gsl = HALFG ? 0.5f : 1.0f;
        f32x4 gv[2][2];
#pragma unroll
        for (int bj = 0; bj < 2; ++bj)
#pragma unroll
            for (int n = 0; n < 2; ++n) gv[bj][n] = *(const f32x4*)(gate + cond * 9216 + col0 + bj * HALF + n * 16) * gsl;
#pragma unroll
        for (int ai = 0; ai < 2; ++ai)
#pragma unroll
            for (int m = 0; m < 4; ++m) { const size_t off = (size_t)(row0 + ai * HALF + m * 16) * 1024 + col0;
#pragma unroll
                for (int bj = 0; bj < 2; ++bj)
#pragma unroll
                    for (int n = 0; n < 2; ++n) { f32x4 a = acc[ai][bj][m][n];
                        if (owner) { const f32x4* s = sp + (((ai * 2 + bj) * 4 + m) * 2 + n) * 512; a += (s[0] + s[32 * 512]) + s[2 * 32 * 512]; }
                        const f32x4 b = *(const f32x4*)(bp + off + bj * HALF + n * 16); *(f32x4*)(out + off + bj * HALF + n * 16) = b + gv[bj][n] * a; }
                asm volatile("" ::: "memory"); }
    }
};
typedef int i32x8 __attribute__((ext_vector_type(8)));
typedef int i32x4 __attribute__((ext_vector_type(4)));
__device__ __forceinline__ i32x8 pg8_ld8(const PG8_LAS unsigned char* p) { const i32x4 lo = *(const PG8_LAS i32x4*)p, hi = *(const PG8_LAS i32x4*)(p + 1024); return __builtin_shufflevector(lo, hi, 0, 1, 2, 3, 4, 5, 6, 7); }
__device__ __forceinline__ void pg8_mfma_f8(f32x4& c, const i32x8& a, const i32x8& b) { asm("v_mfma_f32_16x16x128_f8f6f4 %0, %1, %2, %0" : "+v"(c) : "v"(a), "v"(b)); }
template <class Epi, class Sched, bool ALIGN_EPI = false, bool SP2 = false>
__device__ __forceinline__ void gemm_phase(PG8_LAS unsigned char* lds, const Gemm g, const Sched& S, const Epi& E) {
    const int tid = threadIdx.x, wid = __builtin_amdgcn_readfirstlane(tid >> 6), lane = tid & 63, wr = wid >> 2, wc = wid & 3, fr = lane & 15, fq = lane >> 4;
    const int K = g.K, nt = K / BK;
    unsigned voffA[2], voffB[2];
#pragma unroll
    for (int i = 0; i < 2; ++i) { int R, C; stage_rc(tid * 16 + i * 8192, R, C); const int Rb = Epi::PERM ? ((R & ~31) + perm32(R & 31)) : R;
        voffA[i] = (unsigned)(R * K + C) * 2u; voffB[i] = (unsigned)(Rb * K + C) * 2u; }
    const size_t kstep = (size_t)(BK * 2);
    const size_t hstep = (size_t)HALF * K * 2;
    const size_t tstep = 2 * hstep;
    const size_t tstepA = Epi::TALL ? (size_t)TROWS * K * 2 : tstep;
    const unsigned ldsw = (unsigned)wid * 1024u;
    const int aoff = lds_byte(wr * 64 + fr, fq * 8), boff = lds_byte(wc * 32 + fr, fq * 8);
    const int aoff1 = Epi::TALL ? lds_byte(wr * 16 + fr, fq * 8) : aoff;
#define PG8_SA(b, h) (((b) * 2 + (h)) * HTB)
#define PG8_SB(b, h) ((4 + (b) * 2 + (h)) * HTB)
#define PG8_STAGE(bufoff, gbase, voff) do { _Pragma("unroll") for (int _i = 0; _i < 2; ++_i) \
        __builtin_amdgcn_global_load_lds((const unsigned*)((const char*)(gbase) + (voff)[_i]), (PG8_LAS unsigned*)(lds + (bufoff) + ldsw + _i * 8192), 16, 0, 0); } while (0)
#define PG8_LDA(dst, b, h) do { if constexpr (Epi::TALL && (h) == 1) { if constexpr (Epi::F8) dst##8[0] = pg8_ld8(lds + PG8_SA(b, h) + aoff1); else { _Pragma("unroll") for (int k = 0; k < 2; ++k) dst[0][k] = *(const PG8_LAS bf16x8*)(lds + PG8_SA(b, h) + aoff1 + k * 1024); } } \
        else if constexpr (Epi::F8) { _Pragma("unroll") for (int m = 0; m < 4; ++m) dst##8[m] = pg8_ld8(lds + PG8_SA(b, h) + aoff + m * 2048); } else { \
        _Pragma("unroll") for (int m = 0; m < 4; ++m) _Pragma("unroll") for (int k = 0; k < 2; ++k) dst[m][k] = *(const PG8_LAS bf16x8*)(lds + PG8_SA(b, h) + aoff + m * 2048 + k * 1024); } } while (0)
#define PG8_LDB(dst, b, h) do { if constexpr (Epi::F8) { _Pragma("unroll") for (int n = 0; n < 2; ++n) dst##8[n] = pg8_ld8(lds + PG8_SB(b, h) + boff + n * 2048); } else { \
        _Pragma("unroll") for (int n = 0; n < 2; ++n) _Pragma("unroll") for (int k = 0; k < 2; ++k) dst[n][k] = *(const PG8_LAS bf16x8*)(lds + PG8_SB(b, h) + boff + n * 2048 + k * 1024); } } while (0)
#define PG8_MMA(ai, bj, At, Bt) do { __builtin_amdgcn_s_setprio(1); _Pragma("unroll") for (int m = 0; m < 4; ++m) _Pragma("unroll") for (int n = 0; n < 2; ++n) { if (PG8_ROWSKIP(Epi::TALL, ai, m)) continue; \
        if constexpr (Epi::F8) { pg8_mfma_f8(acc[ai][bj][m][n], Bt##8[n], At##8[m]); } \
        else if constexpr (Epi::I8) { _Pragma("unroll") for (int k = 0; k < 2; ++k) acc[ai][bj][m][n] = __builtin_bit_cast(f32x4, __builtin_amdgcn_mfma_i32_16x16x64_i8(__builtin_bit_cast(i32x4, Bt[n][k]), __builtin_bit_cast(i32x4, At[m][k]), __builtin_bit_cast(i32x4, acc[ai][bj][m][n]), 0, 0, 0)); } \
        else { _Pragma("unroll") for (int k = 0; k < 2; ++k) acc[ai][bj][m][n] = __builtin_amdgcn_mfma_f32_16x16x32_bf16(Bt[n][k], At[m][k], acc[ai][bj][m][n], 0, 0, 0); } } __builtin_amdgcn_s_setprio(0); } while (0)
#define PG8_WAIT_V(n) asm volatile("s_waitcnt vmcnt(" #n ")" ::: "memory")
#define PG8_WAIT_L(n) asm volatile("s_waitcnt lgkmcnt(" #n ")" ::: "memory")
#define PG8_BAR __builtin_amdgcn_s_barrier()
#define PG8_SCHED __builtin_amdgcn_sched_barrier(0)
    Unit cur, nxt; int ui = 0;
    if (!S.next(0, cur)) return;
    f32x4 acc[2][2][4][2];
#pragma unroll
    for (int a = 0; a < 2; ++a)
#pragma unroll
        for (int b = 0; b < 2; ++b)
#pragma unroll
            for (int m = 0; m < 4; ++m)
#pragma unroll
                for (int n = 0; n < 2; ++n) acc[a][b][m][n] = (f32x4){0.f, 0.f, 0.f, 0.f};
    bf16x8 At[4][2], B0[2][2], B1[2][2];
    i32x8 At8[4], B08[2], B18[2];
    const char* cA = (const char*)g.A + (size_t)(cur.pm * g.amul) * tstepA + (size_t)cur.k0 * kstep; const char* cB = (const char*)g.Bt + (size_t)(cur.pn * g.bmul) * tstep + (size_t)cur.k0 * kstep;
    S.a_ready(cur);
    if constexpr (SP2) {
        PG8_STAGE(PG8_SB(0, 0), cB, voffB); PG8_STAGE(PG8_SB(0, 1), cB + hstep, voffB); PG8_STAGE(PG8_SA(0, 0), cA, voffA); PG8_STAGE(PG8_SA(0, 1), cA + hstep, voffA);
        if (wr == 1) PG8_BAR;
        PG8_WAIT_V(2); PG8_BAR;
        PG8_STAGE(PG8_SB(1, 0), cB + kstep, voffB); PG8_STAGE(PG8_SA(1, 0), cA + kstep, voffA); PG8_STAGE(PG8_SB(1, 1), cB + hstep + kstep, voffB);
        PG8_WAIT_V(6); PG8_BAR;
    } else {
        PG8_STAGE(PG8_SB(0, 0), cB, voffB); PG8_STAGE(PG8_SA(0, 0), cA, voffA); PG8_STAGE(PG8_SB(0, 1), cB + hstep, voffB); PG8_STAGE(PG8_SA(0, 1), cA + hstep, voffA);
        if (wr == 1) PG8_BAR;
        PG8_WAIT_V(4); PG8_BAR;
        PG8_STAGE(PG8_SB(1, 0), cB + kstep, voffB); PG8_STAGE(PG8_SA(1, 0), cA + kstep, voffA); PG8_STAGE(PG8_SB(1, 1), cB + hstep + kstep, voffB);
        PG8_WAIT_V(6); PG8_BAR;
    }
    for (;;) {
        const bool has_next = S.next(ui + 1, nxt);
        const char* nA = has_next ? (const char*)g.A + (size_t)(nxt.pm * g.amul) * tstepA + (size_t)nxt.k0 * kstep : cA; const char* nB = has_next ? (const char*)g.Bt + (size_t)(nxt.pn * g.bmul) * tstep + (size_t)nxt.k0 * kstep : cB;
        const int unt = cur.nk ? cur.nk : nt;
#pragma unroll 1
        for (int t = 0; t < unt; t += 2) {
            const bool last = (t == unt - 2);
            const char* a1 = cA + (size_t)(t + 1) * kstep;
            const char* a2 = last ? nA : cA + (size_t)(t + 2) * kstep; const char* b2 = last ? nB : cB + (size_t)(t + 2) * kstep;
            const char* a3 = a2 + kstep; const char* b3 = b2 + kstep;
            if (last && has_next) S.a_ready(nxt);
            if constexpr (SP2) {
            PG8_LDB(B0, 0, 0); PG8_LDB(B1, 0, 1); PG8_SCHED; PG8_LDA(At, 0, 0); PG8_STAGE(PG8_SA(1, 1), a1 + hstep, voffA);
            PG8_WAIT_V(8); PG8_WAIT_L(0); PG8_BAR; PG8_MMA(0, 0, At, B0); PG8_MMA(0, 1, At, B1); PG8_BAR; PG8_SCHED;
            PG8_LDA(At, 0, 1); PG8_STAGE(PG8_SB(0, 0), b2, voffB); PG8_STAGE(PG8_SB(0, 1), b2 + hstep, voffB); PG8_STAGE(PG8_SA(0, 0), a2, voffA);
            PG8_WAIT_V(8); PG8_WAIT_L(0); PG8_BAR; PG8_MMA(1, 0, At, B0); PG8_MMA(1, 1, At, B1); PG8_BAR; PG8_SCHED;
            PG8_LDB(B0, 1, 0); PG8_LDB(B1, 1, 1); PG8_SCHED; PG8_LDA(At, 1, 0); PG8_STAGE(PG8_SA(0, 1), a2 + hstep, voffA);
            PG8_WAIT_V(8); PG8_WAIT_L(0); PG8_BAR; PG8_MMA(0, 0, At, B0); PG8_MMA(0, 1, At, B1); PG8_BAR; PG8_SCHED;
            PG8_LDA(At, 1, 1); PG8_STAGE(PG8_SB(1, 0), b3, voffB); PG8_STAGE(PG8_SB(1, 1), b3 + hstep, voffB); PG8_STAGE(PG8_SA(1, 0), a3, voffA);
            PG8_WAIT_V(8); PG8_WAIT_L(0); PG8_BAR; PG8_MMA(1, 0, At, B0); PG8_MMA(1, 1, At, B1); PG8_BAR; PG8_SCHED;
            } else {
            PG8_LDB(B0, 0, 0); PG8_SCHED; PG8_LDA(At, 0, 0); PG8_STAGE(PG8_SA(1, 1), a1 + hstep, voffA);
            PG8_WAIT_L(8); PG8_BAR; PG8_WAIT_L(0); PG8_MMA(0, 0, At, B0); PG8_BAR; PG8_SCHED;
            PG8_LDB(B1, 0, 1); PG8_STAGE(PG8_SB(0, 0), b2, voffB);
            PG8_BAR; PG8_WAIT_L(0); PG8_MMA(0, 1, At, B1); PG8_BAR;
            PG8_LDA(At, 0, 1); PG8_STAGE(PG8_SA(0, 0), a2, voffA);
            PG8_BAR; PG8_WAIT_L(0); PG8_MMA(1, 0, At, B0); PG8_BAR; PG8_SCHED;
            PG8_STAGE(PG8_SB(0, 1), b2 + hstep, voffB);
            PG8_WAIT_V(6); PG8_BAR; PG8_MMA(1, 1, At, B1); PG8_BAR;
            PG8_LDB(B0, 1, 0); PG8_SCHED; PG8_LDA(At, 1, 0); PG8_STAGE(PG8_SA(0, 1), a2 + hstep, voffA);
            PG8_WAIT_L(8); PG8_BAR; PG8_WAIT_L(0); PG8_MMA(0, 0, At, B0); PG8_BAR; PG8_SCHED;
            PG8_LDB(B1, 1, 1); PG8_STAGE(PG8_SB(1, 0), b3, voffB);
            PG8_BAR; PG8_WAIT_L(0); PG8_MMA(0, 1, At, B1); PG8_BAR;
            PG8_LDA(At, 1, 1); PG8_STAGE(PG8_SA(1, 0), a3, voffA);
            PG8_BAR; PG8_WAIT_L(0); PG8_MMA(1, 0, At, B0); PG8_BAR; PG8_SCHED;
            PG8_STAGE(PG8_SB(1, 1), b3 + hstep, voffB);
            PG8_WAIT_V(6); PG8_BAR; PG8_MMA(1, 1, At, B1); PG8_BAR;
            }
        }
        if constexpr (Epi::F8) { asm volatile("s_nop 15\n\ts_nop 15" ::: "memory"); PG8_SCHED; }
        if constexpr (ALIGN_EPI) { if (wr == 0) PG8_BAR; }
        if constexpr (!Epi::AFTER_DRAIN) { E(acc, cur, wr, wc, fr, fq); S.done(cur); }
        if (!has_next) break;
#pragma unroll
        for (int a = 0; a < 2; ++a)
#pragma unroll
            for (int b = 0; b < 2; ++b)
#pragma unroll
                for (int m = 0; m < 4; ++m)
#pragma unroll
                    for (int n = 0; n < 2; ++n) acc[a][b][m][n] = (f32x4){0.f, 0.f, 0.f, 0.f};
        cur = nxt; cA = nA; cB = nB; ++ui;
        if constexpr (ALIGN_EPI) { if (wr == 1) PG8_BAR; }
    }
    PG8_WAIT_V(0);
    if constexpr (!ALIGN_EPI) { if (wr == 0) PG8_BAR; }
    PG8_BAR;
    if constexpr (Epi::AFTER_DRAIN) { E.fused(acc, cur, wr, wc, fr, fq, lds, wid, lane); S.done(cur); }
#undef PG8_SA
#undef PG8_SB
#undef PG8_STAGE
#undef PG8_LDA
#undef PG8_LDB
#undef PG8_MMA
#undef PG8_WAIT_V
#undef PG8_WAIT_L
#undef PG8_BAR
#undef PG8_SCHED
}
}

#ifndef PG8_SP2
#define PG8_SP2 true
#endif
#ifndef PG8_ALIGN
#define PG8_ALIGN true
#endif
constexpr int NWAVES = 8;
#ifndef MK_ONE_LAUNCH
#define MK_ONE_LAUNCH 1
#endif
#ifndef MERGE_FFN
#define MERGE_FFN 0
#endif
#ifndef MERGE_P01
#define MERGE_P01 0
#endif
#ifndef FUSE_NORM
#define FUSE_NORM 0
#endif
constexpr int N_PHASES = FUSE_NORM ? 11 : 13;
static_assert(!((FFN_IN_MODE || FP8_FFN1_OUT || FP8_FFN2_OUT) && (FUSE_NORM || MERGE_FFN)), "the fp8 ffn-in path is wired into the plain 13-phase program only");
#ifndef CONV_MODE
#define CONV_MODE 0
#endif

constexpr int DM = 1024, M_P = 8192, M_S = 2048, M = M_P + M_S, DFF = 2816, NFF = 2 * DFF, NMIX = 4096;
constexpr int T_P = 256, T_S = 1024, PAST = 512, TK_S = PAST + T_S, NB_P = 32, NB_S = 2;
constexpr float EPS = 1e-6f;
constexpr float QSCALE = 0.125f * 1.4426950408889634f;
constexpr float LAM_INIT = 0.2f;
constexpr size_t OUT_Y = 0, OUT_K = (size_t)M * DM, OUT_V = OUT_K + (size_t)M_P * 512, OUT_S = OUT_V + (size_t)M_P * 512, OUT_END = OUT_S + (size_t)NB_P * 2 * 4 * 128 * 128;
constexpr int PC_Q = 0, PC_I = 512, PC_FF = 1024, PC_FB = 1536, PC_G = 2048, PC_AQ = 2560, PC_AK = 3072, PC_AV = 3584;

constexpr size_t MiB = 1u << 20;
constexpr size_t WS_CTL = 0, CTL_ZERO_BYTES = 192 * 1024;
constexpr size_t WS_MADA = 64 * 1024;
constexpr size_t WS_LB = 1 * MiB + 128 * 1024;
constexpr size_t WS_ROPE = 1 * MiB + 256 * 1024;
constexpr size_t WS_W1I = 2 * MiB, WS_W1O = 13 * MiB, WS_WMI = 19 * MiB, WS_WMO = 27 * MiB, WS_W2I = 29 * MiB, WS_W2O = 40 * MiB;
constexpr size_t WS_ABUF = 46 * MiB;
constexpr size_t WS_BIG = 66 * MiB;
constexpr size_t WS_SLAB = 122 * MiB;
constexpr size_t WS_QB = 146 * MiB;
constexpr size_t WS_KB = 156 * MiB;
constexpr size_t WS_KS = 164 * MiB;
constexpr size_t WS_VTP = 167 * MiB;
constexpr size_t WS_VTS = 175 * MiB;
constexpr size_t WS_OF = 178 * MiB, WS_OB = 198 * MiB;
constexpr size_t WS_ABUF2 = 218 * MiB;
constexpr size_t WS_ROWSS = 238 * MiB;
constexpr size_t WS_BIAS2 = 239 * MiB;
constexpr size_t WS_HSAVE = 240 * MiB;
constexpr size_t WS_END = 241 * MiB;
constexpr int CW_BAR = 4096;
constexpr int CW_QUEUE = 64;
constexpr int CW_MADA = 768;
constexpr int CW_CONVQ = 512;
constexpr int CW_SAMP = 11520, CW_GDONE = 11776;
constexpr int CW_LBAR = 10496;
#ifndef EARLY_CHAINS
#define EARLY_CHAINS (TALL_TILES ? 0 : 1)
#endif
#ifndef LOCAL_SEAMS
#define LOCAL_SEAMS 1
#endif
constexpr int CW_PANEL1 = 8192, CW_PANEL2 = 8832, CW_UNIT1 = 9472, CW_UNIT2 = 9984;

constexpr int RING_OFF = 0, RING_BYTES = 131072;
constexpr int LDSCTL_OFF = RING_BYTES, MISC_OFF = LDSCTL_OFF + 320;
constexpr int LDS_BYTES = 147456;

#define GAS __attribute__((address_space(1)))
#define LAS __attribute__((address_space(3)))
typedef unsigned short bf16;
typedef unsigned v4u __attribute__((ext_vector_type(4)));
typedef unsigned v2u __attribute__((ext_vector_type(2)));
typedef float f32x4 __attribute__((ext_vector_type(4)));
typedef float f32x2 __attribute__((ext_vector_type(2)));
typedef float f32x16 __attribute__((ext_vector_type(16)));
typedef short bf16x8 __attribute__((ext_vector_type(8)));
typedef short s16x4 __attribute__((ext_vector_type(4)));
typedef GAS unsigned gu32;
#define RLX_AGENT __ATOMIC_RELAXED, __HIP_MEMORY_SCOPE_AGENT
#define LDS_WAIT() asm volatile("s_waitcnt lgkmcnt(0)" ::: "memory")
#define VM_WAIT() asm volatile("s_waitcnt vmcnt(0)" ::: "memory")
#define LDS_BARRIER() do { asm volatile("s_waitcnt lgkmcnt(0)" ::: "memory"); __builtin_amdgcn_s_barrier(); asm volatile("" ::: "memory"); } while (0)
__device__ __forceinline__ unsigned f2bf(float f) { unsigned u = __builtin_bit_cast(unsigned, f); return (u + 0x7fffu + ((u >> 16) & 1u)) >> 16; }
typedef __bf16 bf16x2_t __attribute__((ext_vector_type(2)));
typedef _Float16 h2_t __attribute__((ext_vector_type(2)));
__device__ __forceinline__ unsigned pkh2(float lo, float hi) { const h2_t h = {(_Float16)lo, (_Float16)hi}; return __builtin_bit_cast(unsigned, h); }
__device__ __forceinline__ unsigned pk2(float lo, float hi) { const f32x2 v = {lo, hi}; const bf16x2_t b = __builtin_convertvector(v, bf16x2_t); return __builtin_bit_cast(unsigned, b); }
__device__ __forceinline__ float bflo(unsigned w) { return __builtin_bit_cast(float, w << 16); }
__device__ __forceinline__ float bfhi(unsigned w) { return __builtin_bit_cast(float, w & 0xffff0000u); }
__device__ __forceinline__ float wave_sum(float v) {
#pragma unroll
    for (int o = 1; o < 64; o <<= 1) v += __shfl_xor(v, o);
    return v;
}
__device__ __forceinline__ float sigmoid_f(float x) { return __builtin_amdgcn_rcpf(1.0f + __builtin_amdgcn_exp2f(-1.4426950408889634f * x)); }
#define XB_TMO      128
#define XB_XCNT(j)  (256  + 64 * (j))
#define XB_XSUB(j)  (1280 + 64 * (j))
#define XB_XGEN(j)  (2304 + 64 * (j))
#define XB_TOP      3328
#define XB_TOPGEN   3392
#define XCD_BAR_WORDS 3456
#define XB_SPIN_CAP (1u << 18)

__device__ __forceinline__ unsigned xb_ld(unsigned* p)              { return __hip_atomic_load(p, __ATOMIC_RELAXED, __HIP_MEMORY_SCOPE_AGENT); }
__device__ __forceinline__ unsigned xb_add(unsigned* p, unsigned v) { return __hip_atomic_fetch_add(p, v, __ATOMIC_RELAXED, __HIP_MEMORY_SCOPE_AGENT); }
__device__ __forceinline__ unsigned xb_xcc_id() { return (unsigned)__builtin_amdgcn_s_getreg((3 << 11) | 20) & 0xFu; }
#define XB_SPIN(cond, bar) do { unsigned _sp = 0; while (cond) { __builtin_amdgcn_s_sleep(1); \
    if ((++_sp & 255u) == 0u) { if (xb_ld(&(bar)[XB_TMO])) break; if (_sp > XB_SPIN_CAP) { atomicAdd(&(bar)[XB_TMO], 1u); break; } } } } while (0)

struct XcdBarrier {
    unsigned* bar; unsigned x;
    volatile LAS unsigned* st;
};

__device__ __forceinline__ XcdBarrier xcd_barrier_post(unsigned* bar, volatile LAS unsigned* st) {
    XcdBarrier b; b.bar = bar; b.x = xb_xcc_id(); b.st = st;
    if (threadIdx.x == 0) st[2] = xb_add(&bar[XB_XCNT(b.x)], 1u);
    return b;
}
__device__ __forceinline__ void xcd_barrier_complete(unsigned* bar, unsigned x, unsigned& nloc, unsigned& nx) {
    const unsigned G = gridDim.x * gridDim.y * gridDim.z;
    unsigned sum, cnt, mine, sp = 0u;
    for (;;) {
        sum = 0u; cnt = 0u; mine = 0u;
#pragma unroll
        for (unsigned j = 0; j < 16; ++j) { const unsigned c = xb_ld(&bar[XB_XCNT(j)]); sum += c; cnt += (c > 0u) ? 1u : 0u; mine = (j == x) ? c : mine; }
        if (sum == G) break;
        __builtin_amdgcn_s_sleep(1);
        if ((++sp & 255u) == 0u) { if (xb_ld(&bar[XB_TMO])) break; if (sp > XB_SPIN_CAP) { atomicAdd(&bar[XB_TMO], 1u); break; } }
    }
    nloc = mine > 0u ? mine : 1u; nx = cnt > 0u ? cnt : 1u;
}
__device__ __forceinline__ unsigned xcd_census_even(unsigned* bar) {
    const unsigned G = gridDim.x * gridDim.y * gridDim.z; bool ok = (G % 8u) == 0u;
#pragma unroll
    for (unsigned j = 0; j < 16; ++j) { const unsigned c = xb_ld(&bar[XB_XCNT(j)]); ok = ok && (c == (j < 8u ? G / 8u : 0u)); }
    return ok ? 1u : 2u;
}

__device__ __forceinline__ void xcd_barrier(const XcdBarrier& b) {
    asm volatile("s_waitcnt vmcnt(0)" ::: "memory");
    __syncthreads();
    if (threadIdx.x == 0) {
        unsigned* bar = b.bar;
        __builtin_amdgcn_s_waitcnt(0);
        unsigned nloc = b.st[0], nx = b.st[1];
        if (nloc == 0u) { xcd_barrier_complete(bar, b.x, nloc, nx); b.st[0] = nloc; b.st[1] = nx; b.st[3] = xcd_census_even(bar); }
        const unsigned old = xb_add(&bar[XB_XSUB(b.x)], 1u);
        const unsigned gen = old / nloc;
        if (old + 1u == (gen + 1u) * nloc) {
            __builtin_amdgcn_fence(__ATOMIC_RELEASE, "agent");
            asm volatile("s_waitcnt vmcnt(0)" ::: "memory");
            const unsigned og = xb_add(&bar[XB_TOP], 1u);
            const unsigned tg = og / nx;
            if (og + 1u == (tg + 1u) * nx) xb_add(&bar[XB_TOPGEN], 1u);
            else XB_SPIN(xb_ld(&bar[XB_TOPGEN]) == tg, bar);
            __builtin_amdgcn_fence(__ATOMIC_ACQUIRE, "agent");
            xb_add(&bar[XB_XGEN(b.x)], 1u);
            asm volatile("s_waitcnt vmcnt(0)" ::: "memory");
        } else {
            XB_SPIN(xb_ld(&bar[XB_XGEN(b.x)]) == gen, bar);
            __builtin_amdgcn_fence(__ATOMIC_ACQUIRE, "agent");
            asm volatile("s_waitcnt vmcnt(0)" ::: "memory");
        }
    }
    __syncthreads();
}

__device__ __forceinline__ void xcc_barrier(const XcdBarrier& b, unsigned* lsub) {
    asm volatile("s_waitcnt vmcnt(0)" ::: "memory");
    __syncthreads();
    if (threadIdx.x == 0) {
        const unsigned nloc = b.st[0];
        unsigned* c = lsub + 64 * b.x;
        const unsigned old = xb_add(c, 1u), target = (old / nloc + 1u) * nloc;
        XB_SPIN(xb_ld(c) < target, b.bar);
        __builtin_amdgcn_fence(__ATOMIC_ACQUIRE, "agent");
        asm volatile("s_waitcnt vmcnt(0)" ::: "memory");
    }
    __syncthreads();
}

struct Frame {
    LAS unsigned char* lds;
    volatile LAS unsigned* MISC;
    gu32* ctl;
    int tid, lane, wave;
    int vcu, G;
    int xl, xr, xok;
    const float *x_prompt, *x_sample, *c, *cache_k, *cache_v, *state0, *c_ctx, *w_ada, *b_ada, *norm_ffn1, *w_ffn1_in, *w_ffn1_out, *norm_mix, *w_mix_in, *w_mix_out,
                *lb_logits, *hgrn_out_norm, *q_norm, *k_norm, *attn_lambda, *attn_subln, *norm_ffn2, *w_ffn2_in, *w_ffn2_out;
    float* out;
    float *mada, *rope, *lbv, *bias2m, *bias2f, *rowss, *hsave, *rowq, *cq1, *cq2; int* hidx; bf16 *W1I, *W1O, *WMI, *WMO, *W2I, *W2O, *ABUF, *ABUF2, *HID, *PROJ, *QB, *KB, *KS, *VTP, *VTS, *OF, *OB;
};

constexpr int CV_FI = I8_FFN_IN ? (NFF / 32) * 8 : (DM / 64) * (NFF / 32),
               CV_FO = (DFF / 64) * (DM / 32), CV_MI = (DM / 64) * (NMIX / 32), CV_MO = (DM / 64) * (DM / 32);
#ifndef CONV_P5TAIL
#define CONV_P5TAIL 0
#endif
#ifndef CONV_P6
#define CONV_P6 0
#endif
#ifndef CONV_P9
#define CONV_P9 0
#endif
#ifndef CONV_LATE_P3
#define CONV_LATE_P3 0
#endif
#ifndef CONV_P2TAIL
#define CONV_P2TAIL 1
#endif
constexpr int CV_P0_N = CONV_P2TAIL ? CV_FI : CV_FI + CV_FO + CV_MI;
constexpr int CV_LATE0 = CV_FI + CV_FO + CV_MI, CV_LATE_N = CV_MO + CV_FI + CV_FO;
template <int MODE, bool F8 = false>
__device__ __forceinline__ void p0_transpose_item(const float* W, int K, int N, bf16* WT, LAS float* scr, int item, int lane) {
    const int nblk = N / 32, kb = item / nblk, nb = item % nblk, k0 = 64 * kb, n0 = 32 * nb;
    int drow0 = n0;
    if (MODE == 1) { const int half = n0 / DFF, r = n0 % DFF; drow0 = (r / 128) * 256 + half * 128 + (r % 128); }
    float tv[32];
    const float* wp = W + (size_t)(k0 + (lane >> 5)) * N + n0 + (lane & 31);
#pragma unroll
    for (int i = 0; i < 32; ++i) tv[i] = __builtin_nontemporal_load(wp + (size_t)(2 * i) * N);
#pragma unroll
    for (int i = 0; i < 32; ++i) scr[(2 * i + (lane >> 5)) * 33 + (lane & 31)] = tv[i];
    LDS_WAIT(); asm volatile("" ::: "memory");
    const int c = lane & 7;
#pragma unroll
    for (int j = 0; j < 4; ++j) { const int n = (lane >> 3) + 8 * j; const LAS float* s = scr + (8 * c) * 33 + n;
        if constexpr (F8) { v2u o; o.x = pk4_f8(s[0 * 33] * F8_SW, s[1 * 33] * F8_SW, s[2 * 33] * F8_SW, s[3 * 33] * F8_SW); o.y = pk4_f8(s[4 * 33] * F8_SW, s[5 * 33] * F8_SW, s[6 * 33] * F8_SW, s[7 * 33] * F8_SW);
            *(GAS v2u*)((unsigned char*)WT + (size_t)(drow0 + n) * K + k0 + 8 * c) = o; }
        else { v4u o; o.x = pk2(s[0 * 33], s[1 * 33]); o.y = pk2(s[2 * 33], s[3 * 33]); o.z = pk2(s[4 * 33], s[5 * 33]); o.w = pk2(s[6 * 33], s[7 * 33]);
            *(GAS v4u*)(WT + (size_t)(drow0 + n) * K + k0 + 8 * c) = o; } }
    LDS_WAIT(); asm volatile("" ::: "memory");
}

__device__ __forceinline__ void convert_panel_i8(Frame& F, const float* W, bf16* WTb, float* cq, int panel) {
    constexpr int K = DM, N = NFF;
    unsigned char* WT = (unsigned char*)WTb;
    LAS float* scr = (LAS float*)(F.lds + RING_OFF + F.wave * 16384);
    const int lane = F.lane, n0 = 32 * panel, half = n0 / DFF, r = n0 % DFF, drow0 = (r / 128) * 256 + half * 128 + (r % 128);
    float tv[2][32];
#pragma unroll
    for (int sb = 0; sb < 2; ++sb) { const float* wp = W + (size_t)(128 * F.wave + 64 * sb + (lane >> 5)) * N + n0 + (lane & 31);
#pragma unroll
        for (int i = 0; i < 32; ++i) tv[sb][i] = __builtin_nontemporal_load(wp + (size_t)(2 * i) * N); }
    float m = 0.f;
#pragma unroll
    for (int sb = 0; sb < 2; ++sb)
#pragma unroll
        for (int i = 0; i < 32; ++i) m = __builtin_fmaxf(m, __builtin_fabsf(tv[sb][i]));
    m = __builtin_fmaxf(m, __shfl_xor(m, 32));
    if (lane < 32) scr[3072 + lane] = m;
    __syncthreads();
    float cm = 0.f;
#pragma unroll
    for (int w = 0; w < NWAVES; ++w) cm = __builtin_fmaxf(cm, ((LAS float*)(F.lds + RING_OFF + w * 16384))[3072 + (lane & 31)]);
    const float inv = cm > 0.f ? 127.0f / cm : 0.f;
    if (F.wave == 0 && lane < 32) cq[drow0 + lane] = cm * (1.0f / 127.0f);
    const int c = lane & 7;
#pragma unroll
    for (int sb = 0; sb < 2; ++sb) { const int k0 = 128 * F.wave + 64 * sb;
#pragma unroll
        for (int i = 0; i < 32; ++i) scr[(2 * i + (lane >> 5)) * 33 + (lane & 31)] = tv[sb][i] * inv;
        LDS_WAIT(); asm volatile("" ::: "memory");
#pragma unroll
        for (int j = 0; j < 4; ++j) { const int n = (lane >> 3) + 8 * j; const LAS float* s = scr + (8 * c) * 33 + n;
            v2u o; o.x = pk4_i8(s[0 * 33], s[1 * 33], s[2 * 33], s[3 * 33]); o.y = pk4_i8(s[4 * 33], s[5 * 33], s[6 * 33], s[7 * 33]);
            *(GAS v2u*)(WT + (size_t)(drow0 + n) * K + k0 + 8 * c) = o; }
        LDS_WAIT(); asm volatile("" ::: "memory"); }
    __syncthreads();
}
__device__ __forceinline__ void convert_item(Frame& F, LAS float* scr, int it) {
    int r = it;
    if (r < CV_FI) { if constexpr (I8_FFN_IN) convert_panel_i8(F, F.w_ffn1_in, F.W1I, F.cq1, r >> 3); else p0_transpose_item<1, FP8_FFN_IN != 0>(F.w_ffn1_in, DM, NFF, F.W1I, scr, r, F.lane); return; } r -= CV_FI;
    if (r < CV_FO) { p0_transpose_item<0, FP8_FFN1_OUT != 0>(F.w_ffn1_out, DFF, DM, F.W1O, scr, r, F.lane); return; } r -= CV_FO;
    if (r < CV_MI) { p0_transpose_item<0>(F.w_mix_in, DM, NMIX, F.WMI, scr, r, F.lane); return; } r -= CV_MI;
    if (r < CV_MO) { p0_transpose_item<0>(F.w_mix_out, DM, DM, F.WMO, scr, r, F.lane); return; } r -= CV_MO;
    if (r < CV_FI) { if constexpr (I8_FFN_IN) convert_panel_i8(F, F.w_ffn2_in, F.W2I, F.cq2, r >> 3); else p0_transpose_item<1, FP8_FFN_IN != 0>(F.w_ffn2_in, DM, NFF, F.W2I, scr, r, F.lane); return; } r -= CV_FI;
    p0_transpose_item<0, FP8_FFN2_OUT != 0>(F.w_ffn2_out, DFF, DM, F.W2O, scr, r, F.lane);
}
__device__ __forceinline__ void convert_queue(Frame& F, int qword, int first, int n) {
    LAS float* scr = (LAS float*)(F.lds + RING_OFF + F.wave * 16384);
    volatile LAS int* qslot = (volatile LAS int*)(F.lds + MISC_OFF + 64);
    for (;;) {
        if (F.tid == 0) *qslot = (int)__hip_atomic_fetch_add(F.ctl + qword, 1u, RLX_AGENT);
        __syncthreads();
        const int bt = *qslot;
        __syncthreads();
        if (bt * 8 >= n) break;
        { const int it = bt * 8 + F.wave; if (it < n) convert_item(F, scr, first + it); }
    }
}
__device__ __forceinline__ void p0_prologue(Frame& F) {
    if (F.vcu < 144) {
        LAS float* sS = (LAS float*)(F.lds);
        LAS float* red = (LAS float*)(F.lds + 12288);
        for (int i = F.tid; i < 3072; i += NWAVES * 64) { const int cond = i >> 10, k = i & 1023; const float cv = cond == 0 ? F.c_ctx[k] : F.c[(cond - 1) * 1024 + k]; sS[i] = cv * sigmoid_f(cv); }
        __syncthreads();
        const int cb = F.vcu % 36, kq = F.vcu / 36, col = cb * 256 + 4 * F.lane, k0 = kq * 256 + F.wave * 32;
        f32x4 a0 = {0.f, 0.f, 0.f, 0.f}, a1 = a0, a2 = a0;
#pragma unroll
        for (int hb = 0; hb < 2; ++hb) { f32x4 wv[16];
#pragma unroll
            for (int kk = 0; kk < 16; ++kk) wv[kk] = __builtin_nontemporal_load((const f32x4*)(F.w_ada + (size_t)(k0 + hb * 16 + kk) * 9216 + col));
#pragma unroll
            for (int kk = 0; kk < 16; ++kk) { const int k = k0 + hb * 16 + kk; a0 += wv[kk] * sS[k]; a1 += wv[kk] * sS[1024 + k]; a2 += wv[kk] * sS[2048 + k]; } }
        *(LAS f32x4*)(red + (F.wave * 3 + 0) * 256 + 4 * F.lane) = a0; *(LAS f32x4*)(red + (F.wave * 3 + 1) * 256 + 4 * F.lane) = a1; *(LAS f32x4*)(red + (F.wave * 3 + 2) * 256 + 4 * F.lane) = a2;
        __syncthreads();
        for (int o = F.tid; o < 768; o += NWAVES * 64) { const int cond = o >> 8, cc = o & 255; float s = kq == 0 ? F.b_ada[cb * 256 + cc] : 0.f;
#pragma unroll
            for (int w = 0; w < 8; ++w) s += red[(w * 3 + cond) * 256 + cc];
            atomicAdd(F.mada + cond * 9216 + cb * 256 + cc, s); }
        asm volatile("s_waitcnt vmcnt(0)" ::: "memory");
        __syncthreads();
        if (cb < 8 && F.tid == 0) { __builtin_amdgcn_fence(__ATOMIC_RELEASE, "agent"); asm volatile("s_waitcnt vmcnt(0)" ::: "memory"); (void)__hip_atomic_fetch_add(F.ctl + CW_MADA, 1u, RLX_AGENT); }
    }
    if (F.vcu == F.G - 1) { const int k = F.tid; F.lbv[k] = 1.0f / (1.0f + __expf(F.lb_logits[512 + k] - F.lb_logits[k])); }
    { const int gid = (F.vcu * NWAVES + F.wave) * 64 + F.lane;
      if (gid < 1024 * 32) { const int t = gid >> 5, j = gid & 31, i = j & 15; const float pos = (j < 16) ? (float)(t >> 6) : (float)(t & 63);
          const float inv = exp2f(-(float)i * (13.287712379549449f / 16.0f));
          float sn, cs; sincosf(pos * inv, &sn, &cs); F.rope[gid] = cs; F.rope[32768 + gid] = sn; } }
    LAS float* scr = (LAS float*)(F.lds + RING_OFF + F.wave * 16384);
    const int gw = F.vcu * NWAVES + F.wave, NGW = F.G * NWAVES;
#if CONV_MODE == 0
    (void)gw; (void)NGW; (void)scr; convert_queue(F, CW_CONVQ + 128, 0, CV_P0_N);
#else
    for (int it = gw; it < CV_FI; it += NGW) p0_transpose_item<1>(F.w_ffn1_in, DM, NFF, F.W1I, scr, it, F.lane);
#endif
}
__device__ __forceinline__ void wait_mada01(Frame& F) {
    if (F.tid == 0) { unsigned sp = 0;
        while (__hip_atomic_load(F.ctl + CW_MADA, RLX_AGENT) < 32u) { __builtin_amdgcn_s_sleep(2); if (++sp > (1u << 22)) break; }
        __builtin_amdgcn_fence(__ATOMIC_ACQUIRE, "agent"); asm volatile("s_waitcnt vmcnt(0)" ::: "memory"); }
    __syncthreads();
}
template <int QM>
__device__ __forceinline__ void norm_mod_phase(Frame& F, const float* src0, const float* src1, const float* nw, int sh_chunk, int sc_chunk) {
    const int xl = F.xl, wl = F.xr * NWAVES + F.wave, NWL = (F.G / 8) * NWAVES;
    f32x4 a4[4], h4[4]; int cur = -1;
    for (int rl = wl; rl < M / 8; rl += NWL) { const int row = pg8::pmap(5 * xl + (rl >> 8)) * 256 + (rl & 255);
        const float* xr = row < M_P ? src0 + (size_t)row * DM : src1 + (size_t)(row - M_P) * DM;
        const int cond = row < M_P ? 0 : 1 + ((row - M_P) >> 10);
        f32x4 v[4]; float ss = 0.f;
#pragma unroll
        for (int j = 0; j < 4; ++j) { v[j] = ((const GAS f32x4*)xr)[F.lane + 64 * j]; ss += (v[j].x * v[j].x + v[j].y * v[j].y) + (v[j].z * v[j].z + v[j].w * v[j].w); }
        if (cond != cur) { cur = cond; const float* sh = F.mada + cond * 9216 + sh_chunk * 1024; const float* sc = F.mada + cond * 9216 + sc_chunk * 1024;
#pragma unroll
            for (int j = 0; j < 4; ++j) { const int q = F.lane + 64 * j; a4[j] = ((const GAS f32x4*)nw)[q] * (((const GAS f32x4*)sc)[q] + 1.0f); h4[j] = ((const GAS f32x4*)sh)[q]; } }
        const float rstd = 1.0f / sqrtf(wave_sum(ss) * (1.0f / DM) + EPS);
        if constexpr (QM == 2) { GAS unsigned* o4 = (GAS unsigned*)((GAS unsigned char*)F.ABUF + (size_t)row * DM);
            f32x4 o[4]; float am = 0.f;
#pragma unroll
            for (int j = 0; j < 4; ++j) { o[j] = v[j] * rstd * a4[j] + h4[j]; am = __builtin_fmaxf(am, __builtin_fmaxf(__builtin_fmaxf(__builtin_fabsf(o[j].x), __builtin_fabsf(o[j].y)), __builtin_fmaxf(__builtin_fabsf(o[j].z), __builtin_fabsf(o[j].w)))); }
#pragma unroll
            for (int sh = 1; sh < 64; sh <<= 1) am = __builtin_fmaxf(am, __shfl_xor(am, sh));
            const float inv = am > 0.f ? 127.0f / am : 0.f;
            if (F.lane == 0) F.rowq[row] = am * (1.0f / 127.0f);
#pragma unroll
            for (int j = 0; j < 4; ++j) { const f32x4 q = o[j] * inv; o4[F.lane + 64 * j] = pk4_i8(q.x, q.y, q.z, q.w); } }
        else if constexpr (QM == 1) { GAS unsigned* o4 = (GAS unsigned*)((GAS unsigned char*)F.ABUF + (size_t)row * DM);
#pragma unroll
            for (int j = 0; j < 4; ++j) { const int q = F.lane + 64 * j; const f32x4 o = (v[j] * rstd * a4[j] + h4[j]) * F8_SA; o4[q] = pk4_f8(o.x, o.y, o.z, o.w); } }
        else { GAS v2u* o8 = (GAS v2u*)(F.ABUF + (size_t)row * DM);
#pragma unroll
            for (int j = 0; j < 4; ++j) { const int q = F.lane + 64 * j; const f32x4 o = v[j] * rstd * a4[j] + h4[j]; v2u w; w.x = pk2(o.x, o.y); w.y = pk2(o.z, o.w); o8[q] = w; } }
    }
}

__device__ __forceinline__ void bias2_rows(Frame& F, const bf16* Wt, int N, int sh_chunk, float* dst) {
    const int gw = F.vcu * NWAVES + F.wave, NGW = F.G * NWAVES, lane = F.lane;
    float sh[3][16];
#pragma unroll
    for (int c = 0; c < 3; ++c)
#pragma unroll
        for (int j = 0; j < 16; ++j) sh[c][j] = F.mada[c * 9216 + sh_chunk * 1024 + (j < 8 ? 8 * lane + j : 512 + 8 * lane + (j - 8))];
    for (int n = gw; n < N; n += NGW) {
        const v4u w0 = *(const GAS v4u*)(Wt + (size_t)n * DM + 8 * lane), w1 = *(const GAS v4u*)(Wt + (size_t)n * DM + 512 + 8 * lane);
        const float wv[16] = {bflo(w0.x), bfhi(w0.x), bflo(w0.y), bfhi(w0.y), bflo(w0.z), bfhi(w0.z), bflo(w0.w), bfhi(w0.w), bflo(w1.x), bfhi(w1.x), bflo(w1.y), bfhi(w1.y), bflo(w1.z), bfhi(w1.z), bflo(w1.w), bfhi(w1.w)};
        float a0 = 0.f, a1 = 0.f, a2 = 0.f;
#pragma unroll
        for (int j = 0; j < 16; ++j) { a0 += wv[j] * sh[0][j]; a1 += wv[j] * sh[1][j]; a2 += wv[j] * sh[2][j]; }
        a0 = wave_sum(a0); a1 = wave_sum(a1); a2 = wave_sum(a2);
        if (lane == 0) { dst[n] = a0; dst[N + n] = a1; dst[2 * N + n] = a2; }
    }
}

constexpr int N_HEADWG = NB_S * 4 * 2, HG_HEAD = 6;
template <bool SRC_F32>
__device__ __forceinline__ void vt_item(const void* src, size_t src_pitch  , bf16* dst, size_t dst_pitch, LAS unsigned short* scr, int lane) {
#pragma unroll
    for (int i = 0; i < 8; ++i) { const int id = i * 64 + lane, r = id >> 3, ch = id & 7; v4u w;
        if (SRC_F32) { const float* p = (const float*)src + (size_t)r * src_pitch + ch * 8; const f32x4 a = *(const GAS f32x4*)p, b = *(const GAS f32x4*)(p + 4);
            w.x = pk2(a.x, a.y); w.y = pk2(a.z, a.w); w.z = pk2(b.x, b.y); w.w = pk2(b.z, b.w); }
        else w = *(const GAS v4u*)((const bf16*)src + (size_t)r * src_pitch + ch * 8);
        *(LAS v4u*)(scr + r * 72 + ch * 8) = w; }
    LDS_WAIT(); asm volatile("" ::: "memory");
#pragma unroll
    for (int i = 0; i < 8; ++i) { const int id = i * 64 + lane, c = id >> 3, rc = id & 7; const LAS unsigned short* s = scr + (rc * 8) * 72 + c; v4u w;
        w.x = (unsigned)s[0] | ((unsigned)s[72] << 16); w.y = (unsigned)s[2 * 72] | ((unsigned)s[3 * 72] << 16); w.z = (unsigned)s[4 * 72] | ((unsigned)s[5 * 72] << 16); w.w = (unsigned)s[6 * 72] | ((unsigned)s[7 * 72] << 16);
        *(GAS v4u*)(dst + (size_t)c * dst_pitch + rc * 8) = w; }
    LDS_WAIT(); asm volatile("" ::: "memory");
}

__device__ __forceinline__ void p6a_prep(Frame& F, int dense) {
    const int gw = dense * NWAVES + F.wave, NGW = (F.G - N_HEADWG) * NWAVES, lane = F.lane;
    const int d0 = 8 * (lane & 7);
    float qw[8], kw[8];
#pragma unroll
    for (int j = 0; j < 8; ++j) { qw[j] = F.q_norm[d0 + j]; kw[j] = F.k_norm[d0 + j]; }
    for (int row = gw; row < M; row += NGW) {
        const bf16* pr = F.PROJ + (size_t)row * NMIX;
        const v4u qa = *(const GAS v4u*)(pr + PC_AQ + 8 * lane), ka = *(const GAS v4u*)(pr + PC_AK + 8 * lane);
        float q[8] = {bflo(qa.x), bfhi(qa.x), bflo(qa.y), bfhi(qa.y), bflo(qa.z), bfhi(qa.z), bflo(qa.w), bfhi(qa.w)};
        float k[8] = {bflo(ka.x), bfhi(ka.x), bflo(ka.y), bfhi(ka.y), bflo(ka.z), bfhi(ka.z), bflo(ka.w), bfhi(ka.w)};
        float sq = 0.f, sk = 0.f;
#pragma unroll
        for (int j = 0; j < 8; ++j) { sq += q[j] * q[j]; sk += k[j] * k[j]; }
        sq += __shfl_xor(sq, 1); sq += __shfl_xor(sq, 2); sq += __shfl_xor(sq, 4);
        sk += __shfl_xor(sk, 1); sk += __shfl_xor(sk, 2); sk += __shfl_xor(sk, 4);
        const float rq = 1.0f / sqrtf(sq * (1.0f / 64.0f) + EPS), rk = 1.0f / sqrtf(sk * (1.0f / 64.0f) + EPS);
#pragma unroll
        for (int j = 0; j < 8; ++j) { q[j] = q[j] * rq * qw[j]; k[j] = k[j] * rk * kw[j]; }
        if (row < M_P) {
            float* ok = F.out + OUT_K + (size_t)row * 512 + 8 * lane;
            *(GAS f32x4*)ok = (f32x4){k[0], k[1], k[2], k[3]}; *(GAS f32x4*)(ok + 4) = (f32x4){k[4], k[5], k[6], k[7]};
            v4u w; w.x = pk2(k[0], k[1]); w.y = pk2(k[2], k[3]); w.z = pk2(k[4], k[5]); w.w = pk2(k[6], k[7]);
            *(GAS v4u*)(F.KB + (size_t)row * 512 + 8 * lane) = w;
        } else {
            const int rs = row - M_P, b = rs >> 10, t = rs & 1023, g8 = lane & 7;
            const bool first = (g8 & 2) == 0; const int tc = ((g8 >= 4) ? 16 : 0) + 8 * (g8 & 1);
            const float* cs = F.rope + t * 32 + tc; const float* sn = F.rope + 32768 + t * 32 + tc;
#pragma unroll
            for (int j = 0; j < 8; ++j) { const float c = cs[j], s = sn[j]; const float pq = __shfl_xor(q[j], 2), pk = __shfl_xor(k[j], 2);
                q[j] = first ? q[j] * c - pq * s : q[j] * c + pq * s; k[j] = first ? k[j] * c - pk * s : k[j] * c + pk * s; }
            v4u w; w.x = pk2(k[0], k[1]); w.y = pk2(k[2], k[3]); w.z = pk2(k[4], k[5]); w.w = pk2(k[6], k[7]);
            *(GAS v4u*)(F.KS + ((size_t)b * TK_S + PAST + t) * 512 + 8 * lane) = w;
        }
        v4u w; w.x = pk2(q[0] * QSCALE, q[1] * QSCALE); w.y = pk2(q[2] * QSCALE, q[3] * QSCALE); w.z = pk2(q[4] * QSCALE, q[5] * QSCALE); w.w = pk2(q[6] * QSCALE, q[7] * QSCALE);
        *(GAS v4u*)(F.QB + (size_t)row * 512 + 8 * lane) = w;
    }
    for (int r = gw; r < NB_S * PAST; r += NGW) { const int b = r >> 9, j = r & 511; const float* p = F.cache_k + (size_t)r * 512 + 8 * lane;
        const f32x4 a = *(const GAS f32x4*)p, bb = *(const GAS f32x4*)(p + 4); v4u w; w.x = pk2(a.x, a.y); w.y = pk2(a.z, a.w); w.z = pk2(bb.x, bb.y); w.w = pk2(bb.z, bb.w);
        *(GAS v4u*)(F.KS + ((size_t)b * TK_S + j) * 512 + 8 * lane) = w; }
    LAS unsigned short* scr = (LAS unsigned short*)(F.lds + RING_OFF + F.wave * 16384);
    constexpr int IT_P = NB_P * 4 * 4 * 2, IT_SL = NB_S * 4 * 16 * 2, IT_SC = NB_S * 4 * 8 * 2;
    for (int it = gw; it < IT_P + IT_SL + IT_SC; it += NGW) {
        if (it < IT_P) { const int bh = it >> 3, tb = (it >> 1) & 3, db = it & 1, b = bh >> 2, h = bh & 3;
            vt_item<false>(F.PROJ + ((size_t)b * T_P + tb * 64) * NMIX + PC_AV + h * 128 + db * 64, NMIX, F.VTP + ((size_t)bh * 128 + db * 64) * T_P + tb * 64, T_P, scr, lane); }
        else if (it < IT_P + IT_SL) { const int r = it - IT_P, bh = r >> 5, tb = (r >> 1) & 15, db = r & 1, b = bh >> 2, h = bh & 3;
            vt_item<false>(F.PROJ + ((size_t)M_P + b * T_S + tb * 64) * NMIX + PC_AV + h * 128 + db * 64, NMIX, F.VTS + ((size_t)bh * 128 + db * 64) * TK_S + PAST + tb * 64, TK_S, scr, lane); }
        else { const int r = it - IT_P - IT_SL, bh = r >> 4, tb = (r >> 1) & 7, db = r & 1, b = bh >> 2, h = bh & 3;
            vt_item<true>(F.cache_v + ((size_t)b * PAST + tb * 64) * 512 + h * 128 + db * 64, 512, F.VTS + ((size_t)bh * 128 + db * 64) * TK_S + tb * 64, TK_S, scr, lane); }
    }
}

constexpr int HG_QT = 0, HG_KT = 8192, HG_KH = 16384, HG_VT = 24576, HG_PE = 32768, HG_BUF = 33792, HG_GT = 2 * HG_BUF, HG_GTB = 4096, HG_FLAG = HG_GT + 2 * HG_GTB;
#define MFMA16(a, b, c) __builtin_amdgcn_mfma_f32_16x16x32_bf16(a, b, c, 0, 0, 0)
__device__ __forceinline__ int hgrn_unit(Frame& F, int row_base, int T, int h, int dir, const float* s0, float* sfin, bf16* obuf, int c_begin, int c_end, const unsigned* stopc = nullptr, unsigned stopneed = 0u) {
    LAS unsigned char* L = F.lds;
    int tid_ = F.tid; asm volatile("" : "+v"(tid_));
    const int tid = tid_, lane = tid & 63, w = F.wave, r = lane & 15, g = lane >> 4, kp = tid & 63, tg = w;
    f32x4 S[8];
#pragma unroll
    for (int t8 = 0; t8 < 8; ++t8)
#pragma unroll
        for (int i = 0; i < 4; ++i) S[t8][i] = s0 ? s0[(size_t)(16 * t8 + 4 * g + i) * 128 + 16 * w + r] : 0.f;
    const int cq = PC_Q + h * 128 + 2 * kp, cf = (dir == 0 ? PC_FF : PC_FB) + h * 128 + 2 * kp, ci = PC_I + h * 128 + 2 * kp;
    unsigned rq[4], rx[4], rv[4];
    const int tsgn = dir == 0 ? 1 : -1, tbase = dir == 0 ? 0 : T - 1;
    const int nch = c_end;
#define HG_L(c_) do { const int cc_ = (c_) < nch ? (c_) : nch - 1;     \
        _Pragma("unroll") for (int i = 0; i < 4; ++i) { const int tt = 32 * cc_ + 4 * tg + i, ta = tbase + tsgn * tt; const bf16* pr = F.PROJ + (size_t)(row_base + ta) * NMIX; \
        rq[i] = *(const GAS unsigned*)(pr + cq); rx[i] = *(const GAS unsigned*)(pr + cf); rv[i] = *(const GAS unsigned*)(pr + ci); } } while (0)
#define HG_P1(c_) do { { float acc0 = 0.f, acc1 = 0.f; \
        _Pragma("unroll") for (int i = 0; i < 4; ++i) { const h2_t lf = __builtin_bit_cast(h2_t, rx[i]); acc0 += (float)lf[0]; acc1 += (float)lf[1]; } \
        *(LAS f32x2*)(L + HG_GT + ((c_) & 1) * HG_GTB + (tg * 128 + 2 * kp) * 4) = (f32x2){acc0, acc1}; } } while (0)
#define HG_P2(c_) do { { LAS unsigned char* Lb = L + ((c_) & 1) * HG_BUF; const LAS unsigned char* Gt = L + HG_GT + ((c_) & 1) * HG_GTB; f32x2 off = {0.f, 0.f}, be = {0.f, 0.f}; \
        _Pragma("unroll") for (int g2 = 0; g2 < 8; ++g2) { const f32x2 v2 = *(const LAS f32x2*)(Gt + (g2 * 128 + 2 * kp) * 4); if (g2 < tg) off += v2; be += v2; } \
        float kh[2][4]; float b0 = off.x, b1 = off.y; \
        _Pragma("unroll") for (int i = 0; i < 4; ++i) { const int t = 4 * tg + i; const h2_t lf = __builtin_bit_cast(h2_t, rx[i]); const float l0 = (float)lf[0], l1 = (float)lf[1]; b0 += l0; b1 += l1; \
            const float B0 = fmaxf(b0, -80.f), B1 = fmaxf(b1, -80.f); \
            const float qt0 = bflo(rq[i]) * __expf(B0), qt1 = bfhi(rq[i]) * __expf(B1), kt0 = (1.0f - __expf(l0)) * __expf(-B0), kt1 = (1.0f - __expf(l1)) * __expf(-B1); kh[0][i] = kt0; kh[1][i] = kt1; \
            const int a = t * 256 + ((((kp >> 2) ^ (t & 15))) << 4) + (kp & 3) * 4; \
            *(LAS unsigned*)(Lb + HG_QT + a) = pk2(qt0, qt1); *(LAS unsigned*)(Lb + HG_KT + a) = pk2(kt0, kt1); } \
        _Pragma("unroll") for (int e = 0; e < 2; ++e) { const int k = 2 * kp + e; const int a = (((k >> 4) * 4 + (tg >> 1)) * 16 + (k & 15)) * 16 + 8 * (tg & 1); \
            *(LAS v2u*)(Lb + HG_KH + a) = (v2u){pk2(kh[e][0], kh[e][1]), pk2(kh[e][2], kh[e][3])}; \
            v2u vw; if (e == 0) { vw.x = (rv[0] & 0xffffu) | (rv[1] << 16); vw.y = (rv[2] & 0xffffu) | (rv[3] << 16); } else { vw.x = (rv[0] >> 16) | (rv[1] & 0xffff0000u); vw.y = (rv[2] >> 16) | (rv[3] & 0xffff0000u); } \
            *(LAS v2u*)(Lb + HG_VT + a) = vw; } \
        if (tg == 0) *(LAS f32x2*)(Lb + HG_PE + 2 * kp * 4) = (f32x2){__expf(be.x), __expf(be.y)}; } } while (0)
    HG_L(c_begin);
    int c = c_begin;
    for (; c < nch; ++c) {
        if (stopc && tid == 0) *(LAS unsigned*)(L + HG_FLAG) = (__hip_atomic_load(stopc, RLX_AGENT) >= stopneed) ? 1u : 0u;
        HG_P1(c);
        LDS_BARRIER();
        if (stopc && *(const LAS unsigned*)(L + HG_FLAG) != 0u) break;
        HG_P2(c); HG_L(c + 1);
        LDS_BARRIER();
        const LAS unsigned char* Lb = L + (c & 1) * HG_BUF;
        f32x4 d00 = {0.f, 0.f, 0.f, 0.f}, d01 = d00, d11 = d00;
#pragma unroll
        for (int ks = 0; ks < 4; ++ks) { const int co = (((4 * ks + g) ^ r) << 4);
            const bf16x8 kt0 = *(const LAS bf16x8*)(Lb + HG_KT + r * 256 + co), kt1 = *(const LAS bf16x8*)(Lb + HG_KT + (16 + r) * 256 + co);
            const bf16x8 qt0 = *(const LAS bf16x8*)(Lb + HG_QT + r * 256 + co), qt1 = *(const LAS bf16x8*)(Lb + HG_QT + (16 + r) * 256 + co);
            d00 = MFMA16(kt0, qt0, d00); d01 = MFMA16(kt0, qt1, d01); d11 = MFMA16(kt1, qt1, d11); }
        asm volatile("" ::: "memory");
#pragma unroll
        for (int i = 0; i < 4; ++i) if (4 * g + i > r) { d00[i] = 0.f; d11[i] = 0.f; }
        const v4u a0w = {pk2(d00[0], d00[1]), pk2(d00[2], d00[3]), 0u, 0u}, a1w = {pk2(d01[0], d01[1]), pk2(d01[2], d01[3]), pk2(d11[0], d11[1]), pk2(d11[2], d11[3])};
        const v2u vpl = *(const LAS v2u*)(Lb + HG_VT + ((w * 4 + (g >> 1)) * 16 + r) * 16 + 8 * (g & 1)), vph = *(const LAS v2u*)(Lb + HG_VT + ((w * 4 + 2 + (g >> 1)) * 16 + r) * 16 + 8 * (g & 1));
        const bf16x8 vperm = __builtin_bit_cast(bf16x8, (v4u){vpl.x, vpl.y, vph.x, vph.y});
        const bf16x8 vnat = *(const LAS bf16x8*)(Lb + HG_VT + ((w * 4 + g) * 16 + r) * 16);
        f32x4 o0 = MFMA16(__builtin_bit_cast(bf16x8, a0w), vperm, ((f32x4){0.f, 0.f, 0.f, 0.f})), o1 = MFMA16(__builtin_bit_cast(bf16x8, a1w), vperm, ((f32x4){0.f, 0.f, 0.f, 0.f}));
        asm volatile("" ::: "memory");
#pragma unroll
        for (int kk = 0; kk < 4; ++kk) {
            const v4u sw = {pk2(S[2 * kk][0], S[2 * kk][1]), pk2(S[2 * kk][2], S[2 * kk][3]), pk2(S[2 * kk + 1][0], S[2 * kk + 1][1]), pk2(S[2 * kk + 1][2], S[2 * kk + 1][3])};
            const int c_lo = (((4 * kk + (g >> 1)) ^ r) << 4) + 8 * (g & 1), c_hi = (((4 * kk + 2 + (g >> 1)) ^ r) << 4) + 8 * (g & 1);
            const v2u p0l = *(const LAS v2u*)(Lb + HG_QT + r * 256 + c_lo), p0h = *(const LAS v2u*)(Lb + HG_QT + r * 256 + c_hi);
            const v2u p1l = *(const LAS v2u*)(Lb + HG_QT + (16 + r) * 256 + c_lo), p1h = *(const LAS v2u*)(Lb + HG_QT + (16 + r) * 256 + c_hi);
            o0 = MFMA16(__builtin_bit_cast(bf16x8, (v4u){p0l.x, p0l.y, p0h.x, p0h.y}), __builtin_bit_cast(bf16x8, sw), o0);
            o1 = MFMA16(__builtin_bit_cast(bf16x8, (v4u){p1l.x, p1l.y, p1h.x, p1h.y}), __builtin_bit_cast(bf16x8, sw), o1); }
#pragma unroll
        for (int i = 0; i < 4; ++i) { const int t0 = 32 * c + 4 * g + i, t1 = t0 + 16, ta0 = tbase + tsgn * t0, ta1 = tbase + tsgn * t1;
            obuf[(size_t)(row_base + ta0) * 512 + h * 128 + 16 * w + r] = (bf16)(pk2(o0[i], 0.f) & 0xffffu); obuf[(size_t)(row_base + ta1) * 512 + h * 128 + 16 * w + r] = (bf16)(pk2(o1[i], 0.f) & 0xffffu); }
#pragma unroll
        for (int t8 = 0; t8 < 8; ++t8) { const bf16x8 khf = *(const LAS bf16x8*)(Lb + HG_KH + ((t8 * 4 + g) * 16 + r) * 16); const f32x4 pe = *(const LAS f32x4*)(Lb + HG_PE + (16 * t8 + 4 * g) * 4);
            S[t8] = MFMA16(khf, vnat, S[t8]) * pe; }
    }
#undef HG_L
#undef HG_P1
#undef HG_P2
    if (sfin) {
#pragma unroll
        for (int t8 = 0; t8 < 8; ++t8)
#pragma unroll
            for (int i = 0; i < 4; ++i) sfin[(size_t)(16 * t8 + 4 * g + i) * 128 + 16 * w + r] = S[t8][i];
    }
    __syncthreads();
    return c;
}

__device__ __forceinline__ bool early_chains(const Frame& F) { return EARLY_CHAINS && F.xok && F.G == 256; }
__device__ __forceinline__ void p5_chains(Frame& F, unsigned* cw) {
    if (F.xr >= 8) { if (F.tid == 0) (void)__hip_atomic_fetch_add(cw + CW_GDONE + 64 * F.xl, 1u, RLX_AGENT); return; }
    if (F.tid == 0) { unsigned sp = 0; while (__hip_atomic_load(cw + CW_SAMP + 64 * F.xl, RLX_AGENT) < 320u) { __builtin_amdgcn_s_sleep(2); if (++sp > (1u << 22)) break; }
        __builtin_amdgcn_fence(__ATOMIC_ACQUIRE, "agent"); asm volatile("s_waitcnt vmcnt(0)" ::: "memory"); }
    __syncthreads();
    const int b = F.xl - 6, dir = F.xr & 1, h = F.xr >> 1, v = b * 8 + F.xr;
    const int c = hgrn_unit(F, M_P + b * T_S, T_S, h, dir, F.state0 + ((size_t)(b * 2 + dir) * 4 + h) * 16384, F.hsave + (size_t)v * 16384, dir == 0 ? F.OF : F.OB, 0, T_S / 32, cw + CW_GDONE + 64 * F.xl, 24u);
    if (F.tid == 0) F.hidx[v] = c;
}
__device__ __forceinline__ void p6_phase(Frame& F) {
    const bool ec = early_chains(F);
    const bool head = ec ? (F.xl >= 6 && F.xr < 8) : ((int)blockIdx.x < N_HEADWG);
    if (head) { const int v = ec ? (F.xl - 6) * 8 + F.xr : (int)blockIdx.x, dir = v & 1, h = (v >> 1) & 3, b = v >> 3;
        const int c0 = ec ? F.hidx[v] : 0, c1 = c0 + HG_HEAD < T_S / 32 ? c0 + HG_HEAD : T_S / 32;
        if (c0 < c1) hgrn_unit(F, M_P + b * T_S, T_S, h, dir, ec ? F.hsave + (size_t)v * 16384 : F.state0 + ((size_t)(b * 2 + dir) * 4 + h) * 16384, F.hsave + (size_t)v * 16384, dir == 0 ? F.OF : F.OB, c0, c1);
        if (F.tid == 0) F.hidx[v] = c1; }
    else { const int dense = ec ? (F.xl < 6 ? F.xl * 32 + F.xr : 192 + (F.xl - 6) * 24 + (F.xr - 8)) : (int)blockIdx.x - N_HEADWG;
        p6a_prep(F, dense); if (CONV_P6) convert_queue(F, CW_CONVQ + 320, CV_LATE0, CV_LATE_N); }
}

__device__ __forceinline__ int crow(int r, int hi) { return (r & 3) + 8 * (r >> 2) + 4 * hi; }
constexpr int AT_K = 0, AT_V = 16384, AT_STAGE = 16384 + 128 * 136, XCH_SLOT = 64 * 64 * 4;
__device__ __forceinline__ void attn_finish(Frame& F, const f32x16 (&o)[4], const LAS float* slot, float lam, int row0, int h, int lane) {
    const int r32 = lane & 31, hi = lane >> 5;
    f32x16 d[4]; float ss = 0.f;
#pragma unroll
    for (int dv = 0; dv < 4; ++dv)
#pragma unroll
        for (int r = 0; r < 16; ++r) { const float x = o[dv][r] - lam * slot[(dv * 16 + r) * 64 + lane]; d[dv][r] = x; ss += x * x; }
    ss += __shfl_xor(ss, 32);
    const float rstd = (1.0f - LAM_INIT) / sqrtf(ss * (1.0f / 128.0f) + EPS);
    bf16* orow = F.ABUF2 + (size_t)(row0 + r32) * DM + 512 + h * 128;
#pragma unroll
    for (int dv = 0; dv < 4; ++dv)
#pragma unroll
        for (int g = 0; g < 4; ++g) { const int c = 32 * dv + 8 * g + 4 * hi; const f32x4 w4 = *(const GAS f32x4*)(F.attn_subln + c);
            v2u w; w.x = pk2(d[dv][4 * g] * rstd * w4.x, d[dv][4 * g + 1] * rstd * w4.y); w.y = pk2(d[dv][4 * g + 2] * rstd * w4.z, d[dv][4 * g + 3] * rstd * w4.w);
            *(GAS v2u*)(orow + c) = w; }
}
__device__ __forceinline__ float attn_lam(Frame& F) {
    const float a = F.attn_lambda[F.lane] * F.attn_lambda[64 + F.lane], b = F.attn_lambda[128 + F.lane] * F.attn_lambda[192 + F.lane];
    return __expf(wave_sum(a)) - __expf(wave_sum(b)) + LAM_INIT;
}
__device__ __forceinline__ void attn_unit(Frame& F, const bf16* Kb, const bf16* VTb, int TK, int row0, int h) {
    LAS unsigned char* L = F.lds;
    int tid_ = F.tid; asm volatile("" : "+v"(tid_));
    const int tid = tid_, w = F.wave, lane = tid & 63, mp = w >> 2, qb = w & 3, r32 = lane & 31, hi = lane >> 5;
    const float lam = attn_lam(F);
    bf16x8 qf[4];
    { const bf16* Qp = F.QB + (size_t)(row0 + 32 * qb + r32) * 512 + h * 128 + mp * 64 + 8 * hi;
#pragma unroll
      for (int s = 0; s < 4; ++s) qf[s] = *(const GAS bf16x8*)(Qp + 16 * s); }
    f32x16 o[4];
#pragma unroll
    for (int d = 0; d < 4; ++d) o[d] = f32x16{};
    float m_run = -1e30f, l_run = 0.f;
    v4u kreg[2], vreg[2];
    const int krow0 = tid >> 4, kch = tid & 15, vrow0 = tid >> 3, vch = tid & 7;
#define AT_LOAD(kv0_) do { _Pragma("unroll") for (int i = 0; i < 2; ++i) { kreg[i] = *(const GAS v4u*)(Kb + (size_t)((kv0_) + krow0 + 32 * i) * 512 + h * 128 + kch * 8); \
        vreg[i] = *(const GAS v4u*)(VTb + (size_t)(vrow0 + 64 * i) * TK + (kv0_) + vch * 8); } } while (0)
#define AT_WRITE(st_) do { LAS unsigned char* Ls_ = L + (st_) * AT_STAGE; _Pragma("unroll") for (int i = 0; i < 2; ++i) { const int kr = krow0 + 32 * i, vr = vrow0 + 64 * i; \
        *(LAS v4u*)(Ls_ + AT_K + kr * 256 + ((kch ^ (kr & 15)) << 4)) = kreg[i]; \
        *(LAS v2u*)(Ls_ + AT_V + vr * 136 + vch * 16) = (v2u){vreg[i].x, vreg[i].y}; *(LAS v2u*)(Ls_ + AT_V + vr * 136 + vch * 16 + 8) = (v2u){vreg[i].z, vreg[i].w}; } } while (0)
    const int ntiles = TK >> 6;
    AT_LOAD(0); AT_WRITE(0);
    __syncthreads();
    for (int t = 0; t < ntiles; ++t) {
        if (t + 1 < ntiles) AT_LOAD((t + 1) * 64);
        const LAS unsigned char* Ls = L + (t & 1) * AT_STAGE;
#pragma unroll
        for (int j = 0; j < 2; ++j) {
            f32x16 p = f32x16{};
            __builtin_amdgcn_s_setprio(1);
#pragma unroll
            for (int s = 0; s < 4; ++s) { const bf16x8 kf = *(const LAS bf16x8*)(Ls + AT_K + (32 * j + r32) * 256 + (((mp * 8 + 2 * s + hi) ^ (r32 & 15)) << 4));
                p = __builtin_amdgcn_mfma_f32_32x32x16_bf16(kf, qf[s], p, 0, 0, 0); }
            __builtin_amdgcn_s_setprio(0);
            float mx = p[0];
#pragma unroll
            for (int r = 1; r < 16; ++r) mx = fmaxf(mx, p[r]);
            mx = fmaxf(mx, __shfl_xor(mx, 32));
            const float mnew = (mx > m_run + 8.0f) ? mx : m_run, alpha = __builtin_amdgcn_exp2f(m_run - mnew); m_run = mnew;
            float ls = 0.f;
#pragma unroll
            for (int r = 0; r < 16; ++r) { p[r] = __builtin_amdgcn_exp2f(p[r] - mnew); ls += p[r]; }
            l_run = l_run * alpha + ls;
            if (__any(alpha != 1.0f)) {
#pragma unroll
                for (int d = 0; d < 4; ++d)
#pragma unroll
                    for (int r = 0; r < 16; ++r) o[d][r] *= alpha; }
            __builtin_amdgcn_s_setprio(1);
#pragma unroll
            for (int s = 0; s < 2; ++s) { const v4u pw = {pk2(p[8 * s + 0], p[8 * s + 1]), pk2(p[8 * s + 2], p[8 * s + 3]), pk2(p[8 * s + 4], p[8 * s + 5]), pk2(p[8 * s + 6], p[8 * s + 7])};
#pragma unroll
                for (int d = 0; d < 4; ++d) { const LAS unsigned char* vp = Ls + AT_V + (32 * d + r32) * 136 + (32 * j + 16 * s + 4 * hi) * 2;
                    const v2u lo = *(const LAS v2u*)vp, hh = *(const LAS v2u*)(vp + 16);
                    o[d] = __builtin_amdgcn_mfma_f32_32x32x16_bf16(__builtin_bit_cast(bf16x8, (v4u){lo.x, lo.y, hh.x, hh.y}), __builtin_bit_cast(bf16x8, pw), o[d], 0, 0, 0); } }
            __builtin_amdgcn_s_setprio(0);
        }
        if (t + 1 < ntiles) AT_WRITE((t + 1) & 1);
        __syncthreads();
    }
#undef AT_LOAD
#undef AT_WRITE
    const float inv = 1.0f / (l_run + __shfl_xor(l_run, 32));
#pragma unroll
    for (int d = 0; d < 4; ++d)
#pragma unroll
        for (int r = 0; r < 16; ++r) o[d][r] *= inv;
    LAS float* slot = (LAS float*)(L + qb * XCH_SLOT);
    if (mp == 1) {
#pragma unroll
        for (int d = 0; d < 4; ++d)
#pragma unroll
            for (int r = 0; r < 16; ++r) slot[(d * 16 + r) * 64 + lane] = o[d][r];
    }
    __syncthreads();
    if (mp == 0) attn_finish(F, o, slot, lam, row0 + 32 * qb, h, lane);
    __syncthreads();
}

__device__ __forceinline__ void p6b_mixers(Frame& F, int qrun) {
    constexpr int N_HS = NB_S * 4 * 2, N_AS = NB_S * 4 * 8, N_HP = NB_P * 4 * 2, N_AP = NB_P * 4 * 2, N_ALL = N_HS + N_AS + N_HP + N_AP, N_CV = (CONV_LATE_P3 || CONV_P6 || CONV_P5TAIL) ? 0 : (CONV_P9 ? CV_MO / 16 : CV_LATE_N / 16);
    volatile LAS int* qslot = (volatile LAS int*)(F.lds + MISC_OFF + 64);
    for (;;) {
        if (F.tid == 0) *qslot = (int)__hip_atomic_fetch_add(F.ctl + CW_QUEUE + 64 * qrun, 1u, RLX_AGENT);
        __syncthreads();
        int u = *qslot;
        __syncthreads();
        if (u >= N_ALL + N_CV) break;
        if (u >= N_ALL) {
            LAS float* scr = (LAS float*)(F.lds + RING_OFF + F.wave * 16384);
            for (int j = 0; j < 2; ++j) convert_item(F, scr, CV_LATE0 + (u - N_ALL) * 16 + j * 8 + F.wave);
            __syncthreads(); continue; }
#ifdef PROBE_SUB
        if (qrun) { const int cls = u < N_HS ? 0 : u < N_HS + N_AS ? 1 : u < N_HS + N_AS + N_HP ? 2 : 3; if (!((PROBE_SUB >> cls) & 1)) continue; }
#endif
        const bool is_hs = u < N_HS, is_as = !is_hs && u < N_HS + N_AS, is_hp = !is_hs && !is_as && u < N_HS + N_AS + N_HP;
        if (is_hs || is_hp) { const int v = is_hs ? u : u - N_HS - N_AS; const int dir = v & 1, h = (v >> 1) & 3, b = v >> 3;
            hgrn_unit(F, is_hs ? M_P + b * T_S : b * T_P, is_hs ? T_S : T_P, h, dir, is_hs ? F.hsave + (size_t)v * 16384 : nullptr,
                      (is_hs || qrun) ? nullptr : F.out + OUT_S + ((size_t)(b * 2 + dir) * 4 + h) * 16384, dir == 0 ? F.OF : F.OB, is_hs ? F.hidx[v] : 0, is_hs ? T_S / 32 : T_P / 32); continue; }
        { const int v = is_as ? u - N_HS : u - N_HS - N_AS - N_HP;
          const int h = is_as ? (v >> 3) & 3 : (v >> 1) & 3, b = is_as ? v >> 5 : v >> 3, qo = is_as ? (v & 7) * 128 : (v & 1) * 128;
          attn_unit(F, is_as ? F.KS + (size_t)b * TK_S * 512 : F.KB + (size_t)b * T_P * 512, is_as ? F.VTS + (size_t)(b * 4 + h) * 128 * TK_S : F.VTP + (size_t)(b * 4 + h) * 128 * T_P,
                    is_as ? TK_S : T_P, (is_as ? M_P + b * T_S : b * T_P) + qo, h); }
    }
}

__device__ __forceinline__ void p7_combine(Frame& F) {
    const int lane = F.lane, xl = F.xl, wl = F.xr * NWAVES + F.wave, NWL = (F.G / 8) * NWAVES;
    float nw[8];
#pragma unroll
    for (int j = 0; j < 8; ++j) nw[j] = F.hgrn_out_norm[(8 * lane + j) & 127];
    for (int rl = wl; rl < M / 8; rl += NWL) { const int row = pg8::pmap(5 * xl + (rl >> 8)) * 256 + (rl & 255);
        const v4u fa = *(const GAS v4u*)(F.OF + (size_t)row * 512 + 8 * lane), ba = *(const GAS v4u*)(F.OB + (size_t)row * 512 + 8 * lane);
        const float o[8] = {bflo(fa.x) + bflo(ba.x), bfhi(fa.x) + bfhi(ba.x), bflo(fa.y) + bflo(ba.y), bfhi(fa.y) + bfhi(ba.y), bflo(fa.z) + bflo(ba.z), bfhi(fa.z) + bfhi(ba.z), bflo(fa.w) + bflo(ba.w), bfhi(fa.w) + bfhi(ba.w)};
        float ss = 0.f;
#pragma unroll
        for (int j = 0; j < 8; ++j) ss += o[j] * o[j];
        ss += __shfl_xor(ss, 1); ss += __shfl_xor(ss, 2); ss += __shfl_xor(ss, 4); ss += __shfl_xor(ss, 8);
        const float rstd = 1.0f / sqrtf(ss * (1.0f / 128.0f) + EPS);
        const v4u ga = *(const GAS v4u*)(F.PROJ + (size_t)row * NMIX + PC_G + 8 * lane);
        const float g[8] = {bflo(ga.x), bfhi(ga.x), bflo(ga.y), bfhi(ga.y), bflo(ga.z), bfhi(ga.z), bflo(ga.w), bfhi(ga.w)};
        float y[8];
#pragma unroll
        for (int j = 0; j < 8; ++j) y[j] = o[j] * rstd * nw[j] * (g[j] * sigmoid_f(g[j]));
        v4u w; w.x = pk2(y[0], y[1]); w.y = pk2(y[2], y[3]); w.z = pk2(y[4], y[5]); w.w = pk2(y[6], y[7]);
        *(GAS v4u*)(F.ABUF2 + (size_t)row * DM + 8 * lane) = w;
    }
}

struct Args { const float* in[24]; float* out; unsigned char* ws; int ph_lo, ph_hi, use_bar, pad; };
__global__ void __launch_bounds__(NWAVES * 64, 2) hymba_fwd(Args args) {
    extern __shared__ __attribute__((aligned(16))) unsigned char lds[];
    Frame F;
    F.lds = (LAS unsigned char*)lds;
    F.MISC = (volatile LAS unsigned*)(F.lds + MISC_OFF);
    F.tid = threadIdx.x; F.lane = F.tid & 63; F.wave = __builtin_amdgcn_readfirstlane(F.tid >> 6);
    F.G = gridDim.x; { const int bx = blockIdx.x; F.vcu = (F.G % 8 == 0) ? (bx % 8) * (F.G / 8) + bx / 8 : bx; }
    unsigned char* ws = args.ws;
    F.ctl = (gu32*)(ws + WS_CTL);
    F.x_prompt = args.in[0]; F.x_sample = args.in[1]; F.c = args.in[2]; F.cache_k = args.in[3]; F.cache_v = args.in[4]; F.state0 = args.in[5]; F.c_ctx = args.in[6];
    F.w_ada = args.in[7]; F.b_ada = args.in[8]; F.norm_ffn1 = args.in[9]; F.w_ffn1_in = args.in[10]; F.w_ffn1_out = args.in[11]; F.norm_mix = args.in[12]; F.w_mix_in = args.in[13]; F.w_mix_out = args.in[14];
    F.lb_logits = args.in[15]; F.hgrn_out_norm = args.in[16]; F.q_norm = args.in[17]; F.k_norm = args.in[18]; F.attn_lambda = args.in[19]; F.attn_subln = args.in[20]; F.norm_ffn2 = args.in[21];
    F.w_ffn2_in = args.in[22]; F.w_ffn2_out = args.in[23]; F.out = args.out;
    F.mada = (float*)(ws + WS_MADA); F.rope = (float*)(ws + WS_ROPE); F.lbv = (float*)(ws + WS_LB);
    F.W1I = (bf16*)(ws + WS_W1I); F.W1O = (bf16*)(ws + WS_W1O); F.WMI = (bf16*)(ws + WS_WMI); F.WMO = (bf16*)(ws + WS_WMO); F.W2I = (bf16*)(ws + WS_W2I); F.W2O = (bf16*)(ws + WS_W2O);
    F.ABUF = (bf16*)(ws + WS_ABUF); F.ABUF2 = (bf16*)(ws + WS_ABUF2); F.rowss = (float*)(ws + WS_ROWSS); F.bias2m = (float*)(ws + WS_BIAS2); F.bias2f = F.bias2m + 3 * 4096; F.hsave = (float*)(ws + WS_HSAVE); F.hidx = (int*)(ws + WS_ROWSS); F.cq1 = (float*)(ws + WS_BIAS2); F.cq2 = F.cq1 + NFF; F.rowq = F.cq2 + NFF; F.HID = (bf16*)(ws + WS_BIG); F.PROJ = (bf16*)(ws + WS_BIG); F.QB = (bf16*)(ws + WS_QB); F.KB = (bf16*)(ws + WS_KB); F.KS = (bf16*)(ws + WS_KS);
    F.VTP = (bf16*)(ws + WS_VTP); F.VTS = (bf16*)(ws + WS_VTS); F.OF = (bf16*)(ws + WS_OF); F.OB = (bf16*)(ws + WS_OB);
    for (int u = F.tid; u < (LDS_BYTES - LDSCTL_OFF) / 4; u += NWAVES * 64) ((LAS unsigned*)(F.lds + LDSCTL_OFF))[u] = 0u;
    __syncthreads();
    XcdBarrier bar; bar.bar = (unsigned*)(F.ctl + CW_BAR); bar.x = 0; bar.st = nullptr;
    if (args.use_bar) bar = xcd_barrier_post((unsigned*)(F.ctl + CW_BAR), F.MISC + 8);
    const int lo = args.ph_lo, hi = args.ph_hi;
#ifndef PROBE_DUP
#define PROBE_DUP 0u
#endif
#define IN(k) (lo <= (k) && (k) < hi)
#define SEAM_LOCAL(k) (LOCAL_SEAMS && !FUSE_NORM && !MERGE_FFN && ((k) == 1 || (k) == 3 || (k) == 9 || (k) == 10 || (k) == 11))
#define SEAM(k) do { if (IN(k) && IN((k) + 1) && !(MERGE_FFN && !FUSE_NORM && ((k) == 2 || (k) == 11))) { if (SEAM_LOCAL(k) && F.xok) xcc_barrier(bar, cw + CW_LBAR); else xcd_barrier(bar); } } while (0)
#define PHASE(k, ...) if (IN(k)) { constexpr bool dupk = ((PROBE_DUP) >> (k)) & 1u; \
        if constexpr (dupk) { _Pragma("unroll 1") for (int qrun = 0; qrun < 2; ++qrun) { if (qrun) xcd_barrier(bar); __VA_ARGS__ } } \
        else { constexpr int qrun = 0; (void)qrun; __VA_ARGS__ } } SEAM(k)
#ifdef PROBE_EPI
#define PROBE_EPI_FLAG args.pad
#else
#define PROBE_EPI_FLAG 0
#endif
#ifdef PROBE_BMUL
#define PROBE_GEMM_HOOK if (args.pad) { g.bmul = (PROBE_BMUL) & 1; g.amul = ((PROBE_BMUL) >> 1) & 1; }
#else
#define PROBE_GEMM_HOOK
#endif
#ifndef PROBE_FFN_PART
#define PROBE_FFN_PART 0
#endif
#ifndef PROBE_FORCE_LOCAL
#define PROBE_FORCE_LOCAL 0
#endif
#define COMMA ,
#define GEMM_PHASE(EPI, A_, B_, N_, K_, ...) do { Gemm g{A_, B_, M, N_, K_}; PROBE_GEMM_HOOK; typedef pg8::EPI EpiT; typedef pg8::OrderSel<EpiT::TALL>::type OrderT; OrderT S; S.init(M, N_, F.G, F.xr * 8 + F.xl); EpiT E{__VA_ARGS__}; \
        pg8::gemm_phase<EpiT, OrderT, PG8_ALIGN, PG8_SP2>(F.lds + RING_OFF, g, S, E); } while (0)
    using pg8::Gemm; using pg8::StaticOrder;
    constexpr int KFI = FFN_IN_MODE ? DM / 2 : DM;
    float* const outS = F.out + (size_t)M_P * DM;
    F.xl = (int)blockIdx.x % 8; F.xr = (int)blockIdx.x / 8; F.xok = PROBE_FORCE_LOCAL;
#define RELABEL() do { if (args.use_bar && IN(0) && IN(1)) { const unsigned verdict = F.MISC[11], rk = F.MISC[10]; if (verdict == 1u && rk < (unsigned)(F.G / 8)) { F.xok = 1; F.xl = (int)bar.x; F.xr = (int)rk; } } } while (0)
    unsigned* const cw = (unsigned*)F.ctl;
#if FUSE_NORM
    PHASE(0, p0_prologue(F); );
    PHASE(1, norm_mod_phase<0>(F, F.x_prompt, F.x_sample, F.norm_ffn1, 0, 1); bias2_rows(F, F.WMI, NMIX, 3, F.bias2m); bias2_rows(F, F.W2I, NFF, 6, F.bias2f); );
    PHASE(2, GEMM_PHASE(EpiSwiGLU<false>, F.ABUF, F.W1I, NFF, KFI, F.HID, DFF, nullptr, nullptr, PROBE_EPI_FLAG); if (CONV_P2TAIL) convert_queue(F, CW_CONVQ, CV_FI, CV_FO + CV_MI); );
    PHASE(3, GEMM_PHASE(EpiResid<true COMMA true>, F.HID, F.W1O, DM, DFF, F.x_prompt, F.x_sample, F.out, F.mada + 2 * 1024, F.ABUF, F.norm_mix, F.mada + 4 * 1024, F.rowss);
             if (CONV_LATE_P3) convert_queue(F, CW_CONVQ + 64, CV_LATE0, CV_LATE_N); );
    PHASE(4, GEMM_PHASE(EpiProj<true>, F.ABUF, F.WMI, NMIX, DM, F.PROJ, F.out + OUT_V, F.lbv, F.rowss, F.bias2m); );
    PHASE(5, p6_phase(F); );
    PHASE(6, p6b_mixers(F, qrun + args.pad); );
    PHASE(7, p7_combine(F); );
    PHASE(8, GEMM_PHASE(EpiResid<true COMMA false>, F.ABUF2, F.WMO, DM, DM, F.out, outS, F.out, F.mada + 5 * 1024, F.ABUF, F.norm_ffn2, F.mada + 7 * 1024, F.rowss); );
    PHASE(9, GEMM_PHASE(EpiSwiGLU<true>, F.ABUF, F.W2I, NFF, DM, F.HID, DFF, F.rowss, F.bias2f, NFF); );
    PHASE(10, GEMM_PHASE(EpiResid<false COMMA true>, F.HID, F.W2O, DM, DFF, F.out, outS, F.out, F.mada + 8 * 1024, nullptr, nullptr, nullptr, nullptr); );
#else
    PHASE(0, p0_prologue(F); );
    RELABEL();
    PHASE(1, norm_mod_phase<FFN_IN_MODE>(F, F.x_prompt, F.x_sample, F.norm_ffn1, 0, 1); );
#if MERGE_FFN
#define FFN_MERGED(AIN, WIN, WOUT, B0, B1, GATE, PC, UC) do { \
        if (!(args.pad && PROBE_FFN_PART == 2)) { Gemm g{AIN, WIN, M, NFF, DM}; pg8::XccInOrder S{F.xl, F.xr, cw + (PC) + 4096 * args.pad, F.xok}; typedef pg8::EpiSwiGLU<false> EpiT; EpiT E{F.HID, DFF, nullptr, nullptr, 0}; \
          pg8::gemm_phase<EpiT, pg8::XccInOrder, PG8_ALIGN, PG8_SP2>(F.lds + RING_OFF, g, S, E); } \
        if (!(args.pad && PROBE_FFN_PART == 1)) { Gemm g{F.HID, WOUT, M, DM, DFF}; pg8::XccOutOrder S{F.xl, F.xr, cw + (PC) + (PROBE_FFN_PART == 2 ? 0 : 4096 * args.pad)}; typedef pg8::EpiResidSplit<true> EpiT; EpiT E{B0, B1, args.pad ? (float*)(args.ws + WS_OF) : F.out, GATE, (float*)(args.ws + WS_SLAB), cw + (UC) + 4096 * args.pad, F.xl, F.xok};     \
          pg8::gemm_phase<EpiT, pg8::XccOutOrder, PG8_ALIGN, PG8_SP2>(F.lds + RING_OFF, g, S, E); } } while (0)
    PHASE(2, FFN_MERGED(F.ABUF, F.W1I, F.W1O, F.x_prompt, F.x_sample, F.mada + 2 * 1024, CW_PANEL1, CW_UNIT1); );
    PHASE(3, ; );
#else
    PHASE(2, GEMM_PHASE(EpiSwiGLU<false COMMA FP8_FFN1_OUT != 0 COMMA TALL_FI != 0>, F.ABUF, F.W1I, NFF, KFI, F.HID, DFF, F.rowq, F.cq1, PROBE_EPI_FLAG); if (CONV_P2TAIL) convert_queue(F, CW_CONVQ, CV_FI, CV_FO + CV_MI); );
    PHASE(3, GEMM_PHASE(EpiResid<false COMMA true COMMA FP8_FFN1_OUT != 0 COMMA TALL_FO != 0>, F.HID, F.W1O, DM, FP8_FFN1_OUT ? DFF / 2 : DFF, F.x_prompt, F.x_sample, F.out, F.mada + 2 * 1024, nullptr, nullptr, nullptr, nullptr);
             if (CONV_LATE_P3) convert_queue(F, CW_CONVQ + 64, CV_LATE0, CV_LATE_N); );
#endif
    PHASE(4, norm_mod_phase<0>(F, F.out, outS, F.norm_mix, 3, 4); );
#if TALL_MI
    PHASE(5, GEMM_PHASE(EpiProj<false COMMA true>, F.ABUF, F.WMI, NMIX, DM, F.PROJ, F.out + OUT_V, F.lbv, nullptr, nullptr); );
#else
    PHASE(5, { Gemm g{F.ABUF, F.WMI, M, NMIX, DM}; StaticOrder S; S.init(M, NMIX, F.G, F.xr * 8 + F.xl); const bool ec = early_chains(F) && !args.pad;
               if (ec) { S.sf = 1; S.sc = cw + CW_SAMP + 64 * F.xl; S.local = 1; }
               typedef pg8::EpiProj<false> EpiT; EpiT E{F.PROJ, F.out + OUT_V, F.lbv, nullptr, nullptr};
               pg8::gemm_phase<EpiT, StaticOrder, PG8_ALIGN, PG8_SP2>(F.lds + RING_OFF, g, S, E);
               if (ec && F.xl >= 6) p5_chains(F, cw);
               if (CONV_P5TAIL && !(ec && F.xl >= 6 && F.xr < 8)) convert_queue(F, CW_CONVQ + 384, CV_LATE0, CV_LATE_N); } );
#endif
    PHASE(6, p6_phase(F); );
    PHASE(7, p6b_mixers(F, qrun + args.pad); );
    PHASE(8, p7_combine(F); );
    PHASE(9, GEMM_PHASE(EpiResid<false COMMA false COMMA false COMMA TALL_MO != 0>, F.ABUF2, F.WMO, DM, DM, F.out, outS, F.out, F.mada + 5 * 1024, nullptr, nullptr, nullptr, nullptr);
             if (CONV_P9) convert_queue(F, CW_CONVQ + 192, CV_LATE0 + CV_MO, CV_FI + CV_FO); );
    PHASE(10, norm_mod_phase<FFN_IN_MODE>(F, F.out, outS, F.norm_ffn2, 6, 7); );
#if MERGE_FFN
    PHASE(11, FFN_MERGED(F.ABUF, F.W2I, F.W2O, F.out, outS, F.mada + 8 * 1024, CW_PANEL2, CW_UNIT2); );
    PHASE(12, ; );
#else
    PHASE(11, GEMM_PHASE(EpiSwiGLU<false COMMA FP8_FFN2_OUT != 0 COMMA TALL_FI != 0>, F.ABUF, F.W2I, NFF, KFI, F.HID, DFF, F.rowq, F.cq2, 0); );
    PHASE(12, GEMM_PHASE(EpiResid<false COMMA true COMMA FP8_FFN2_OUT != 0 COMMA TALL_FO != 0>, F.HID, F.W2O, DM, FP8_FFN2_OUT ? DFF / 2 : DFF, F.out, outS, F.out, F.mada + 8 * 1024, nullptr, nullptr, nullptr, nullptr); );
#endif
#endif
#ifdef PROBE_XBAR
#pragma unroll 1
    for (int i = 0; i < PROBE_XBAR; ++i) xcd_barrier(bar);
#endif
#undef IN
#undef SEAM
#undef PHASE
#undef GEMM_PHASE
}

extern "C" void kernel_launch(void* const* d_in, const int* in_sizes, int n_in, void* d_out, int out_size, void* d_ws, size_t ws_size, hipStream_t stream) {
    static int grid = 0;
    if (grid == 0) {
        if (n_in != 24 || in_sizes[0] != M_P * DM || in_sizes[1] != M_S * DM || (size_t)out_size != OUT_END || ws_size < WS_END) {
            fprintf(stderr, "kernel_launch: unexpected shapes (n_in %d, out %d, ws %zu); nothing launched\n", n_in, out_size, ws_size); grid = -1; return; }
        int dev = 0, cus = 0, per_cu = 0;
        if (hipGetDevice(&dev) != hipSuccess || hipDeviceGetAttribute(&cus, hipDeviceAttributeMultiprocessorCount, dev) != hipSuccess) { grid = -1; return; }
        if (hipFuncSetAttribute((const void*)hymba_fwd, hipFuncAttributeMaxDynamicSharedMemorySize, LDS_BYTES) != hipSuccess) { fprintf(stderr, "kernel_launch: hipFuncSetAttribute failed\n"); grid = -1; return; }
        if (hipOccupancyMaxActiveBlocksPerMultiprocessor(&per_cu, (const void*)hymba_fwd, NWAVES * 64, LDS_BYTES) != hipSuccess || per_cu < 1) {
            fprintf(stderr, "kernel_launch: occupancy query reports %d workgroups per CU; nothing launched\n", per_cu); (void)hipGetLastError(); grid = -1; return; }
        grid = cus;
        if (grid % 8 != 0) grid -= grid % 8;
        if (MERGE_FFN && grid != 256) { fprintf(stderr, "kernel_launch: this build needs a 256-CU device (got %d workgroups); nothing launched\n", grid); grid = -1; return; }
    }
    if (grid < 0) return;
    if (hipMemsetAsync((char*)d_ws + WS_CTL, 0, CTL_ZERO_BYTES, stream) != hipSuccess) return;
    Args a{};
    for (int i = 0; i < 24; ++i) a.in[i] = (const float*)d_in[i];
    a.out = (float*)d_out; a.ws = (unsigned char*)d_ws;
#if MK_ONE_LAUNCH
    a.ph_lo = 0; a.ph_hi = N_PHASES; a.use_bar = 1;
    hipLaunchKernelGGL(hymba_fwd, dim3(grid), dim3(NWAVES * 64), LDS_BYTES, stream, a);
#ifdef PROBE_RELAUNCH
    a.ph_lo = PROBE_RELAUNCH; a.ph_hi = PROBE_RELAUNCH + 1; a.use_bar = 0; a.pad = 1;
    hipLaunchKernelGGL(hymba_fwd, dim3(grid), dim3(NWAVES * 64), LDS_BYTES, stream, a);
#endif
#else
    for (int p = 0; p < N_PHASES; ++p) { a.ph_lo = p; a.ph_hi = p + 1; a.use_bar = 0; hipLaunchKernelGGL(hymba_fwd, dim3(grid), dim3(NWAVES * 64), LDS_BYTES, stream, a); }
#endif
}
```
